# Optimizing an MI355X kernel written in HIP

```python
import math
import jax, jax.numpy as jnp
from jax import lax
import numpy as np

D_MODEL = 2048
BATCH = 2
SEQ = 16384
DEPTH = 2

N_EVEN = (DEPTH + 1) // 2
N_ODD = DEPTH // 2

POOL_WIDTH = D_MODEL // 2
POOL_WINDOWS = (2, 4, 8, 16)
POOL_GROUP = POOL_WIDTH // len(POOL_WINDOWS)
GMLP_WIDTH = D_MODEL // 2
GMLP_CHUNK = 128
GMLP_GROUPS = 8
GMLP_GROUP_DIM = GMLP_WIDTH // GMLP_GROUPS
IN_EVEN_WIDTH = POOL_WIDTH + 2 * GMLP_WIDTH

DIFF_HEAD_DIM = 64
DIFF_HEADS = D_MODEL // (2 * DIFF_HEAD_DIM)
DIFF_V_DIM = 2 * DIFF_HEAD_DIM
Q_BLOCK = 128
ROPE_THETA = 10000.0

D_FF = 5632
N_EXPERTS = 8
TOP_K = 2
EPS = 1e-5

kernel_name = "hybrid_pool_gmlp_diffattn_moe"


def rms_norm(x, g):
    xf = x.astype(jnp.float32)
    y = xf * lax.rsqrt(jnp.mean(xf * xf, axis=-1, keepdims=True) + EPS)
    return (y * g.astype(jnp.float32)).astype(x.dtype)


def layer_norm(x, g, b):
    xf = x.astype(jnp.float32)
    mu = jnp.mean(xf, axis=-1, keepdims=True)
    xc = xf - mu
    var = jnp.mean(xc * xc, axis=-1, keepdims=True)
    y = xc * lax.rsqrt(var + EPS) * g.astype(jnp.float32) + b.astype(jnp.float32)
    return y.astype(x.dtype)


def swiglu(h, w_gate, w_up, w_down):
    return (jax.nn.silu(h @ w_gate) * (h @ w_up)) @ w_down


def causal_pool_mixer(z, w_pool, pool_scale):
    S_ = z.shape[1]
    zf = z.astype(jnp.float32)
    cnt_base = jnp.arange(S_) + 1
    outs = []
    for g, w in enumerate(POOL_WINDOWS):
        zg = zf[..., g * POOL_GROUP:(g + 1) * POOL_GROUP]
        c = jnp.cumsum(zg, axis=1)
        lower = jnp.pad(c[:, :S_ - w], ((0, 0), (w, 0), (0, 0)))
        cnt = jnp.minimum(cnt_base, w).astype(jnp.float32)[None, :, None]
        pooled = ((c - lower) / cnt - zg).astype(z.dtype)
        outs.append(jnp.einsum('bsc,cd->bsd', pooled, w_pool[g]))
    return jnp.concatenate(outs, axis=-1) * pool_scale


def chunked_spatial_gating(z, ln_g, ln_b, w_spatial, b_spatial):
    a = jax.nn.gelu(z, approximate=False)
    u, v = jnp.split(a, 2, axis=-1)
    v = layer_norm(v, ln_g, ln_b)
    B_, S_, _ = v.shape
    v = v.reshape(B_, S_ // GMLP_CHUNK, GMLP_CHUNK, GMLP_GROUPS, GMLP_GROUP_DIM)
    mask = jnp.tril(jnp.ones((GMLP_CHUNK, GMLP_CHUNK), dtype=bool))
    w = jnp.where(mask[None], w_spatial, 0).astype(v.dtype)
    mixed = jnp.einsum('gts,bnsgc->bntgc', w, v) + b_spatial.T[None, None, :, :, None]
    return u * mixed.reshape(B_, S_, GMLP_WIDTH)


def rotary(x, cos, sin):
    x1, x2 = jnp.split(x, 2, axis=-1)
    return jnp.concatenate([x1 * cos - x2 * sin, x2 * cos + x1 * sin], axis=-1)


def diff_attention(h, positions, w_qkv, lam_q1, lam_k1, lam_q2, lam_k2, subln_g, w_o, lambda_init):
    B_, S_, _ = h.shape
    q, k, v = jnp.split(h @ w_qkv, 3, axis=-1)
    q = q.reshape(B_, S_, DIFF_HEADS, 2, DIFF_HEAD_DIM)
    k = k.reshape(B_, S_, DIFF_HEADS, 2, DIFF_HEAD_DIM)
    v = v.reshape(B_, S_, DIFF_HEADS, DIFF_V_DIM)
    inv_freq = ROPE_THETA ** (-jnp.arange(0, DIFF_HEAD_DIM, 2, dtype=jnp.float32) / DIFF_HEAD_DIM)
    ang = positions.astype(jnp.float32)[..., None] * inv_freq
    cos = jnp.cos(ang)[:, :, None, None, :].astype(h.dtype)
    sin = jnp.sin(ang)[:, :, None, None, :].astype(h.dtype)
    q = rotary(q, cos, sin) * (DIFF_HEAD_DIM ** -0.5)
    k = rotary(k, cos, sin)
    lam = (jnp.exp(jnp.sum((lam_q1 * lam_k1).astype(jnp.float32)))
           - jnp.exp(jnp.sum((lam_q2 * lam_k2).astype(jnp.float32)))
           + lambda_init)
    n_blk = S_ // Q_BLOCK
    q_blocks = q.reshape(B_, n_blk, Q_BLOCK, DIFF_HEADS, 2, DIFF_HEAD_DIM).transpose(1, 0, 2, 3, 4, 5)
    key_pos = jnp.arange(S_)

    def one_block(args):
        qb, i = args
        s = jnp.einsum('bqhcd,bkhcd->bhcqk', qb, k).astype(jnp.float32)
        q_pos = i * Q_BLOCK + jnp.arange(Q_BLOCK)
        causal = key_pos[None, :] <= q_pos[:, None]
        s = jnp.where(causal, s, -jnp.inf)
        p = jax.nn.softmax(s, axis=-1)
        att = p[:, :, 0] - lam * p[:, :, 1]
        return jnp.einsum('bhqk,bkhe->bqhe', att.astype(v.dtype), v)

    o = lax.map(one_block, (q_blocks, jnp.arange(n_blk)))
    o = o.transpose(1, 0, 2, 3, 4).reshape(B_, S_, DIFF_HEADS, DIFF_V_DIM)
    o = rms_norm(o, subln_g) * (1.0 - lambda_init)
    return o.reshape(B_, S_, DIFF_HEADS * DIFF_V_DIM) @ w_o


def moe_swiglu(h, w_router, we_gate, we_up, we_down):
    logits = (h @ w_router).astype(jnp.float32)
    top_v, top_i = lax.top_k(logits, TOP_K)
    top_w = jax.nn.softmax(top_v, axis=-1)
    gates = jnp.sum(jax.nn.one_hot(top_i, N_EXPERTS, dtype=jnp.float32) * top_w[..., None], axis=-2)
    y = jnp.zeros_like(h)
    for e in range(N_EXPERTS):
        y = y + gates[..., e:e + 1].astype(h.dtype) * swiglu(h, we_gate[e], we_up[e], we_down[e])
    return y


def setup_inputs(seed: int = 0) -> dict:
    key = jax.random.key(seed)
    ks = iter(jax.random.split(key, 40))
    f32 = jnp.float32

    def nrm(shape, scale):
        return jax.random.normal(next(ks), shape, f32) * scale

    def gain(shape):
        return 1.0 + 0.05 * jax.random.normal(next(ks), shape, f32)

    D = D_MODEL
    return {
        "x": jax.random.normal(next(ks), (BATCH, SEQ, D), f32),
        "positions": jnp.tile(jnp.arange(SEQ, dtype=jnp.int32)[None], (BATCH, 1)),
        "ev_norm_mix": gain((N_EVEN, D)),
        "ev_w_in": nrm((N_EVEN, D, IN_EVEN_WIDTH), D ** -0.5),
        "ev_w_pool": nrm((N_EVEN, len(POOL_WINDOWS), POOL_GROUP, POOL_GROUP), POOL_GROUP ** -0.5),
        "ev_pool_scale": gain((N_EVEN, POOL_WIDTH)),
        "ev_ln_g": gain((N_EVEN, GMLP_WIDTH)),
        "ev_ln_b": nrm((N_EVEN, GMLP_WIDTH), 0.02),
        "ev_w_spatial": nrm((N_EVEN, GMLP_GROUPS, GMLP_CHUNK, GMLP_CHUNK), GMLP_CHUNK ** -0.5),
        "ev_b_spatial": 1.0 + nrm((N_EVEN, GMLP_GROUPS, GMLP_CHUNK), 0.02),
        "ev_w_out": nrm((N_EVEN, POOL_WIDTH + GMLP_WIDTH, D), (POOL_WIDTH + GMLP_WIDTH) ** -0.5),
        "ev_norm_ffn": gain((N_EVEN, D)),
        "ev_w_gate": nrm((N_EVEN, D, D_FF), D ** -0.5),
        "ev_w_up": nrm((N_EVEN, D, D_FF), D ** -0.5),
        "ev_w_down": nrm((N_EVEN, D_FF, D), D_FF ** -0.5),
        "od_norm_attn": gain((N_ODD, D)),
        "od_w_qkv": nrm((N_ODD, D, 3 * D), D ** -0.5),
        "od_lam_q1": nrm((N_ODD, DIFF_HEAD_DIM), 0.1),
        "od_lam_k1": nrm((N_ODD, DIFF_HEAD_DIM), 0.1),
        "od_lam_q2": nrm((N_ODD, DIFF_HEAD_DIM), 0.1),
        "od_lam_k2": nrm((N_ODD, DIFF_HEAD_DIM), 0.1),
        "od_subln_g": gain((N_ODD, DIFF_V_DIM)),
        "od_w_o": nrm((N_ODD, D, D), D ** -0.5),
        "od_norm_moe": gain((N_ODD, D)),
        "od_w_router": nrm((N_ODD, D, N_EXPERTS), D ** -0.5),
        "od_we_gate": nrm((N_ODD, N_EXPERTS, D, D_FF), D ** -0.5),
        "od_we_up": nrm((N_ODD, N_EXPERTS, D, D_FF), D ** -0.5),
        "od_we_down": nrm((N_ODD, N_EXPERTS, D_FF, D), D_FF ** -0.5),
        "final_norm": gain((D,)),
    }


def reference(x, positions,
              ev_norm_mix, ev_w_in, ev_w_pool, ev_pool_scale, ev_ln_g, ev_ln_b,
              ev_w_spatial, ev_b_spatial, ev_w_out, ev_norm_ffn, ev_w_gate, ev_w_up, ev_w_down,
              od_norm_attn, od_w_qkv, od_lam_q1, od_lam_k1, od_lam_q2, od_lam_k2, od_subln_g,
              od_w_o, od_norm_moe, od_w_router, od_we_gate, od_we_up, od_we_down,
              final_norm):
    for i in range(DEPTH):
        j = i // 2
        if i % 2 == 0:
            h = rms_norm(x, ev_norm_mix[j])
            z = h @ ev_w_in[j]
            y_pool = causal_pool_mixer(z[..., :POOL_WIDTH], ev_w_pool[j], ev_pool_scale[j])
            y_gate = chunked_spatial_gating(z[..., POOL_WIDTH:], ev_ln_g[j], ev_ln_b[j],
                                            ev_w_spatial[j], ev_b_spatial[j])
            x = x + jnp.concatenate([y_pool, y_gate], axis=-1) @ ev_w_out[j]
            x = x + swiglu(rms_norm(x, ev_norm_ffn[j]), ev_w_gate[j], ev_w_up[j], ev_w_down[j])
        else:
            lambda_init = 0.8 - 0.6 * math.exp(-0.3 * i)
            h = rms_norm(x, od_norm_attn[j])
            x = x + diff_attention(h, positions, od_w_qkv[j], od_lam_q1[j], od_lam_k1[j],
                                   od_lam_q2[j], od_lam_k2[j], od_subln_g[j], od_w_o[j], lambda_init)
            x = x + moe_swiglu(rms_norm(x, od_norm_moe[j]), od_w_router[j],
                               od_we_gate[j], od_we_up[j], od_we_down[j])
    return rms_norm(x, final_norm)
```

```cpp
#include <hip/hip_runtime.h>
#include <hip/hip_bf16.h>
#include <cstdio>
#include <cstdint>
#include <cmath>
namespace pg8 {
#define PG8_LAS __attribute__((address_space(3)))
typedef unsigned short bf16_t;
typedef short bf16x8 __attribute__((ext_vector_type(8)));
typedef float f32x4 __attribute__((ext_vector_type(4)));
typedef unsigned u32x4 __attribute__((ext_vector_type(4)));
constexpr int BM = 256, BK = 64, HALF = 128, HTB = HALF * BK * 2  , STAGE_BYTES = 8 * HTB, NXCD = 8, WGM = 8;

__host__ __device__ __forceinline__ int lds_byte(int r, int c) { const int st = (r >> 4) * 2 + (c >> 5), rr = r & 15, cc = c & 31, ob = rr * 64 + cc * 2; return st * 1024 + (ob ^ (((ob >> 9) & 1) << 5)); }
__host__ __device__ __forceinline__ void stage_rc(int b, int& R, int& C) { const int st = b / 1024, sb = b % 1024, swz = sb ^ (((sb >> 9) & 1) << 5); R = (st >> 1) * 16 + swz / 64; C = (st & 1) * 32 + (swz % 64) / 2; }
__host__ __device__ __forceinline__ int perm32(int rho) { const int n = rho >> 4, i = rho & 15; return 8 * (i >> 2) + 4 * n + (i & 3); }

struct Unit { int pm, pn, be; };
struct Gemm { const bf16_t* A; const bf16_t* Bt; int K; size_t bstride; };

struct StaticOrder {
    int nM, nN, nwg, G, c;
    __host__ __device__ void init(int M, int N, int G_, int c_) { nM = M / BM; nN = N / BM; nwg = nM * nN; G = G_; c = c_; }
    __host__ __device__ bool next(int i, Unit& u) const {
        const long L = (long)i * G + c; if (L >= nwg) return false;
        int wgid = (int)L; { const int q = nwg / NXCD, r = nwg % NXCD, xcd = wgid % NXCD, off = wgid / NXCD; wgid = (xcd < r ? xcd * (q + 1) : r * (q + 1) + (xcd - r) * q) + off; }
        const int nig = WGM * nN, gid = wgid / nig, fm = gid * WGM, gsz = (nM - fm) < WGM ? (nM - fm) : WGM;
        u.pm = fm + ((wgid % nig) % gsz); u.pn = (wgid % nig) / gsz; u.be = 0; return true;
    }
    __device__ __forceinline__ void a_ready(const Unit&) const {}
    __device__ __forceinline__ void done(const Unit&) const {}
};

__device__ __forceinline__ unsigned cvt_pk_bf16(float lo, float hi) { unsigned r; asm volatile("v_cvt_pk_bf16_f32 %0, %1, %2" : "=v"(r) : "v"(lo), "v"(hi)); return r; }
typedef float f32x2 __attribute__((ext_vector_type(2)));
__device__ __forceinline__ f32x2 gelu_pk(f32x2 v) {
    const f32x2 av = __builtin_elementwise_abs(v), d = av * 0.2316418882f + 1.0f;
    f32x2 t; t.x = __builtin_amdgcn_rcpf(d.x); t.y = __builtin_amdgcn_rcpf(d.y);
    f32x2 q = t * 0.5307027145f + (-0.7265760135f); q = q * t + 0.7107068705f; q = q * t + (-0.142248368f); q = q * t + 0.127414796f; q = q * t;
    const f32x2 s = (v * v) * (-0.72134752044f);
    f32x2 e; e.x = __builtin_amdgcn_exp2f(s.x); e.y = __builtin_amdgcn_exp2f(s.y);
    const f32x2 m = v * (q * e), r = v - m;
    f32x2 o; o.x = v.x < 0.f ? m.x : r.x; o.y = v.y < 0.f ? m.y : r.y; return o;
}

__device__ __forceinline__ u32x4 pack8(f32x4 v0, f32x4 v1) { u32x4 w; w.x = cvt_pk_bf16(v0[0], v0[1]); w.y = cvt_pk_bf16(v0[2], v0[3]); w.z = cvt_pk_bf16(v1[0], v1[1]); w.w = cvt_pk_bf16(v1[2], v1[3]); return w; }
__device__ __forceinline__ f32x4 gelu4(f32x4 v) { const f32x2 a = gelu_pk((f32x2){v[0], v[1]}), b = gelu_pk((f32x2){v[2], v[3]}); return (f32x4){a.x, a.y, b.x, b.y}; }
__device__ __forceinline__ float silu1(float x) { return x * __builtin_amdgcn_rcpf(1.0f + __builtin_amdgcn_exp2f(x * -1.4426950408889634f)); }
__device__ __forceinline__ f32x4 swiglu4(f32x4 g, f32x4 u) { return (f32x4){silu1(g[0]) * u[0], silu1(g[1]) * u[1], silu1(g[2]) * u[2], silu1(g[3]) * u[3]}; }

struct EpiZ {
    static constexpr bool PERM = true, AFTER_DRAIN = false;
    bf16_t* O; int ldc; int gelu_from;
    __device__ __forceinline__ void operator()(const f32x4 (&acc)[2][2][4][2], const Unit& u, int wr, int wc, int fr, int fq) const {
        const int row0 = u.pm * BM + wr * 64 + fr, col0 = u.pn * BM + wc * 32 + 8 * fq; const bool gel = u.pn >= gelu_from;
#pragma unroll
        for (int ai = 0; ai < 2; ++ai)
#pragma unroll
            for (int m = 0; m < 4; ++m) { bf16_t* rowp = O + (size_t)(row0 + ai * HALF + m * 16) * ldc + col0;
#pragma unroll
                for (int bj = 0; bj < 2; ++bj) { f32x4 v0 = acc[ai][bj][m][0], v1 = acc[ai][bj][m][1];
                    if (gel) { v0 = gelu4(v0); v1 = gelu4(v1); }
                    *(u32x4*)(rowp + bj * HALF) = pack8(v0, v1); } }
    }
};
struct EpiPlain {
    static constexpr bool PERM = true, AFTER_DRAIN = false;
    bf16_t* O; int ldc;
    __device__ __forceinline__ void operator()(const f32x4 (&acc)[2][2][4][2], const Unit& u, int wr, int wc, int fr, int fq) const {
        const int row0 = u.pm * BM + wr * 64 + fr, col0 = u.pn * BM + wc * 32 + 8 * fq;
#pragma unroll
        for (int ai = 0; ai < 2; ++ai)
#pragma unroll
            for (int m = 0; m < 4; ++m) { bf16_t* rowp = O + (size_t)(row0 + ai * HALF + m * 16) * ldc + col0;
#pragma unroll
                for (int bj = 0; bj < 2; ++bj) *(u32x4*)(rowp + bj * HALF) = pack8(acc[ai][bj][m][0], acc[ai][bj][m][1]); }
    }
};
struct EpiRes {
    static constexpr bool PERM = false, AFTER_DRAIN = false;
    const float* res; float* out; int ldc;
    __device__ __forceinline__ void operator()(const f32x4 (&acc)[2][2][4][2], const Unit& u, int wr, int wc, int fr, int fq) const {
        const int row0 = u.pm * BM + wr * 64 + fr, col0 = u.pn * BM + wc * 32 + 4 * fq;
#pragma unroll
        for (int ai = 0; ai < 2; ++ai)
#pragma unroll
            for (int m = 0; m < 4; ++m) { const size_t off = (size_t)(row0 + ai * HALF + m * 16) * ldc + col0;
                f32x4 r[2][2];
#pragma unroll
                for (int bj = 0; bj < 2; ++bj)
#pragma unroll
                    for (int n = 0; n < 2; ++n) r[bj][n] = *(const f32x4*)(res + off + bj * HALF + n * 16);
#pragma unroll
                for (int bj = 0; bj < 2; ++bj)
#pragma unroll
                    for (int n = 0; n < 2; ++n) *(f32x4*)(out + off + bj * HALF + n * 16) = r[bj][n] + acc[ai][bj][m][n];
                asm volatile("" ::: "memory"); }
    }
};
struct EpiSwiGLU {
    static constexpr bool PERM = true, AFTER_DRAIN = false;
    bf16_t* O; int ldc;
    __device__ __forceinline__ void operator()(const f32x4 (&acc)[2][2][4][2], const Unit& u, int wr, int wc, int fr, int fq) const {
        const int row0 = u.pm * BM + wr * 64 + fr, col0 = u.pn * HALF + wc * 32 + 8 * fq;
#pragma unroll
        for (int ai = 0; ai < 2; ++ai)
#pragma unroll
            for (int m = 0; m < 4; ++m) { bf16_t* rowp = O + (size_t)(row0 + ai * HALF + m * 16) * ldc + col0;
                const f32x4 a0 = swiglu4(acc[ai][0][m][0], acc[ai][1][m][0]), a1 = swiglu4(acc[ai][0][m][1], acc[ai][1][m][1]);
                *(u32x4*)rowp = pack8(a0, a1); }
    }
};
struct EpiQKV {
    static constexpr bool PERM = true, AFTER_DRAIN = false;
    bf16_t* Q; bf16_t* Kk; bf16_t* V; int ldc; const float* rope; float qscale;
    __device__ __forceinline__ void operator()(const f32x4 (&acc)[2][2][4][2], const Unit& u, int wr, int wc, int fr, int fq) const {
        const int row0 = u.pm * BM + wr * 64 + fr;
        if (u.pn < 16) {
            bf16_t* base = (u.pn < 8) ? Q : Kk; const float sc = (u.pn < 8) ? qscale : 1.0f; const int col0 = (u.pn & 7) * BM + wc * 64 + 8 * fq;
#pragma unroll
            for (int ai = 0; ai < 2; ++ai)
#pragma unroll
                for (int m = 0; m < 4; ++m) { const int r = row0 + ai * HALF + m * 16; const float* cs = rope + (size_t)r * 64 + 8 * fq;
                    const f32x4 c0 = *(const f32x4*)(cs), c1 = *(const f32x4*)(cs + 4), s0 = *(const f32x4*)(cs + 32), s1 = *(const f32x4*)(cs + 36);
                    const f32x4 x10 = acc[ai][0][m][0], x11 = acc[ai][0][m][1], x20 = acc[ai][1][m][0], x21 = acc[ai][1][m][1];
                    const f32x4 o10 = (x10 * c0 - x20 * s0) * sc, o11 = (x11 * c1 - x21 * s1) * sc, o20 = (x20 * c0 + x10 * s0) * sc, o21 = (x21 * c1 + x11 * s1) * sc;
                    bf16_t* rowp = base + (size_t)r * ldc + col0;
                    *(u32x4*)rowp = pack8(o10, o11); *(u32x4*)(rowp + 32) = pack8(o20, o21); }
        } else {
            const int col0 = (u.pn - 16) * BM + wc * 32 + 8 * fq;
#pragma unroll
            for (int ai = 0; ai < 2; ++ai)
#pragma unroll
                for (int m = 0; m < 4; ++m) { bf16_t* rowp = V + (size_t)(row0 + ai * HALF + m * 16) * ldc + col0;
#pragma unroll
                    for (int bj = 0; bj < 2; ++bj) *(u32x4*)(rowp + bj * HALF) = pack8(acc[ai][bj][m][0], acc[ai][bj][m][1]); }
        }
    }
};
struct MoeOrder : StaticOrder {
    int tile0; int ts[9];
    __device__ __forceinline__ bool next(int i, Unit& u) const {
        if (!StaticOrder::next(i, u)) return false;
        const int t = tile0 + u.pm; int e = 0;
#pragma unroll
        for (int k = 1; k < 8; ++k) e += (t >= ts[k]) ? 1 : 0;
        u.be = e; return true;
    }
};
template <class Epi, class Sched, bool ALIGN_EPI = false, bool SP2 = false>
__device__ __forceinline__ void gemm_phase(PG8_LAS unsigned char* lds, const Gemm g, const Sched& S, const Epi& E) {
    int tid_ = threadIdx.x; asm volatile("" : "+v"(tid_));
    const int tid = tid_, wid = __builtin_amdgcn_readfirstlane(tid >> 6), lane = tid & 63, wr = wid >> 2, wc = wid & 3, fr = lane & 15, fq = lane >> 4;
    const int K = g.K, nt = K / BK;
    unsigned voffA[2], voffB[2];
#pragma unroll
    for (int i = 0; i < 2; ++i) { int R, C; stage_rc(tid * 16 + i * 8192, R, C); const int Rb = Epi::PERM ? ((R & ~31) + perm32(R & 31)) : R;
        voffA[i] = (unsigned)(R * K + C) * 2u; voffB[i] = (unsigned)(Rb * K + C) * 2u; }
    const size_t kstep = (size_t)(BK * 2);
    const size_t hstep = (size_t)HALF * K * 2;
    const size_t tstep = 2 * hstep;
    const unsigned ldsw = (unsigned)wid * 1024u;
    const int aoff = lds_byte(wr * 64 + fr, fq * 8), boff = lds_byte(wc * 32 + fr, fq * 8);
#define PG8_SA(b, h) (((b) * 2 + (h)) * HTB)
#define PG8_SB(b, h) ((4 + (b) * 2 + (h)) * HTB)
#define PG8_STAGE(bufoff, gbase, voff) do { _Pragma("unroll") for (int _i = 0; _i < 2; ++_i) \
        __builtin_amdgcn_global_load_lds((const unsigned*)((const char*)(gbase) + (voff)[_i]), (PG8_LAS unsigned*)(lds + (bufoff) + ldsw + _i * 8192), 16, 0, 0); } while (0)
#define PG8_LDA(dst, b, h) do { _Pragma("unroll") for (int m = 0; m < 4; ++m) _Pragma("unroll") for (int k = 0; k < 2; ++k) dst[m][k] = *(const PG8_LAS bf16x8*)(lds + PG8_SA(b, h) + aoff + m * 2048 + k * 1024); } while (0)
#define PG8_LDB(dst, b, h) do { _Pragma("unroll") for (int n = 0; n < 2; ++n) _Pragma("unroll") for (int k = 0; k < 2; ++k) dst[n][k] = *(const PG8_LAS bf16x8*)(lds + PG8_SB(b, h) + boff + n * 2048 + k * 1024); } while (0)
#define PG8_MMA(ai, bj, At, Bt) do { __builtin_amdgcn_s_setprio(1); _Pragma("unroll") for (int m = 0; m < 4; ++m) _Pragma("unroll") for (int n = 0; n < 2; ++n) _Pragma("unroll") for (int k = 0; k < 2; ++k) \
        acc[ai][bj][m][n] = __builtin_amdgcn_mfma_f32_16x16x32_bf16(Bt[n][k], At[m][k], acc[ai][bj][m][n], 0, 0, 0); __builtin_amdgcn_s_setprio(0); } while (0)
#define PG8_WAIT_V(n) asm volatile("s_waitcnt vmcnt(" #n ")" ::: "memory")
#define PG8_WAIT_L(n) asm volatile("s_waitcnt lgkmcnt(" #n ")" ::: "memory")
#define PG8_BAR __builtin_amdgcn_s_barrier()
#define PG8_SCHED __builtin_amdgcn_sched_barrier(0)
    Unit cur, nxt; int ui = 0;
    if (!S.next(0, cur)) return;
    f32x4 acc[2][2][4][2];
#pragma unroll
    for (int a = 0; a < 2; ++a)
#pragma unroll
        for (int b = 0; b < 2; ++b)
#pragma unroll
            for (int m = 0; m < 4; ++m)
#pragma unroll
                for (int n = 0; n < 2; ++n) acc[a][b][m][n] = (f32x4){0.f, 0.f, 0.f, 0.f};
    bf16x8 At[4][2], B0[2][2], B1[2][2];
    const char* cA = (const char*)g.A + (size_t)cur.pm * tstep; const char* cB = (const char*)g.Bt + (size_t)cur.be * g.bstride + (size_t)cur.pn * tstep;
    S.a_ready(cur);
    if constexpr (SP2) {
        PG8_STAGE(PG8_SB(0, 0), cB, voffB); PG8_STAGE(PG8_SB(0, 1), cB + hstep, voffB); PG8_STAGE(PG8_SA(0, 0), cA, voffA); PG8_STAGE(PG8_SA(0, 1), cA + hstep, voffA);
        if (wr == 1) PG8_BAR;
        PG8_WAIT_V(2); PG8_BAR;
        PG8_STAGE(PG8_SB(1, 0), cB + kstep, voffB); PG8_STAGE(PG8_SA(1, 0), cA + kstep, voffA); PG8_STAGE(PG8_SB(1, 1), cB + hstep + kstep, voffB);
        PG8_WAIT_V(6); PG8_BAR;
    } else {
        PG8_STAGE(PG8_SB(0, 0), cB, voffB); PG8_STAGE(PG8_SA(0, 0), cA, voffA); PG8_STAGE(PG8_SB(0, 1), cB + hstep, voffB); PG8_STAGE(PG8_SA(0, 1), cA + hstep, voffA);
        if (wr == 1) PG8_BAR;
        PG8_WAIT_V(4); PG8_BAR;
        PG8_STAGE(PG8_SB(1, 0), cB + kstep, voffB); PG8_STAGE(PG8_SA(1, 0), cA + kstep, voffA); PG8_STAGE(PG8_SB(1, 1), cB + hstep + kstep, voffB);
        PG8_WAIT_V(6); PG8_BAR;
    }
    for (;;) {
        const bool has_next = S.next(ui + 1, nxt);
        const char* nA = has_next ? (const char*)g.A + (size_t)nxt.pm * tstep : cA; const char* nB = has_next ? (const char*)g.Bt + (size_t)nxt.be * g.bstride + (size_t)nxt.pn * tstep : cB;
        for (int t = 0; t < nt; t += 2) {
            const bool last = (t == nt - 2);
            const char* a1 = cA + (size_t)(t + 1) * kstep;
            const char* a2 = last ? nA : cA + (size_t)(t + 2) * kstep; const char* b2 = last ? nB : cB + (size_t)(t + 2) * kstep;
            const char* a3 = a2 + kstep; const char* b3 = b2 + kstep;
            if (last && has_next) S.a_ready(nxt);
            if constexpr (SP2) {
            PG8_LDB(B0, 0, 0); PG8_LDB(B1, 0, 1); PG8_SCHED; PG8_LDA(At, 0, 0); PG8_STAGE(PG8_SA(1, 1), a1 + hstep, voffA);
            PG8_WAIT_V(8); PG8_WAIT_L(0); PG8_BAR; PG8_MMA(0, 0, At, B0); PG8_MMA(0, 1, At, B1); PG8_BAR; PG8_SCHED;
            PG8_LDA(At, 0, 1); PG8_STAGE(PG8_SB(0, 0), b2, voffB); PG8_STAGE(PG8_SB(0, 1), b2 + hstep, voffB); PG8_STAGE(PG8_SA(0, 0), a2, voffA);
            PG8_WAIT_V(8); PG8_WAIT_L(0); PG8_BAR; PG8_MMA(1, 0, At, B0); PG8_MMA(1, 1, At, B1); PG8_BAR; PG8_SCHED;
            PG8_LDB(B0, 1, 0); PG8_LDB(B1, 1, 1); PG8_SCHED; PG8_LDA(At, 1, 0); PG8_STAGE(PG8_SA(0, 1), a2 + hstep, voffA);
            PG8_WAIT_V(8); PG8_WAIT_L(0); PG8_BAR; PG8_MMA(0, 0, At, B0); PG8_MMA(0, 1, At, B1); PG8_BAR; PG8_SCHED;
            PG8_LDA(At, 1, 1); PG8_STAGE(PG8_SB(1, 0), b3, voffB); PG8_STAGE(PG8_SB(1, 1), b3 + hstep, voffB); PG8_STAGE(PG8_SA(1, 0), a3, voffA);
            PG8_WAIT_V(8); PG8_WAIT_L(0); PG8_BAR; PG8_MMA(1, 0, At, B0); PG8_MMA(1, 1, At, B1); PG8_BAR; PG8_SCHED;
            } else {
            PG8_LDB(B0, 0, 0); PG8_SCHED; PG8_LDA(At, 0, 0); PG8_STAGE(PG8_SA(1, 1), a1 + hstep, voffA);
            PG8_WAIT_L(8); PG8_BAR; PG8_WAIT_L(0); PG8_MMA(0, 0, At, B0); PG8_BAR; PG8_SCHED;
            PG8_LDB(B1, 0, 1); PG8_STAGE(PG8_SB(0, 0), b2, voffB);
            PG8_BAR; PG8_WAIT_L(0); PG8_MMA(0, 1, At, B1); PG8_BAR;
            PG8_LDA(At, 0, 1); PG8_STAGE(PG8_SA(0, 0), a2, voffA);
            PG8_BAR; PG8_WAIT_L(0); PG8_MMA(1, 0, At, B0); PG8_BAR; PG8_SCHED;
            PG8_STAGE(PG8_SB(0, 1), b2 + hstep, voffB);
            PG8_WAIT_V(6); PG8_BAR; PG8_MMA(1, 1, At, B1); PG8_BAR;
            PG8_LDB(B0, 1, 0); PG8_SCHED; PG8_LDA(At, 1, 0); PG8_STAGE(PG8_SA(0, 1), a2 + hstep, voffA);
            PG8_WAIT_L(8); PG8_BAR; PG8_WAIT_L(0); PG8_MMA(0, 0, At, B0); PG8_BAR; PG8_SCHED;
            PG8_LDB(B1, 1, 1); PG8_STAGE(PG8_SB(1, 0), b3, voffB);
            PG8_BAR; PG8_WAIT_L(0); PG8_MMA(0, 1, At, B1); PG8_BAR;
            PG8_LDA(At, 1, 1); PG8_STAGE(PG8_SA(1, 0), a3, voffA);
            PG8_BAR; PG8_WAIT_L(0); PG8_MMA(1, 0, At, B0); PG8_BAR; PG8_SCHED;
            PG8_STAGE(PG8_SB(1, 1), b3 + hstep, voffB);
            PG8_WAIT_V(6); PG8_BAR; PG8_MMA(1, 1, At, B1); PG8_BAR;
            }
        }
        if constexpr (ALIGN_EPI) { if (wr == 0) PG8_BAR; }
        if constexpr (!Epi::AFTER_DRAIN) { E(acc, cur, wr, wc, fr, fq); S.done(cur); }
        if (!has_next) break;
#pragma unroll
        for (int a = 0; a < 2; ++a)
#pragma unroll
            for (int b = 0; b < 2; ++b)
#pragma unroll
                for (int m = 0; m < 4; ++m)
#pragma unroll
                    for (int n = 0; n < 2; ++n) acc[a][b][m][n] = (f32x4){0.f, 0.f, 0.f, 0.f};
        cur = nxt; cA = nA; cB = nB; ++ui;
        if constexpr (ALIGN_EPI) { if (wr == 1) PG8_BAR; }
    }
    PG8_WAIT_V(0);
    if constexpr (!ALIGN_EPI) { if (wr == 0) PG8_BAR; }
    PG8_BAR;
    if constexpr (Epi::AFTER_DRAIN) { E.fused(acc, cur, wr, wc, fr, fq, lds, wid, lane); S.done(cur); }
#undef PG8_SA
#undef PG8_SB
#undef PG8_STAGE
#undef PG8_LDA
#undef PG8_LDB
#undef PG8_MMA
#undef PG8_WAIT_V
#undef PG8_WAIT_L
#undef PG8_BAR
#undef PG8_SCHED
}
}

#ifndef PG8_SP2
#define PG8_SP2 true
#endif
#include <hip/hip_bf16.h>
#include <cmath>
namespace attn_body {
using bf16=__hip_bfloat16;
using bf16x8=__attribute__((ext_vector_type(8)))short;
using s16x4=__attribute__((ext_vector_type(4)))short;
using f32x16=__attribute__((ext_vector_type(16)))float;
using u32x4=__attribute__((ext_vector_type(4)))unsigned;
constexpr int BATCH=2,NHEAD=16,SEQ=16384,D=64,DM=2048;
constexpr int NW=8,QBLK=32,QB=QBLK*NW,KVBLK=64,NQB=SEQ/QB;
constexpr int ATTN_PITCH=DM, ATTN_UNIT_ROWS=QB;
__device__ __forceinline__ int crow(int r,int hi){return (r&3)+8*(r>>2)+4*hi;}
#define SBAR() __builtin_amdgcn_sched_barrier(0)
__device__ __forceinline__ void cmask(f32x16&p0,f32x16&p1,int jb,int qrel,int hi){
  const float NEG=-INFINITY; int kb=64*jb+4*hi;
  #pragma unroll
  for(int r=0;r<16;++r){int kv=kb+(r&3)+8*(r>>2); if(kv>qrel)p0[r]=NEG; if(kv+32>qrel)p1[r]=NEG;}
}

constexpr int NSLOT=3, SLOTB=8192;
constexpr int LDS_K=0, LDS_V=NSLOT*SLOTB, LDS_WS=2*NSLOT*SLOTB, LDS_OST=LDS_WS+NW*64*4, LDS_BYTES=LDS_OST+NW*4096;
constexpr float C2=0.125f*1.4426950408889634f;
__device__ __forceinline__ void glds16(const void*gsrc,unsigned lds_dst){unsigned keep;
  asm volatile("s_mov_b32 %0, m0\n\ts_mov_b32 m0, %2\n\ts_nop 0\n\tglobal_load_lds_dwordx4 %1, off\n\ts_mov_b32 m0, %0":"=&s"(keep):"v"(gsrc),"s"(lds_dst):"memory");}
__device__ __forceinline__ float max3f(float a,float b,float c){float r;asm("v_max3_f32 %0, %1, %2, %3":"=v"(r):"v"(a),"v"(b),"v"(c));return r;}
__device__ __forceinline__ float max2f(float a,float b){float r;asm("v_max_f32_e32 %0, %1, %2":"=v"(r):"v"(a),"v"(b));return r;}
__device__ __forceinline__ float fadd_s(float a,float b){float r;asm("v_add_f32_e32 %0, %1, %2":"=v"(r):"v"(a),"v"(b));return r;}
__device__ __forceinline__ float fsub_s(float a,float b){float r;asm("v_sub_f32_e32 %0, %1, %2":"=v"(r):"v"(a),"v"(b));return r;}
typedef float f32x2_t __attribute__((ext_vector_type(2))); typedef __bf16 bf16x2_t __attribute__((ext_vector_type(2)));
__device__ __forceinline__ unsigned cvtpk_s(float lo,float hi){f32x2_t v={lo,hi};bf16x2_t b=__builtin_convertvector(v,bf16x2_t);return __builtin_bit_cast(unsigned,b);}
#define WAIT_BAR(N) asm volatile("s_waitcnt vmcnt(" #N ") lgkmcnt(0)\n\ts_barrier":::"memory")

__device__ __forceinline__ void qkt(f32x16&p0,f32x16&p1,const char*Kslot,const bf16x8*qr,const f32x16&negm,int r32,int hi){
  const char*kb=Kslot+hi*1024+r32*16;
  #pragma unroll
  for(int d0=0;d0<4;++d0){
    const bf16x8 b0=*reinterpret_cast<const bf16x8*>(kb+d0*2048);
    const bf16x8 b1=*reinterpret_cast<const bf16x8*>(kb+d0*2048+512);
    if(d0==0){p0=__builtin_amdgcn_mfma_f32_32x32x16_bf16(b0,qr[0],negm,0,0,0);p1=__builtin_amdgcn_mfma_f32_32x32x16_bf16(b1,qr[0],negm,0,0,0);}
    else{p0=__builtin_amdgcn_mfma_f32_32x32x16_bf16(b0,qr[d0],p0,0,0,0);p1=__builtin_amdgcn_mfma_f32_32x32x16_bf16(b1,qr[d0],p1,0,0,0);}}
}
typedef __attribute__((address_space(3))) const char* lds_cptr;
typedef short v4i16_t __attribute__((ext_vector_type(4)));
__device__ __forceinline__ void kload8(bf16x8*kf,lds_cptr kp){
  kf[0]=*(const __attribute__((address_space(3))) bf16x8*)(kp);      kf[1]=*(const __attribute__((address_space(3))) bf16x8*)(kp+512);
  kf[2]=*(const __attribute__((address_space(3))) bf16x8*)(kp+2048); kf[3]=*(const __attribute__((address_space(3))) bf16x8*)(kp+2560);
  kf[4]=*(const __attribute__((address_space(3))) bf16x8*)(kp+4096); kf[5]=*(const __attribute__((address_space(3))) bf16x8*)(kp+4608);
  kf[6]=*(const __attribute__((address_space(3))) bf16x8*)(kp+6144); kf[7]=*(const __attribute__((address_space(3))) bf16x8*)(kp+6656);
}
__device__ __forceinline__ void kload2(bf16x8*kf,lds_cptr kp,int j){ kf[2*j]=*(const __attribute__((address_space(3))) bf16x8*)(kp+j*2048); kf[2*j+1]=*(const __attribute__((address_space(3))) bf16x8*)(kp+j*2048+512); }
__device__ __forceinline__ s16x4 vtr(lds_cptr p){ return __builtin_bit_cast(s16x4,__builtin_amdgcn_ds_read_tr16_b64_v4i16((__attribute__((address_space(3))) v4i16_t*)p)); }
__device__ __forceinline__ float rowmax(const f32x16&p0,const f32x16&p1){
  float a=max3f(p0[0],p0[1],p1[0]),b=max3f(p0[2],p0[3],p1[1]);a=max3f(a,p1[2],p1[3]);
  #pragma unroll
  for(int r=4;r<16;r+=4){a=max3f(a,p0[r],p0[r+1]);b=max3f(b,p0[r+2],p0[r+3]);a=max3f(a,p1[r],p1[r+1]);b=max3f(b,p1[r+2],p1[r+3]);}
  const float m=max2f(a,b);
  auto rr=__builtin_amdgcn_permlane32_swap(__float_as_uint(m),__float_as_uint(m),false,false);
  return max2f(__uint_as_float(rr[0]),__uint_as_float(rr[1]));
}
__device__ __forceinline__ void pv(f32x16*o,int vb,bf16x8 pa0,bf16x8 pa1,bf16x8 pa2,bf16x8 pa3){
  #pragma unroll
  for(int d0=0;d0<2;++d0){s16x4 lo[4],hi[4];
    #pragma unroll
    for(int ks=0;ks<4;++ks){
      asm volatile("ds_read_b64_tr_b16 %0,%1 offset:%c2":"=&v"(lo[ks]):"v"(vb),"i"(d0*4096+ks*1024):"memory");
      asm volatile("ds_read_b64_tr_b16 %0,%1 offset:%c2":"=&v"(hi[ks]):"v"(vb),"i"(d0*4096+ks*1024+512):"memory");}
    asm volatile("s_waitcnt lgkmcnt(0)":::"memory");SBAR();
    #define PK(k) (bf16x8){lo[k][0],lo[k][1],lo[k][2],lo[k][3],hi[k][0],hi[k][1],hi[k][2],hi[k][3]}
    o[d0]=__builtin_amdgcn_mfma_f32_32x32x16_bf16(pa0,PK(0),o[d0],0,0,0);
    o[d0]=__builtin_amdgcn_mfma_f32_32x32x16_bf16(pa1,PK(1),o[d0],0,0,0);
    o[d0]=__builtin_amdgcn_mfma_f32_32x32x16_bf16(pa2,PK(2),o[d0],0,0,0);
    o[d0]=__builtin_amdgcn_mfma_f32_32x32x16_bf16(pa3,PK(3),o[d0],0,0,0);
    #undef PK
  }
}

#ifndef ATTN_STORE16
#define ATTN_STORE16(p,v) (*(u32x4*)(p)=(v))
#endif
template<int THRL> __device__ __forceinline__ void attn_unit(int b,int h,int qb,const bf16*Q,const bf16*__restrict__ K,const bf16*__restrict__ V,bf16*O,char*shm){
  const int tid=threadIdx.x,lane=tid&63,r32=lane&31,hi=lane>>5; const int wid=__builtin_amdgcn_readfirstlane(tid>>6);
  const long rowbase=(long)b*SEQ; const int q0=qb*QB;
  const bf16*Qw=Q+(rowbase+q0+wid*QBLK)*DM+h*D;
  const bf16*Kh=K+rowbase*DM+h*D,*Vh=V+rowbase*DM+h*D;
  const unsigned lds0=(unsigned)(uintptr_t)shm;
  float*wsf=(float*)(shm+LDS_WS)+wid*64;
  const bf16*ksrc=Kh+(long)lane*DM+wid*8;
  const bf16*vsrc=Vh+(long)(16*(wid&3)+(lane>>2))*DM+(wid>>2)*32+(lane&3)*8;
  const unsigned kdst=lds0+LDS_K+wid*1024, vdst=lds0+LDS_V+wid*1024;
  #define DMA_K(t,slot) glds16(ksrc+(long)(t)*KVBLK*DM,(unsigned)__builtin_amdgcn_readfirstlane(kdst+(slot)))
  #define DMA_V(t,slot) glds16(vsrc+(long)(t)*KVBLK*DM,(unsigned)__builtin_amdgcn_readfirstlane(vdst+(slot)))
  const int vb0=(int)(lds0+LDS_V)+((lane>>4)&1)*32+(lane&3)*8+(4*hi+((lane&15)>>2))*64;
  const char*Kbase=shm+LDS_K; bf16x8 kf[8];
  const lds_cptr shm3=(lds_cptr)shm; const lds_cptr kp0=shm3+LDS_K+hi*1024+r32*16; const lds_cptr vp0=shm3+LDS_V+((lane>>4)&1)*32+(lane&3)*8+(4*hi+((lane&15)>>2))*64;
  const int NT=(q0+QB)/KVBLK;
  DMA_K(0,0);DMA_V(0,0);DMA_K(1,SLOTB);
  bf16x8 qr[4];
  #pragma unroll
  for(int d0=0;d0<4;++d0)qr[d0]=*reinterpret_cast<const bf16x8*>(&Qw[(long)r32*DM+d0*16+hi*8]);
  float mhat=0.f,l_reg=0.f;f32x16 o[2];o[0]=f32x16{};o[1]=f32x16{};f32x16 negm=f32x16{};asm volatile("":"+v"(negm));
  const int qrel=wid*QBLK+r32;
  #define CMASK(P0,P1,t) do{int jb_=(t)-(NT-4); if(jb_>=0)cmask(P0,P1,jb_,qrel,hi);}while(0)
  bool resc=false;
  #define START(P0,P1) do{ const float rm=rowmax(P0,P1); resc=false; \
    { const float dl=rm; mhat=fadd_s(mhat,dl); \
      _Pragma("unroll") for(int r=0;r<16;++r){P0[r]=fsub_s(P0[r],dl);P1[r]=fsub_s(P1[r],dl);} \
      _Pragma("unroll") for(int r=0;r<16;++r)negm[r]=-mhat; asm volatile("":"+v"(negm)); } \
    _Pragma("unroll") for(int r=0;r<16;++r)P0[r]=__builtin_amdgcn_exp2f(P0[r]); }while(0)
  #define RESC() do{ if(resc){ asm volatile("s_waitcnt lgkmcnt(0)":::"memory"); \
      _Pragma("unroll") for(int d_=0;d_<2;++d_) _Pragma("unroll") for(int r=0;r<16;++r)o[d_][r]*=wsf[crow(r,hi)]; } }while(0)
  f32x16 pA0,pA1,pB0,pB1;
  int sl_prev=0,sl_cur=0,sl_next=SLOTB;
  #define ROT() do{sl_prev=sl_cur;sl_cur=sl_next;sl_next=(sl_next==(NSLOT-1)*SLOTB)?0:sl_next+SLOTB;}while(0)
  DMA_K(2,2*SLOTB);
  WAIT_BAR(3);
  qkt(pA0,pA1,Kbase,qr,negm,r32,hi);asm volatile("s_nop 15\n\ts_nop 7":"+v"(pA0),"+v"(pA1));CMASK(pA0,pA1,0);
  START(pA0,pA1);
  _Pragma("unroll") for(int r=0;r<16;++r)pA1[r]=__builtin_amdgcn_exp2f(pA1[r]);
  WAIT_BAR(0);
  DMA_K(3,0);DMA_V(1,SLOTB);
  ROT();
  kload8(kf,kp0+sl_cur);
  WAIT_BAR(2);
  s16x4 vlo[8],vhi[8]; u32x4 pw0,pw1,pw2,pw3;
  #define PKW(P,B) cvtpk_s(P[B],P[B+1])
  #define PAF(k) __builtin_bit_cast(bf16x8,pw##k)
  #define VFR(i) (bf16x8){vlo[i][0],vlo[i][1],vlo[i][2],vlo[i][3],vhi[i][0],vhi[i][1],vhi[i][2],vhi[i][3]}
  #define PIN(x) asm volatile("":"+v"(x))
  #define MX3(a,b,c) __builtin_fmaxf(__builtin_fmaxf((a),(b)),(c))
  #define GAPA(MF,A0,A1,A2,A3,W0,W1,PW) do{ MF; sacc+=A0; sacc+=A1; sacc+=A2; sacc+=A3; PIN(sacc); W0; W1; PIN(PW); SBAR(); }while(0)
  #define EX(v) __builtin_amdgcn_exp2f(v)
  #define GAPB(MF,X,B) do{ MF; X[B]=EX(X[B]); X[B+1]=EX(X[B+1]); X[B+2]=EX(X[B+2]); X[B+3]=EX(X[B+3]); PIN(X); SBAR(); }while(0)
  #define VRD(i) do{ vlo[i]=vtr(vp_+(((i)>>2)*4096+((i)&3)*1024)); vhi[i]=vtr(vp_+(((i)>>2)*4096+((i)&3)*1024+512)); }while(0)
  #define KRD(G,j) do{ if(G){ kload2(kf,kp0+sl_next,j); SBAR(); } }while(0)
  #define STEP(C0,C1,P0,P1,t,GK,GV,GL) do{ SBAR(); \
    const lds_cptr vp_=vp0+sl_prev; \
    VRD(0); SBAR(); float sacc=(P0[0]+P0[1]); \
    GAPA(C0=__builtin_amdgcn_mfma_f32_32x32x16_bf16(kf[0],qr[0],negm,0,0,0), P0[2],P0[3],P0[4],P0[5],     pw0[0]=PKW(P0,0), pw0[1]=PKW(P0,2), pw0); \
    VRD(4); SBAR(); GAPA(C1=__builtin_amdgcn_mfma_f32_32x32x16_bf16(kf[1],qr[0],negm,0,0,0), P0[6],P0[7],P0[8],P0[9],     pw0[2]=PKW(P0,4), pw0[3]=PKW(P0,6), pw0); \
    VRD(1); SBAR(); GAPA(C0=__builtin_amdgcn_mfma_f32_32x32x16_bf16(kf[2],qr[1],C0,0,0,0),   P0[10],P0[11],P0[12],P0[13], pw1[0]=PKW(P0,8), pw1[1]=PKW(P0,10), pw1); \
    VRD(5); SBAR(); GAPA(C1=__builtin_amdgcn_mfma_f32_32x32x16_bf16(kf[3],qr[1],C1,0,0,0),   P0[14],P0[15],P1[0],P1[1],   pw1[2]=PKW(P0,12),pw1[3]=PKW(P0,14), pw1); \
    VRD(2); SBAR(); GAPA(C0=__builtin_amdgcn_mfma_f32_32x32x16_bf16(kf[4],qr[2],C0,0,0,0),   P1[2],P1[3],P1[4],P1[5],     pw2[0]=PKW(P1,0), pw2[1]=PKW(P1,2), pw2); \
    VRD(6); SBAR(); GAPA(C1=__builtin_amdgcn_mfma_f32_32x32x16_bf16(kf[5],qr[2],C1,0,0,0),   P1[6],P1[7],P1[8],P1[9],     pw2[2]=PKW(P1,4), pw2[3]=PKW(P1,6), pw2); \
    VRD(3); SBAR(); GAPA(C0=__builtin_amdgcn_mfma_f32_32x32x16_bf16(kf[6],qr[3],C0,0,0,0),   P1[10],P1[11],P1[12],P1[13], pw3[0]=PKW(P1,8), pw3[1]=PKW(P1,10), pw3); \
    VRD(7); SBAR(); GAPA(C1=__builtin_amdgcn_mfma_f32_32x32x16_bf16(kf[7],qr[3],C1,0,0,0),   P1[14],P1[15],0.f,0.f,       pw3[2]=PKW(P1,12),pw3[3]=PKW(P1,14), pw3); \
    l_reg+=sacc; \
    if(GK){DMA_K((t)+3,sl_cur);} if(GV){DMA_V((t)+1,sl_next);} \
    CMASK(C0,C1,t); \
    { float a=MX3(C0[0],C0[1],C1[0]),b=MX3(C0[2],C0[3],C1[1]); a=MX3(a,C1[2],C1[3]); \
      _Pragma("unroll") for(int r=4;r<16;r+=4){a=MX3(a,C0[r],C0[r+1]);b=MX3(b,C0[r+2],C0[r+3]);a=MX3(a,C1[r],C1[r+1]);b=MX3(b,C1[r+2],C1[r+3]);} \
      float rm=__builtin_fmaxf(a,b); { auto rr=__builtin_amdgcn_permlane32_swap(__float_as_uint(rm),__float_as_uint(rm),false,false); rm=__builtin_fmaxf(__uint_as_float(rr[0]),__uint_as_float(rr[1])); } \
      resc=false; \
      if(__builtin_expect(__any(rm>(float)THRL),0)){ const float dl=__builtin_fmaxf(rm,0.f); mhat+=dl; \
        _Pragma("unroll") for(int r=0;r<16;++r){C0[r]-=dl;C1[r]-=dl;} \
        _Pragma("unroll") for(int r=0;r<16;++r)negm[r]=-mhat; asm volatile("":"+v"(negm)); \
        const float f=__builtin_amdgcn_exp2f(-dl); l_reg*=f; if(hi==0)wsf[r32]=f; resc=true; } } \
    SBAR(); \
    GAPB(o[0]=__builtin_amdgcn_mfma_f32_32x32x16_bf16(PAF(0),VFR(0),o[0],0,0,0), C0,0); \
    GAPB(o[1]=__builtin_amdgcn_mfma_f32_32x32x16_bf16(PAF(0),VFR(4),o[1],0,0,0), C0,4); \
    KRD(GL,0); GAPB(o[0]=__builtin_amdgcn_mfma_f32_32x32x16_bf16(PAF(1),VFR(1),o[0],0,0,0), C0,8); \
    KRD(GL,1); GAPB(o[1]=__builtin_amdgcn_mfma_f32_32x32x16_bf16(PAF(1),VFR(5),o[1],0,0,0), C0,12); \
    KRD(GL,2); GAPB(o[0]=__builtin_amdgcn_mfma_f32_32x32x16_bf16(PAF(2),VFR(2),o[0],0,0,0), C1,0); \
    KRD(GL,3); GAPB(o[1]=__builtin_amdgcn_mfma_f32_32x32x16_bf16(PAF(2),VFR(6),o[1],0,0,0), C1,4); \
    GAPB(o[0]=__builtin_amdgcn_mfma_f32_32x32x16_bf16(PAF(3),VFR(3),o[0],0,0,0), C1,8); \
    GAPB(o[1]=__builtin_amdgcn_mfma_f32_32x32x16_bf16(PAF(3),VFR(7),o[1],0,0,0), C1,12); \
    }while(0)
  int t=1;
  #undef CMASK
  #define CMASK(P0,P1,t) do{}while(0)
  for(;t+5<NT;t+=2){
    STEP(pB0,pB1,pA0,pA1,t,true,true,true);     WAIT_BAR(2); RESC(); ROT();
    STEP(pA0,pA1,pB0,pB1,t+1,true,true,true);   WAIT_BAR(2); RESC(); ROT();
  }
  #undef CMASK
  #define CMASK(P0,P1,t) do{int jb_=(t)-(NT-4); if(jb_>=0)cmask(P0,P1,jb_,qrel,hi);}while(0)
  #define ENDW(tt) do{ if((tt)+3<NT){WAIT_BAR(2);} else if((tt)+2<NT){WAIT_BAR(1);} else {WAIT_BAR(0);} }while(0)
  for(;t+1<NT;t+=2){
    STEP(pB0,pB1,pA0,pA1,t,(t+3<NT),(t+1<NT),(t+1<NT));       ENDW(t);   RESC(); ROT();
    STEP(pA0,pA1,pB0,pB1,t+1,(t+4<NT),(t+2<NT),(t+2<NT));     ENDW(t+1); RESC(); ROT();
  }
  STEP(pB0,pB1,pA0,pA1,NT-1,false,false,false); RESC();
  { float sacc=pB0[0]+pB0[1]; _Pragma("unroll") for(int r=2;r<16;++r)sacc+=pB0[r]; _Pragma("unroll") for(int r=0;r<16;++r)sacc+=pB1[r]; l_reg+=sacc;
    pw0=(u32x4){PKW(pB0,0),PKW(pB0,2),PKW(pB0,4),PKW(pB0,6)};pw1=(u32x4){PKW(pB0,8),PKW(pB0,10),PKW(pB0,12),PKW(pB0,14)};pw2=(u32x4){PKW(pB1,0),PKW(pB1,2),PKW(pB1,4),PKW(pB1,6)};pw3=(u32x4){PKW(pB1,8),PKW(pB1,10),PKW(pB1,12),PKW(pB1,14)};
    SBAR(); pv(o,vb0+sl_cur,PAF(0),PAF(1),PAF(2),PAF(3)); }
  #undef PKW
  #undef PAF
  #undef VFR
  #undef PIN
  #undef MX3
  #undef GAPA
  #undef GAPB
  #undef EX
  #undef VRD
  #undef KRD
  #undef STEP
  #undef ENDW
  {auto rr=__builtin_amdgcn_permlane32_swap(__float_as_uint(l_reg),__float_as_uint(l_reg),false,false);l_reg=__uint_as_float(rr[0])+__uint_as_float(rr[1]);}
  if(hi==0)wsf[32+r32]=l_reg;asm volatile("s_waitcnt lgkmcnt(0)":::"memory");
  float rli[16];
  #pragma unroll
  for(int r=0;r<16;++r)rli[r]=__builtin_amdgcn_rcpf(wsf[32+crow(r,hi)]);
  bf16*Ow=O+(rowbase+q0+wid*QBLK)*DM+h*D;
  { bf16*stg=(bf16*)(shm+LDS_OST)+wid*2048;
    #pragma unroll
    for(int r=0;r<16;++r){const int orow=crow(r,hi);
      #pragma unroll
      for(int d0=0;d0<2;++d0)stg[orow*64+d0*32+r32]=__float2bfloat16(o[d0][r]*rli[r]);}
    asm volatile("s_waitcnt lgkmcnt(0)":::"memory");
    #pragma unroll
    for(int i=0;i<4;++i){const int row=i*8+(lane>>3),ch=lane&7; const u32x4 v=*(const u32x4*)(stg+row*64+ch*8); ATTN_STORE16(Ow+(long)row*DM+ch*8,v);} }
  asm volatile("s_waitcnt lgkmcnt(0)\n\ts_barrier":::"memory");
  #undef DMA_K
  #undef DMA_V
  #undef CMASK
  #undef START
  #undef RESC
  #undef ROT
}
constexpr int ATTN_LDS_BYTES=LDS_BYTES;
struct AttnUnit { int b, h, c, vh, qb; };
struct DiffOrder {
  int vcu;
  __device__ __forceinline__ explicit DiffOrder(int v):vcu(v){}
  __device__ __forceinline__ bool next(int i,AttnUnit&u)const{ if(i>=32)return false; const int r=i>>3,k=i&7,x=vcu>>5,loc=vcu&31,sl=loc>>3,j=loc&7; const int bh=r*8+x;
    u.b=bh>>4; u.h=bh&15; u.c=sl>>1; u.vh=sl&1; const int pair=j+8*(k>>1); u.qb=(k&1)?63-pair:pair; return true; }
};
#undef SBAR
#undef WAIT_BAR
}
#define GAS __attribute__((address_space(1)))
#define LAS __attribute__((address_space(3)))
typedef unsigned short bf16;
typedef unsigned v4u __attribute__((ext_vector_type(4)));
typedef float f32x4 __attribute__((ext_vector_type(4)));
typedef short bf16x8 __attribute__((ext_vector_type(8)));
typedef GAS unsigned gu32;
typedef GAS unsigned long long gu64;
#define RLX_AGENT __ATOMIC_RELAXED, __HIP_MEMORY_SCOPE_AGENT
#define LDS_WAIT() asm volatile("s_waitcnt lgkmcnt(0)" ::: "memory")
#define VM_WAIT() asm volatile("s_waitcnt vmcnt(0)" ::: "memory")
__device__ __forceinline__ unsigned long long rt() { return __builtin_amdgcn_s_memrealtime(); }
__device__ __forceinline__ unsigned f2bf(float f) { unsigned u = __builtin_bit_cast(unsigned, f); return (u + 0x7fffu + ((u >> 16) & 1u)) >> 16; }
__device__ __forceinline__ unsigned pk2(float lo, float hi) { return f2bf(lo) | (f2bf(hi) << 16); }

#define XB_TMO      128
#define XB_XCNT(j)  (256  + 64 * (j))
#define XB_XSUB(j)  (1280 + 64 * (j))
#define XB_XGEN(j)  (2304 + 64 * (j))
#define XB_TOP      3328
#define XB_TOPGEN   3392
#define XCD_BAR_WORDS 3456
#define XB_SPIN_CAP (1u << 18)

__device__ __forceinline__ unsigned xb_ld(unsigned* p)              { return __hip_atomic_load(p, __ATOMIC_RELAXED, __HIP_MEMORY_SCOPE_AGENT); }
__device__ __forceinline__ unsigned xb_add(unsigned* p, unsigned v) { return __hip_atomic_fetch_add(p, v, __ATOMIC_RELAXED, __HIP_MEMORY_SCOPE_AGENT); }
__device__ __forceinline__ unsigned xb_xcc_id() { return (unsigned)__builtin_amdgcn_s_getreg((3 << 11) | 20) & 0xFu; }
#define XB_SPIN(cond, bar) do { unsigned _sp = 0; while (cond) { __builtin_amdgcn_s_sleep(1); \
    if ((++_sp & 255u) == 0u) { if (xb_ld(&(bar)[XB_TMO])) break; if (_sp > XB_SPIN_CAP) { atomicAdd(&(bar)[XB_TMO], 1u); break; } } } } while (0)

struct XcdBarrier {
    unsigned* bar; unsigned x;
    volatile LAS unsigned* st;
};

__device__ __forceinline__ XcdBarrier xcd_barrier_post(unsigned* bar, volatile LAS unsigned* st) {
    XcdBarrier b; b.bar = bar; b.x = xb_xcc_id(); b.st = st;
    if (threadIdx.x == 0) (void)xb_add(&bar[XB_XCNT(b.x)], 1u);
    return b;
}
__device__ __forceinline__ void xcd_barrier_complete(unsigned* bar, unsigned x, unsigned& nloc, unsigned& nx) {
    const unsigned G = gridDim.x * gridDim.y * gridDim.z;
    unsigned sum, cnt, mine, sp = 0u;
    for (;;) {
        sum = 0u; cnt = 0u; mine = 0u;
#pragma unroll
        for (unsigned j = 0; j < 16; ++j) { const unsigned c = xb_ld(&bar[XB_XCNT(j)]); sum += c; cnt += (c > 0u) ? 1u : 0u; mine = (j == x) ? c : mine; }
        if (sum == G) break;
        __builtin_amdgcn_s_sleep(1);
        if ((++sp & 255u) == 0u) { if (xb_ld(&bar[XB_TMO])) break; if (sp > XB_SPIN_CAP) { atomicAdd(&bar[XB_TMO], 1u); break; } }
    }
    nloc = mine > 0u ? mine : 1u; nx = cnt > 0u ? cnt : 1u;
}

__device__ __forceinline__ void xcd_barrier(const XcdBarrier& b) {
    asm volatile("s_waitcnt vmcnt(0)" ::: "memory");
    __syncthreads();
    if (threadIdx.x == 0) {
        unsigned* bar = b.bar;
        __builtin_amdgcn_s_waitcnt(0);
        unsigned nloc = b.st[0], nx = b.st[1];
        if (nloc == 0u) { xcd_barrier_complete(bar, b.x, nloc, nx); b.st[0] = nloc; b.st[1] = nx; }
        const unsigned old = xb_add(&bar[XB_XSUB(b.x)], 1u);
        const unsigned gen = old / nloc;
        if (old + 1u == (gen + 1u) * nloc) {
            __builtin_amdgcn_fence(__ATOMIC_RELEASE, "agent");
            asm volatile("s_waitcnt vmcnt(0)" ::: "memory");
            const unsigned og = xb_add(&bar[XB_TOP], 1u);
            const unsigned tg = og / nx;
            if (og + 1u == (tg + 1u) * nx) xb_add(&bar[XB_TOPGEN], 1u);
            else XB_SPIN(xb_ld(&bar[XB_TOPGEN]) == tg, bar);
            __builtin_amdgcn_fence(__ATOMIC_ACQUIRE, "agent");
            xb_add(&bar[XB_XGEN(b.x)], 1u);
            asm volatile("s_waitcnt vmcnt(0)" ::: "memory");
        } else {
            XB_SPIN(xb_ld(&bar[XB_XGEN(b.x)]) == gen, bar);
            __builtin_amdgcn_fence(__ATOMIC_ACQUIRE, "agent");
            asm volatile("s_waitcnt vmcnt(0)" ::: "memory");
        }
    }
    __syncthreads();
}
constexpr int NWAVES = 8;
constexpr int BATCH = 2, SEQ = 16384, D = 2048, M = BATCH * SEQ;
constexpr int ZW = 3072, PW = 1024, GW = 1024, FF = 5632, NE = 8, NQKV = 3 * D;
constexpr int CHUNK_TILES = 64, MAX_TILES = 264;
constexpr float EPS = 1e-5f;
constexpr float LAMBDA_INIT = 0.35550906759096927f;
constexpr size_t MiB = 1u << 20;
constexpr size_t WS_CTL = 0, CTL_ZERO_BYTES = 1 * MiB;
constexpr size_t WS_ROPE = 2 * MiB;
constexpr size_t WS_TOK = 10 * MiB;
constexpr size_t WS_WSP = 12 * MiB, WS_WPOOL = 12 * MiB + 512 * 1024;
constexpr size_t WS_WIN = 16 * MiB, WS_WOUT = 28 * MiB, WS_WGU = 36 * MiB, WS_WD = 80 * MiB, WS_WQKV = 102 * MiB, WS_WO = 126 * MiB, WS_WEGU = 134 * MiB, WS_WED = 486 * MiB;
constexpr size_t WS_A = 662 * MiB;
constexpr size_t WS_B = 790 * MiB;
constexpr size_t WS_Z = WS_B, WS_Y1 = WS_B + 192 * MiB, WS_ACT = WS_B;
constexpr size_t WS_Q = WS_B, WS_K = WS_B + 128 * MiB, WS_V = WS_B + 256 * MiB, WS_O0 = WS_B + 384 * MiB, WS_O1 = WS_B + 512 * MiB;
constexpr size_t WS_XP = WS_A, WS_YM = 926 * MiB, WS_ACTC = 1190 * MiB;
constexpr size_t WS_END = 1430 * MiB;
static_assert(WS_XP + (size_t)MAX_TILES * 256 * D * 2 <= WS_YM && WS_YM + (size_t)MAX_TILES * 256 * D * 2 <= WS_ACTC && WS_ACTC + (size_t)CHUNK_TILES * 256 * FF * 2 <= WS_END, "moe map");
static_assert(WS_ACT + (size_t)M * FF * 2 <= WS_END && WS_Y1 + (size_t)M * D * 2 <= WS_END && WS_WED + (size_t)NE * D * FF * 2 <= WS_A, "map");
constexpr int CW_TMO = 0, CW_CODE = 1, CW_BAR = 4096, CW_GCNT = 16384;
constexpr int RING_OFF = 0, RING_BYTES = 131072;
constexpr int LDSCTL_OFF = RING_BYTES, MISC_OFF = LDSCTL_OFF + 320;
constexpr int LDS_BYTES = 147456;
constexpr int LW_TS = 0, LW_SEG = 16;

struct Frame {
    LAS unsigned char* lds;
    volatile LAS unsigned* MISC;
    gu32* ctl;
    int tid, lane, wave;
    int vcu, G;
};

__device__ __forceinline__ float wave_sum(float v) {
#pragma unroll
    for (int o = 1; o < 64; o <<= 1) v += __shfl_xor(v, o);
    return v;
}
__device__ __forceinline__ float bf2f(unsigned short b) { return __uint_as_float((unsigned)b << 16); }
__device__ __forceinline__ float bflo(unsigned w) { return __uint_as_float(w << 16); }
__device__ __forceinline__ float bfhi(unsigned w) { return __uint_as_float(w & 0xffff0000u); }

__device__ __forceinline__ void p0_transpose_item(const float* W, int K, int N, bf16* WT, int k0, int n0, int drow0, LAS float* scr, int lane) {
#pragma unroll 8
    for (int i = 0; i < 32; ++i) { const int kk = 2 * i + (lane >> 5); scr[kk * 33 + (lane & 31)] = W[(size_t)(k0 + kk) * N + n0 + (lane & 31)]; }
    LDS_WAIT(); asm volatile("" ::: "memory");
    const int c = lane & 7;
#pragma unroll
    for (int j = 0; j < 4; ++j) { const int n = (lane >> 3) + 8 * j; const LAS float* s = scr + (8 * c) * 33 + n;
        v4u o; o.x = pk2(s[0 * 33], s[1 * 33]); o.y = pk2(s[2 * 33], s[3 * 33]); o.z = pk2(s[4 * 33], s[5 * 33]); o.w = pk2(s[6 * 33], s[7 * 33]);
        *(GAS v4u*)(WT + (size_t)(drow0 + n) * K + k0 + 8 * c) = o; }
    LDS_WAIT(); asm volatile("" ::: "memory");
}
__device__ __forceinline__ int map_gate(int n) { return 256 * (n >> 7) + (n & 127); }
__device__ __forceinline__ int map_up(int n) { return 256 * (n >> 7) + 128 + (n & 127); }
__device__ __forceinline__ int map_qkv(int n) {
    if (n >= 2 * D) return n;
    const int sec = n / D, cs = n % D, tile = cs >> 8, hh = (cs & 255) >> 6, d = cs & 63;
    return sec * D + tile * 256 + (d >> 5) * 128 + hh * 32 + (d & 31);
}
template <int MODE> __device__ __forceinline__ void p0_matrix(const float* W, int K, int N, bf16* WT, LAS float* scr, int lane, int it) {
    const int nblk = N / 32, kb = it / nblk, nb = it % nblk, n0 = 32 * nb;
    const int dr = MODE == 0 ? n0 : MODE == 1 ? map_gate(n0) : MODE == 2 ? map_up(n0) : map_qkv(n0);
    p0_transpose_item(W, K, N, WT, 64 * kb, n0, dr, scr, lane);
}
__device__ __forceinline__ float rms_row_to_bf16(const float* xrow, const float* gain, bf16* orow, int lane) {
    const GAS f32x4* xr = (const GAS f32x4*)xrow + lane; const GAS f32x4* gr = (const GAS f32x4*)gain + lane;
    f32x4 v[8]; float s = 0.f;
#pragma unroll
    for (int j = 0; j < 8; ++j) { v[j] = xr[64 * j]; s += (v[j].x * v[j].x + v[j].y * v[j].y) + (v[j].z * v[j].z + v[j].w * v[j].w); }
    const float rstd = 1.f / sqrtf(wave_sum(s) * (1.f / D) + EPS);
    GAS unsigned long long* o8 = (GAS unsigned long long*)orow + lane;
#pragma unroll
    for (int j = 0; j < 8; ++j) { const f32x4 g = gr[64 * j];
        o8[64 * j] = (unsigned long long)pk2(v[j].x * rstd * g.x, v[j].y * rstd * g.y) | ((unsigned long long)pk2(v[j].z * rstd * g.z, v[j].w * rstd * g.w) << 32); }
    return rstd;
}
__device__ __forceinline__ void norm_phase(Frame& F, const float* x, const float* gain, bf16* out) {
    const int gw = F.vcu * NWAVES + F.wave, NGW = F.G * NWAVES;
    for (int m = gw; m < M; m += NGW) (void)rms_row_to_bf16(x + (size_t)m * D, gain, out + (size_t)m * D, F.lane);
}
struct P0Args { const float *w_in, *w_out, *w_gate, *w_up, *w_down, *w_qkv, *w_o, *w_pool, *we_gate, *we_up, *we_down, *w_spatial; const int* positions; const float* x; const float* norm_mix; };
__device__ __forceinline__ void p0_prologue(Frame& F, const P0Args& a, unsigned char* ws) {
    LAS float* scr = (LAS float*)(F.lds + RING_OFF + F.wave * 16384);
    const int gw = F.vcu * NWAVES + F.wave, NGW = F.G * NWAVES, lane = F.lane;
    norm_phase(F, a.x, a.norm_mix, (bf16*)(ws + WS_A));
    constexpr int I_IN = (D / 64) * (ZW / 32), I_DD = (D / 64) * (D / 32), I_FF = (D / 64) * (FF / 32), I_QKV = (D / 64) * (NQKV / 32), I_POOL = 4 * 8;
    constexpr int N_DENSE = I_IN + I_DD + 3 * I_FF + I_QKV + I_DD + 4 * I_POOL, N_ALL = N_DENSE + NE * 3 * I_FF;
    for (int it = gw; it < N_ALL; it += NGW) {
        int r = it;
        if (r < I_IN) { p0_matrix<0>(a.w_in, D, ZW, (bf16*)(ws + WS_WIN), scr, lane, r); continue; } r -= I_IN;
        if (r < I_DD) { p0_matrix<0>(a.w_out, D, D, (bf16*)(ws + WS_WOUT), scr, lane, r); continue; } r -= I_DD;
        if (r < I_FF) { p0_matrix<1>(a.w_gate, D, FF, (bf16*)(ws + WS_WGU), scr, lane, r); continue; } r -= I_FF;
        if (r < I_FF) { p0_matrix<2>(a.w_up, D, FF, (bf16*)(ws + WS_WGU), scr, lane, r); continue; } r -= I_FF;
        if (r < I_FF) { p0_matrix<0>(a.w_down, FF, D, (bf16*)(ws + WS_WD), scr, lane, r); continue; } r -= I_FF;
        if (r < I_QKV) { p0_matrix<3>(a.w_qkv, D, NQKV, (bf16*)(ws + WS_WQKV), scr, lane, r); continue; } r -= I_QKV;
        if (r < I_DD) { p0_matrix<0>(a.w_o, D, D, (bf16*)(ws + WS_WO), scr, lane, r); continue; } r -= I_DD;
        if (r < 4 * I_POOL) { const int g = r / I_POOL; p0_matrix<0>(a.w_pool + (size_t)g * 65536, 256, 256, (bf16*)(ws + WS_WPOOL) + (size_t)g * 65536, scr, lane, r % I_POOL); continue; } r -= 4 * I_POOL;
        { const int e = r / (3 * I_FF), q = r % (3 * I_FF), which = q / I_FF, ii = q % I_FF;
          if (which == 0) p0_matrix<1>(a.we_gate + (size_t)e * D * FF, D, FF, (bf16*)(ws + WS_WEGU) + (size_t)e * 2 * FF * D, scr, lane, ii);
          else if (which == 1) p0_matrix<2>(a.we_up + (size_t)e * D * FF, D, FF, (bf16*)(ws + WS_WEGU) + (size_t)e * 2 * FF * D, scr, lane, ii);
          else p0_matrix<0>(a.we_down + (size_t)e * FF * D, FF, D, (bf16*)(ws + WS_WED) + (size_t)e * D * FF, scr, lane, ii); }
    }
    { bf16* wsp = (bf16*)(ws + WS_WSP); const int gt = F.vcu * NWAVES * 64 + F.tid, NT = F.G * NWAVES * 64;
      for (int i = gt; i < 8 * 128 * 128; i += NT) { const int t = (i >> 7) & 127, s = i & 127; wsp[i] = (bf16)(s <= t ? f2bf(a.w_spatial[i]) : 0u); }
      float* rope = (float*)(ws + WS_ROPE);
      for (int i = gt; i < M * 32; i += NT) { const int r = i >> 5, k = i & 31;
          const float inv = exp2f(-(float)k * (13.287712379549449f / 32.0f)); const float ang = (float)a.positions[r] * inv;
          const double rev = (double)ang * 0.15915494309189535; const float fr = (float)(rev - rint(rev));
          rope[(size_t)r * 64 + k] = __builtin_amdgcn_cosf(fr); rope[(size_t)r * 64 + 32 + k] = __builtin_amdgcn_sinf(fr); } }
}

typedef unsigned v2u __attribute__((ext_vector_type(2)));
__device__ __forceinline__ void p2_mixer(Frame& F, const bf16* Z, bf16* Y, const bf16* WpT, const float* pscale, const bf16* Wsp, const float* bsp, const float* lng, const float* lnb) {
    constexpr int ZP = 136;
    LAS bf16* ZS = (LAS bf16*)(F.lds);
    LAS bf16* PL = (LAS bf16*)(F.lds + 144 * ZP * 2);
    LAS bf16* VT = (LAS bf16*)(F.lds);
    LAS float* ST = (LAS float*)(F.lds + 81920);
    const int tid = F.tid, lane = F.lane, w = F.wave, fr = lane & 15, fq = lane >> 4;
    for (int unit = F.vcu; unit < M / 128; unit += F.G) {
        const int r0 = unit * 128, tpos0 = r0 % SEQ; const bool first = tpos0 == 0;
        for (int g = 0; g < 4; ++g) {
            const int win = 2 << g;
            f32x4 acc[2][8];
#pragma unroll
            for (int a = 0; a < 2; ++a)
#pragma unroll
                for (int b = 0; b < 8; ++b) acc[a][b] = (f32x4){0.f, 0.f, 0.f, 0.f};
            for (int kh = 0; kh < 2; ++kh) {
                __syncthreads();
                for (int i = tid; i < 144 * 16; i += 512) { const int row = i >> 4, ch = i & 15; v4u v = (v4u){0u, 0u, 0u, 0u};
                    if (!(first && row < 16)) v = *(const GAS v4u*)(Z + (size_t)(r0 - 16 + row) * ZW + g * 256 + kh * 128 + ch * 8);
                    *(LAS v4u*)(ZS + row * ZP + ch * 8) = v; }
                __syncthreads();
                { const int ch = tid & 15, tq = tid >> 4;
#pragma unroll 1
                  for (int k = 0; k < 4; ++k) { const int t = tq + 32 * k; float s[8];
#pragma unroll
                      for (int j = 0; j < 8; ++j) s[j] = 0.f;
                      for (int j = 0; j < win; ++j) { const v4u v = *(const LAS v4u*)(ZS + (t + 16 - j) * ZP + ch * 8);
                          s[0] += bflo(v.x); s[1] += bfhi(v.x); s[2] += bflo(v.y); s[3] += bfhi(v.y); s[4] += bflo(v.z); s[5] += bfhi(v.z); s[6] += bflo(v.w); s[7] += bfhi(v.w); }
                      const v4u zc = *(const LAS v4u*)(ZS + (t + 16) * ZP + ch * 8); const int tp = tpos0 + t; const float inv = 1.0f / (float)(tp + 1 < win ? tp + 1 : win);
                      v4u o; o.x = pk2(s[0] * inv - bflo(zc.x), s[1] * inv - bfhi(zc.x)); o.y = pk2(s[2] * inv - bflo(zc.y), s[3] * inv - bfhi(zc.y));
                      o.z = pk2(s[4] * inv - bflo(zc.z), s[5] * inv - bfhi(zc.z)); o.w = pk2(s[6] * inv - bflo(zc.w), s[7] * inv - bfhi(zc.w));
                      *(LAS v4u*)(PL + t * ZP + ch * 8) = o; } }
                __syncthreads();
#pragma unroll 1
                for (int ks = 0; ks < 4; ++ks) { bf16x8 af[2];
#pragma unroll
                    for (int db = 0; db < 2; ++db) af[db] = *(const GAS bf16x8*)(WpT + ((size_t)g * 256 + 32 * w + 16 * db + fr) * 256 + kh * 128 + 32 * ks + 8 * fq);
#pragma unroll
                    for (int tb = 0; tb < 8; ++tb) { const bf16x8 bv = *(const LAS bf16x8*)(PL + (16 * tb + fr) * ZP + 32 * ks + 8 * fq);
#pragma unroll
                        for (int db = 0; db < 2; ++db) acc[db][tb] = __builtin_amdgcn_mfma_f32_16x16x32_bf16(af[db], bv, acc[db][tb], 0, 0, 0); } }
            }
#pragma unroll
            for (int db = 0; db < 2; ++db) { const int col = g * 256 + 32 * w + 16 * db + 4 * fq; const f32x4 sc = *(const GAS f32x4*)(pscale + col);
#pragma unroll
                for (int tb = 0; tb < 8; ++tb) { const f32x4 v = acc[db][tb] * sc; v2u o; o.x = pk2(v[0], v[1]); o.y = pk2(v[2], v[3]);
                    *(GAS v2u*)(Y + (size_t)(r0 + 16 * tb + fr) * D + col) = o; } }
        }
        __syncthreads();
        for (int k = 0; k < 16; ++k) { const int t = 16 * w + k; const GAS v4u* vr = (const GAS v4u*)(Z + (size_t)(r0 + t) * ZW + PW + GW) + lane; const v4u a = vr[0], b = vr[64];
            float x[16] = {bflo(a.x), bfhi(a.x), bflo(a.y), bfhi(a.y), bflo(a.z), bfhi(a.z), bflo(a.w), bfhi(a.w), bflo(b.x), bfhi(b.x), bflo(b.y), bfhi(b.y), bflo(b.z), bfhi(b.z), bflo(b.w), bfhi(b.w)};
            float s = 0.f;
#pragma unroll
            for (int j = 0; j < 16; ++j) s += x[j];
            const float mean = wave_sum(s) * (1.0f / GW); float q = 0.f;
#pragma unroll
            for (int j = 0; j < 16; ++j) { const float d = x[j] - mean; q += d * d; }
            const float rstd = 1.0f / sqrtf(wave_sum(q) * (1.0f / GW) + EPS);
            if (lane == 0) { ST[2 * t] = mean; ST[2 * t + 1] = rstd; } }
        __syncthreads();
        for (int g = 0; g < 8; ++g) {
#pragma unroll 1
            for (int k = 0; k < 4; ++k) { const int i = tid + 512 * k, s = i >> 4, ch = i & 15;
                const v4u v = *(const GAS v4u*)(Z + (size_t)(r0 + s) * ZW + PW + GW + g * 128 + ch * 8); const float mean = ST[2 * s], rstd = ST[2 * s + 1];
                const f32x4 g0 = *(const GAS f32x4*)(lng + g * 128 + ch * 8), g1 = *(const GAS f32x4*)(lng + g * 128 + ch * 8 + 4), b0 = *(const GAS f32x4*)(lnb + g * 128 + ch * 8), b1 = *(const GAS f32x4*)(lnb + g * 128 + ch * 8 + 4);
                LAS bf16* vt = VT + (ch * 8) * ZP + s;
                vt[0 * ZP] = (bf16)f2bf((bflo(v.x) - mean) * rstd * g0[0] + b0[0]); vt[1 * ZP] = (bf16)f2bf((bfhi(v.x) - mean) * rstd * g0[1] + b0[1]);
                vt[2 * ZP] = (bf16)f2bf((bflo(v.y) - mean) * rstd * g0[2] + b0[2]); vt[3 * ZP] = (bf16)f2bf((bfhi(v.y) - mean) * rstd * g0[3] + b0[3]);
                vt[4 * ZP] = (bf16)f2bf((bflo(v.z) - mean) * rstd * g1[0] + b1[0]); vt[5 * ZP] = (bf16)f2bf((bfhi(v.z) - mean) * rstd * g1[1] + b1[1]);
                vt[6 * ZP] = (bf16)f2bf((bflo(v.w) - mean) * rstd * g1[2] + b1[2]); vt[7 * ZP] = (bf16)f2bf((bfhi(v.w) - mean) * rstd * g1[3] + b1[3]); }
            __syncthreads();
            f32x4 acc[8];
#pragma unroll
            for (int b = 0; b < 8; ++b) acc[b] = (f32x4){0.f, 0.f, 0.f, 0.f};
            const int nks = (w >> 1) + 1;
#pragma unroll 1
            for (int ks = 0; ks < nks; ++ks) { const bf16x8 bw = *(const GAS bf16x8*)(Wsp + ((size_t)g * 128 + 16 * w + fr) * 128 + 32 * ks + 8 * fq);
#pragma unroll
                for (int cb = 0; cb < 8; ++cb) { const bf16x8 av = *(const LAS bf16x8*)(VT + (16 * cb + fr) * ZP + 32 * ks + 8 * fq);
                    acc[cb] = __builtin_amdgcn_mfma_f32_16x16x32_bf16(av, bw, acc[cb], 0, 0, 0); } }
            { const int t = 16 * w + fr; const float bias = bsp[g * 128 + t];
#pragma unroll
              for (int cb = 0; cb < 8; ++cb) { const int c = g * 128 + 16 * cb + 4 * fq; const v2u uu = *(const GAS v2u*)(Z + (size_t)(r0 + t) * ZW + PW + c);
                  v2u o; o.x = pk2(bflo(uu.x) * (acc[cb][0] + bias), bfhi(uu.x) * (acc[cb][1] + bias)); o.y = pk2(bflo(uu.y) * (acc[cb][2] + bias), bfhi(uu.y) * (acc[cb][3] + bias));
                  *(GAS v2u*)(Y + (size_t)(r0 + t) * D + PW + c) = o; } }
            __syncthreads();
        }
    }
}

__device__ __forceinline__ void p10_combine(Frame& F, const bf16* O0, const bf16* O1, bf16* O, const float* lq1, const float* lk1, const float* lq2, const float* lk2, const float* subg) {
    const int gw = F.vcu * NWAVES + F.wave, NGW = F.G * NWAVES, lane = F.lane;
    const float s1 = wave_sum(lq1[lane] * lk1[lane]), s2 = wave_sum(lq2[lane] * lk2[lane]);
    const float lam = expf(s1) - expf(s2) + LAMBDA_INIT;
    const int e0 = (lane & 15) * 8;
    const f32x4 g0 = *(const GAS f32x4*)(subg + e0), g1 = *(const GAS f32x4*)(subg + e0 + 4);
    const float post = 1.0f - LAMBDA_INIT;
    for (int m = gw; m < M; m += NGW) {
        const GAS v4u* a = (const GAS v4u*)(O0 + (size_t)m * D) + lane; const GAS v4u* b = (const GAS v4u*)(O1 + (size_t)m * D) + lane; GAS v4u* o = (GAS v4u*)(O + (size_t)m * D) + lane;
#pragma unroll
        for (int j = 0; j < 4; ++j) { const v4u x = a[64 * j], y = b[64 * j]; float d[8];
            d[0] = bflo(x.x) - lam * bflo(y.x); d[1] = bfhi(x.x) - lam * bfhi(y.x); d[2] = bflo(x.y) - lam * bflo(y.y); d[3] = bfhi(x.y) - lam * bfhi(y.y);
            d[4] = bflo(x.z) - lam * bflo(y.z); d[5] = bfhi(x.z) - lam * bfhi(y.z); d[6] = bflo(x.w) - lam * bflo(y.w); d[7] = bfhi(x.w) - lam * bfhi(y.w);
            float q = 0.f;
#pragma unroll
            for (int i = 0; i < 8; ++i) q += d[i] * d[i];
            q += __shfl_xor(q, 1); q += __shfl_xor(q, 2); q += __shfl_xor(q, 4); q += __shfl_xor(q, 8);
            const float r = post / sqrtf(q * (1.0f / 128.0f) + EPS);
            v4u w; w.x = pk2(d[0] * r * g0[0], d[1] * r * g0[1]); w.y = pk2(d[2] * r * g0[2], d[3] * r * g0[3]); w.z = pk2(d[4] * r * g1[0], d[5] * r * g1[1]); w.w = pk2(d[6] * r * g1[2], d[7] * r * g1[3]);
            o[64 * j] = w; }
    }
}

__device__ __forceinline__ void p12a_route(Frame& F, const float* X, const float* gain, const float* wrt, unsigned char* ws) {
    LAS float* WR = (LAS float*)(F.lds);
    LAS int* SEL = (LAS int*)(F.lds + 65536);
    LAS int* RNK = (LAS int*)(F.lds + 65536 + 1024);
    LAS int* LCNT = (LAS int*)(F.lds + 65536 + 2048);
    int* tok_e = (int*)(ws + WS_TOK); int* tok_p = tok_e + 2 * M; float* tok_w = (float*)(tok_p + 2 * M); float* tok_rstd = tok_w + 2 * M;
    const int tid = F.tid, lane = F.lane, w = F.wave;
    for (int i = tid; i < D * NE; i += 512) WR[(i & 7) * D + (i >> 3)] = wrt[i];
    if (tid < 16) LCNT[tid] = 0;
    __syncthreads();
    const int rows_per_blk = M / F.G;
    const int rbase = F.vcu * rows_per_blk;
    for (int li = w; li < rows_per_blk; li += NWAVES) { const int m = rbase + li;
        const GAS f32x4* xr = (const GAS f32x4*)(X + (size_t)m * D) + lane; const GAS f32x4* gr = (const GAS f32x4*)gain + lane;
        f32x4 v[8]; float s = 0.f;
#pragma unroll
        for (int j = 0; j < 8; ++j) { v[j] = xr[64 * j]; s += (v[j].x * v[j].x + v[j].y * v[j].y) + (v[j].z * v[j].z + v[j].w * v[j].w); }
        const float rstd = 1.f / sqrtf(wave_sum(s) * (1.f / D) + EPS);
        float lg[8];
#pragma unroll
        for (int e = 0; e < 8; ++e) lg[e] = 0.f;
#pragma unroll
        for (int j = 0; j < 8; ++j) { const f32x4 g = gr[64 * j]; const f32x4 h = (f32x4){v[j].x * rstd * g.x, v[j].y * rstd * g.y, v[j].z * rstd * g.z, v[j].w * rstd * g.w};
#pragma unroll
            for (int e = 0; e < 8; ++e) { const f32x4 wv = *(const LAS f32x4*)(WR + e * D + 4 * (64 * j + lane)); lg[e] += (h.x * wv.x + h.y * wv.y) + (h.z * wv.z + h.w * wv.w); } }
#pragma unroll
        for (int e = 0; e < 8; ++e) lg[e] = wave_sum(lg[e]);
        if (lane == 0) {
            int e0 = 0; float v0 = lg[0];
#pragma unroll
            for (int e = 1; e < 8; ++e) if (lg[e] > v0) { v0 = lg[e]; e0 = e; }
            int e1 = -1; float v1 = -INFINITY;
#pragma unroll
            for (int e = 0; e < 8; ++e) if (e != e0 && (e1 < 0 || lg[e] > v1)) { v1 = lg[e]; e1 = e; }
            const float w1 = 1.0f / (1.0f + expf(v0 - v1)), w0 = 1.0f - w1;
            SEL[2 * li] = e0; SEL[2 * li + 1] = e1; tok_w[2 * m] = w0; tok_w[2 * m + 1] = w1; tok_rstd[m] = rstd; }
    }
    __syncthreads();
    if (tid < 2 * rows_per_blk) RNK[tid] = __hip_atomic_fetch_add(LCNT + SEL[tid], 1, __ATOMIC_RELAXED, __HIP_MEMORY_SCOPE_WORKGROUP);
    __syncthreads();
    if (tid < 8) LCNT[8 + tid] = (int)__hip_atomic_fetch_add(F.ctl + CW_GCNT + 64 * tid, (unsigned)LCNT[tid], RLX_AGENT);
    __syncthreads();
    if (tid < 2 * rows_per_blk) { const int e = SEL[tid]; tok_e[2 * rbase + tid] = e; tok_p[2 * rbase + tid] = LCNT[8 + e] + RNK[tid]; }
    __syncthreads();
}
__device__ __forceinline__ void p12b_gather(Frame& F, const float* X, const float* gain, unsigned char* ws) {
    volatile LAS int* LW = (volatile LAS int*)(F.lds + LDSCTL_OFF);
    if (F.tid == 0) { int ts = 0; LW[LW_TS] = 0; LW[LW_SEG] = 0;
        for (int e = 0; e < 8; ++e) { const unsigned c = __hip_atomic_load(F.ctl + CW_GCNT + 64 * e, RLX_AGENT); ts += (int)((c + 255u) >> 8); LW[LW_TS + e + 1] = ts; LW[LW_SEG + e + 1] = ts * 256; } }
    __syncthreads();
    int* tok_e = (int*)(ws + WS_TOK); int* tok_p = tok_e + 2 * M; float* tok_w = (float*)(tok_p + 2 * M); float* tok_rstd = tok_w + 2 * M;
    bf16* Xp = (bf16*)(ws + WS_XP);
    const int gw = F.vcu * NWAVES + F.wave, NGW = F.G * NWAVES, lane = F.lane;
    for (int m = gw; m < M; m += NGW) {
        const int e0 = tok_e[2 * m], e1 = tok_e[2 * m + 1]; const int p0 = LW[LW_SEG + e0] + tok_p[2 * m], p1 = LW[LW_SEG + e1] + tok_p[2 * m + 1]; const float rstd = tok_rstd[m];
        const GAS f32x4* xr = (const GAS f32x4*)(X + (size_t)m * D) + lane; const GAS f32x4* gr = (const GAS f32x4*)gain + lane;
        GAS unsigned long long* d0 = (GAS unsigned long long*)(Xp + (size_t)p0 * D) + lane; GAS unsigned long long* d1 = (GAS unsigned long long*)(Xp + (size_t)p1 * D) + lane;
#pragma unroll
        for (int j = 0; j < 8; ++j) { const f32x4 v = xr[64 * j], g = gr[64 * j];
            const unsigned long long o = (unsigned long long)pk2(v.x * rstd * g.x, v.y * rstd * g.y) | ((unsigned long long)pk2(v.z * rstd * g.z, v.w * rstd * g.w) << 32);
            d0[64 * j] = o; d1[64 * j] = o; }
        asm volatile("" ::: "memory");
        if (lane == 0) { tok_p[2 * m] = p0; tok_p[2 * m + 1] = p1; }
    }
}
__device__ __forceinline__ void p15_final(Frame& F, float* X, const float* gain, unsigned char* ws, bool poison) {
    const int* tok_e = (const int*)(ws + WS_TOK); const int* tok_p = tok_e + 2 * M; const float* tok_w = (const float*)(tok_p + 2 * M);
    const bf16* Ym = (const bf16*)(ws + WS_YM);
    const int gw = F.vcu * NWAVES + F.wave, NGW = F.G * NWAVES, lane = F.lane;
    for (int m = gw; m < M; m += NGW) {
        const int p0 = tok_p[2 * m], p1 = tok_p[2 * m + 1]; const float w0 = tok_w[2 * m], w1 = tok_w[2 * m + 1];
        GAS f32x4* xr = (GAS f32x4*)(X + (size_t)m * D) + lane; const GAS f32x4* gr = (const GAS f32x4*)gain + lane;
        const GAS v2u* y0 = (const GAS v2u*)(Ym + (size_t)p0 * D) + lane; const GAS v2u* y1 = (const GAS v2u*)(Ym + (size_t)p1 * D) + lane;
        f32x4 v[8]; float s = 0.f;
#pragma unroll
        for (int j = 0; j < 8; ++j) { const f32x4 x = xr[64 * j]; const v2u a = y0[64 * j], b = y1[64 * j];
            v[j] = (f32x4){x.x + w0 * bflo(a.x) + w1 * bflo(b.x), x.y + w0 * bfhi(a.x) + w1 * bfhi(b.x), x.z + w0 * bflo(a.y) + w1 * bflo(b.y), x.w + w0 * bfhi(a.y) + w1 * bfhi(b.y)};
            s += (v[j].x * v[j].x + v[j].y * v[j].y) + (v[j].z * v[j].z + v[j].w * v[j].w); }
        float rstd = 1.f / sqrtf(wave_sum(s) * (1.f / D) + EPS);
        if (poison) rstd = __builtin_nanf("");
#pragma unroll
        for (int j = 0; j < 8; ++j) { const f32x4 g = gr[64 * j]; xr[64 * j] = (f32x4){v[j].x * rstd * g.x, v[j].y * rstd * g.y, v[j].z * rstd * g.z, v[j].w * rstd * g.w}; }
    }
}
struct Args { const void* in[29]; float* out; unsigned char* ws; };
__global__ void __launch_bounds__(NWAVES * 64, 2) hybrid_fwd(Args args) {
    extern __shared__ __attribute__((aligned(16))) unsigned char lds[];
    Frame F;
    F.lds = (LAS unsigned char*)lds;
    F.MISC = (volatile LAS unsigned*)(F.lds + MISC_OFF);
    F.tid = threadIdx.x; F.lane = F.tid & 63; F.wave = __builtin_amdgcn_readfirstlane(F.tid >> 6);
    F.G = gridDim.x; { const int bx = blockIdx.x; F.vcu = (F.G % 8 == 0) ? (bx % 8) * (F.G / 8) + bx / 8 : bx; }
    unsigned char* ws = args.ws;
    F.ctl = (gu32*)(ws + WS_CTL);
    for (int u = F.tid; u < (LDS_BYTES - LDSCTL_OFF) / 4; u += NWAVES * 64) ((LAS unsigned*)(F.lds + LDSCTL_OFF))[u] = 0u;
    __syncthreads();
    XcdBarrier bar = xcd_barrier_post((unsigned*)(F.ctl + CW_BAR), F.MISC + 8);
#define GRID_BAR() do { xcd_barrier(bar); int t_ = threadIdx.x; asm volatile("" : "+v"(t_)); F.tid = t_; F.lane = t_ & 63; } while (0)
    const float* x = (const float*)args.in[0]; float* out = args.out;
    bf16* const A = (bf16*)(ws + WS_A);
    typedef pg8::bf16_t pb;

    { P0Args a; a.w_in = (const float*)args.in[3]; a.w_out = (const float*)args.in[10]; a.w_gate = (const float*)args.in[12]; a.w_up = (const float*)args.in[13]; a.w_down = (const float*)args.in[14];
      a.w_qkv = (const float*)args.in[16]; a.w_o = (const float*)args.in[22]; a.w_pool = (const float*)args.in[4]; a.we_gate = (const float*)args.in[25]; a.we_up = (const float*)args.in[26]; a.we_down = (const float*)args.in[27];
      a.w_spatial = (const float*)args.in[8]; a.positions = (const int*)args.in[1]; a.x = x; a.norm_mix = (const float*)args.in[2];
      p0_prologue(F, a, ws); }
    GRID_BAR();
    { pg8::Gemm g{(const pb*)A, (const pb*)(ws + WS_WIN), D, 0}; pg8::StaticOrder S; S.init(M, ZW, F.G, (int)blockIdx.x);
      pg8::EpiZ E{(pb*)(ws + WS_Z), ZW, PW / 256};
      pg8::gemm_phase<pg8::EpiZ, pg8::StaticOrder, true, true>(F.lds + RING_OFF, g, S, E); }
    GRID_BAR();
    p2_mixer(F, (const bf16*)(ws + WS_Z), (bf16*)(ws + WS_Y1), (const bf16*)(ws + WS_WPOOL), (const float*)args.in[5], (const bf16*)(ws + WS_WSP), (const float*)args.in[9], (const float*)args.in[6], (const float*)args.in[7]);
    GRID_BAR();
    { pg8::Gemm g{(const pb*)(ws + WS_Y1), (const pb*)(ws + WS_WOUT), D, 0}; pg8::StaticOrder S; S.init(M, D, F.G, (int)blockIdx.x);
      pg8::EpiRes E{x, out, D};
      pg8::gemm_phase<pg8::EpiRes, pg8::StaticOrder, true, true>(F.lds + RING_OFF, g, S, E); }
    GRID_BAR();
    norm_phase(F, out, (const float*)args.in[11], A);
    GRID_BAR();
    { pg8::Gemm g{(const pb*)A, (const pb*)(ws + WS_WGU), D, 0}; pg8::StaticOrder S; S.init(M, 2 * FF, F.G, (int)blockIdx.x);
      pg8::EpiSwiGLU E{(pb*)(ws + WS_ACT), FF};
      pg8::gemm_phase<pg8::EpiSwiGLU, pg8::StaticOrder, true, true>(F.lds + RING_OFF, g, S, E); }
    GRID_BAR();
    { pg8::Gemm g{(const pb*)(ws + WS_ACT), (const pb*)(ws + WS_WD), FF, 0}; pg8::StaticOrder S; S.init(M, D, F.G, (int)blockIdx.x);
      pg8::EpiRes E{out, out, D};
      pg8::gemm_phase<pg8::EpiRes, pg8::StaticOrder, true, true>(F.lds + RING_OFF, g, S, E); }
    GRID_BAR();
    norm_phase(F, out, (const float*)args.in[15], A);
    GRID_BAR();
    { pg8::Gemm g{(const pb*)A, (const pb*)(ws + WS_WQKV), D, 0}; pg8::StaticOrder S; S.init(M, NQKV, F.G, (int)blockIdx.x);
      pg8::EpiQKV E{(pb*)(ws + WS_Q), (pb*)(ws + WS_K), (pb*)(ws + WS_V), D, (const float*)(ws + WS_ROPE), attn_body::C2};
      pg8::gemm_phase<pg8::EpiQKV, pg8::StaticOrder, true, true>(F.lds + RING_OFF, g, S, E); }
    GRID_BAR();
    { const attn_body::DiffOrder S(F.vcu); attn_body::AttnUnit u;
      const attn_body::bf16* Qb = (const attn_body::bf16*)(ws + WS_Q); const attn_body::bf16* Kb = (const attn_body::bf16*)(ws + WS_K); const attn_body::bf16* Vb = (const attn_body::bf16*)(ws + WS_V);
      for (int i = 0; S.next(i, u); ++i) { const int qc = (u.h * 2 + u.c) * 64, vc = (u.h * 2 + u.vh) * 64;
          attn_body::bf16* Ob = (attn_body::bf16*)(ws + (u.c ? WS_O1 : WS_O0));
          attn_body::attn_unit<8>(u.b, 0, u.qb, Qb + qc, Kb + qc, Vb + vc, Ob + vc, (char*)lds + RING_OFF); } }
    GRID_BAR();
    p10_combine(F, (const bf16*)(ws + WS_O0), (const bf16*)(ws + WS_O1), A, (const float*)args.in[17], (const float*)args.in[18], (const float*)args.in[19], (const float*)args.in[20], (const float*)args.in[21]);
    GRID_BAR();
    { pg8::Gemm g{(const pb*)A, (const pb*)(ws + WS_WO), D, 0}; pg8::StaticOrder S; S.init(M, D, F.G, (int)blockIdx.x);
      pg8::EpiRes E{out, out, D};
      pg8::gemm_phase<pg8::EpiRes, pg8::StaticOrder, true, true>(F.lds + RING_OFF, g, S, E); }
    GRID_BAR();
    p12a_route(F, out, (const float*)args.in[23], (const float*)args.in[24], ws);
    GRID_BAR();
    p12b_gather(F, out, (const float*)args.in[23], ws);
    GRID_BAR();
    { volatile LAS int* LW = (volatile LAS int*)(F.lds + LDSCTL_OFF); const int n_tiles = __builtin_amdgcn_readfirstlane(LW[LW_TS + 8]);
      for (int t0 = 0; t0 < n_tiles; t0 += CHUNK_TILES) { const int nt = (n_tiles - t0) < CHUNK_TILES ? (n_tiles - t0) : CHUNK_TILES;
          { pg8::Gemm g{(const pb*)(ws + WS_XP) + (size_t)t0 * 256 * D, (const pb*)(ws + WS_WEGU), D, (size_t)2 * FF * D * 2}; pg8::MoeOrder S; S.init(nt * 256, 2 * FF, F.G, (int)blockIdx.x); S.tile0 = t0;
#pragma unroll
            for (int k = 0; k < 9; ++k) S.ts[k] = __builtin_amdgcn_readfirstlane(LW[LW_TS + k]);
            pg8::EpiSwiGLU E{(pb*)(ws + WS_ACTC), FF};
            pg8::gemm_phase<pg8::EpiSwiGLU, pg8::MoeOrder, true, true>(F.lds + RING_OFF, g, S, E); }
          GRID_BAR();
          { pg8::Gemm g{(const pb*)(ws + WS_ACTC), (const pb*)(ws + WS_WED), FF, (size_t)D * FF * 2}; pg8::MoeOrder S; S.init(nt * 256, D, F.G, (int)blockIdx.x); S.tile0 = t0;
#pragma unroll
            for (int k = 0; k < 9; ++k) S.ts[k] = __builtin_amdgcn_readfirstlane(LW[LW_TS + k]);
            pg8::EpiPlain E{(pb*)(ws + WS_YM) + (size_t)t0 * 256 * D, D};
            pg8::gemm_phase<pg8::EpiPlain, pg8::MoeOrder, true, true>(F.lds + RING_OFF, g, S, E); }
          GRID_BAR();
      } }
    { const bool poison = __hip_atomic_load(F.ctl + CW_BAR + XB_TMO, RLX_AGENT) != 0u;
      p15_final(F, out, (const float*)args.in[28], ws, poison); }
}

extern "C" void kernel_launch(void* const* d_in, const int* in_sizes, int n_in, void* d_out, int out_size, void* d_ws, size_t ws_size, hipStream_t stream) {
    static int grid = 0;
    if (grid == 0) {
        if (n_in != 29 || in_sizes[0] != M * D || out_size != M * D || ws_size < WS_END) { fprintf(stderr, "kernel_launch: unexpected shapes (n_in %d, in0 %d, out %d, ws %zu < %zu); nothing launched\n", n_in, n_in > 0 ? in_sizes[0] : -1, out_size, ws_size, (size_t)WS_END); grid = -1; return; }
        int dev = 0, cus = 0, per_cu = 0;
        if (hipGetDevice(&dev) != hipSuccess || hipDeviceGetAttribute(&cus, hipDeviceAttributeMultiprocessorCount, dev) != hipSuccess) { grid = -1; return; }
        if (hipFuncSetAttribute((const void*)hybrid_fwd, hipFuncAttributeMaxDynamicSharedMemorySize, LDS_BYTES) != hipSuccess) { fprintf(stderr, "kernel_launch: hipFuncSetAttribute failed\n"); grid = -1; return; }
        if (hipOccupancyMaxActiveBlocksPerMultiprocessor(&per_cu, (const void*)hybrid_fwd, NWAVES * 64, LDS_BYTES) != hipSuccess || per_cu < 1) fprintf(stderr, "kernel_launch: occupancy query says %d\n", per_cu);
        (void)hipGetLastError();
        if (cus < 256) { fprintf(stderr, "kernel_launch: needs 256 CUs, device has %d\n", cus); grid = -1; return; }
        grid = 256;
    }
    if (grid < 0) return;
    if (hipMemsetAsync((char*)d_ws + WS_CTL, 0, CTL_ZERO_BYTES, stream) != hipSuccess) return;
    Args a{};
    for (int i = 0; i < 29; ++i) a.in[i] = d_in[i];
    a.out = (float*)d_out; a.ws = (unsigned char*)d_ws;
    hipLaunchKernelGGL(hybrid_fwd, dim3(grid), dim3(NWAVES * 64), LDS_BYTES, stream, a);
    const hipError_t le = hipPeekAtLastError();
    if (le != hipSuccess) fprintf(stderr, "kernel_launch: launch failed: %s\n", hipGetErrorName(le));
}
```

```cpp
#include <hip/hip_runtime.h>
#include <hip/hip_bf16.h>
#include <cstdio>
#include <cstdint>
#include <cmath>
namespace pg8 {
#define PG8_LAS __attribute__((address_space(3)))
typedef unsigned short bf16_t;
typedef short bf16x8 __attribute__((ext_vector_type(8)));
typedef float f32x4 __attribute__((ext_vector_type(4)));
typedef unsigned u32x4 __attribute__((ext_vector_type(4)));
constexpr int BM = 256, BK = 64, HALF = 128, HTB = HALF * BK * 2  , STAGE_BYTES = 8 * HTB, NXCD = 8, WGM = 8;

__host__ __device__ __forceinline__ int lds_byte(int r, int c) { const int st = (r >> 4) * 2 + (c >> 5), rr = r & 15, cc = c & 31, ob = rr * 64 + cc * 2; return st * 1024 + (ob ^ (((ob >> 9) & 1) << 5)); }
__host__ __device__ __forceinline__ void stage_rc(int b, int& R, int& C) { const int st = b / 1024, sb = b % 1024, swz = sb ^ (((sb >> 9) & 1) << 5); R = (st >> 1) * 16 + swz / 64; C = (st & 1) * 32 + (swz % 64) / 2; }
__host__ __device__ __forceinline__ int perm32(int rho) { const int n = rho >> 4, i = rho & 15; return 8 * (i >> 2) + 4 * n + (i & 3); }

struct Unit { int pm, pn, be; };
struct Gemm { const bf16_t* A; const bf16_t* Bt; int K; size_t bstride; };

struct StaticOrder {
    int nM, nN, nwg, G, c;
    __host__ __device__ void init(int M, int N, int G_, int c_) { nM = M / BM; nN = N / BM; nwg = nM * nN; G = G_; c = c_; }
    __host__ __device__ bool next(int i, Unit& u) const {
        const long L = (long)i * G + c; if (L >= nwg) return false;
        int wgid = (int)L; { const int q = nwg / NXCD, r = nwg % NXCD, xcd = wgid % NXCD, off = wgid / NXCD; wgid = (xcd < r ? xcd * (q + 1) : r * (q + 1) + (xcd - r) * q) + off; }
        const int nig = WGM * nN, gid = wgid / nig, fm = gid * WGM, gsz = (nM - fm) < WGM ? (nM - fm) : WGM;
        u.pm = fm + ((wgid % nig) % gsz); u.pn = (wgid % nig) / gsz; u.be = 0; return true;
    }
    __device__ __forceinline__ void a_ready(const Unit&) const {}
    __device__ __forceinline__ void done(const Unit&) const {}
};

__device__ __forceinline__ unsigned cvt_pk_bf16(float lo, float hi) { unsigned r; asm volatile("v_cvt_pk_bf16_f32 %0, %1, %2" : "=v"(r) : "v"(lo), "v"(hi)); return r; }
typedef float f32x2 __attribute__((ext_vector_type(2)));
__device__ __forceinline__ f32x2 gelu_pk(f32x2 v) {
    const f32x2 av = __builtin_elementwise_abs(v), d = av * 0.2316418882f + 1.0f;
    f32x2 t; t.x = __builtin_amdgcn_rcpf(d.x); t.y = __builtin_amdgcn_rcpf(d.y);
    f32x2 q = t * 0.5307027145f + (-0.7265760135f); q = q * t + 0.7107068705f; q = q * t + (-0.142248368f); q = q * t + 0.127414796f; q = q * t;
    const f32x2 s = (v * v) * (-0.72134752044f);
    f32x2 e; e.x = __builtin_amdgcn_exp2f(s.x); e.y = __builtin_amdgcn_exp2f(s.y);
    const f32x2 m = v * (q * e), r = v - m;
    f32x2 o; o.x = v.x < 0.f ? m.x : r.x; o.y = v.y < 0.f ? m.y : r.y; return o;
}

typedef int v4i_t __attribute__((ext_vector_type(4)));
__device__ __forceinline__ u32x4 pack8(f32x4 v0, f32x4 v1) { u32x4 w; w.x = cvt_pk_bf16(v0[0], v0[1]); w.y = cvt_pk_bf16(v0[2], v0[3]); w.z = cvt_pk_bf16(v1[0], v1[1]); w.w = cvt_pk_bf16(v1[2], v1[3]); return w; }
__device__ __forceinline__ f32x4 gelu4(f32x4 v) { const f32x2 a = gelu_pk((f32x2){v[0], v[1]}), b = gelu_pk((f32x2){v[2], v[3]}); return (f32x4){a.x, a.y, b.x, b.y}; }
__device__ __forceinline__ float silu1(float x) { return x * __builtin_amdgcn_rcpf(1.0f + __builtin_amdgcn_exp2f(x * -1.4426950408889634f)); }
__device__ __forceinline__ f32x4 swiglu4(f32x4 g, f32x4 u) { return (f32x4){silu1(g[0]) * u[0], silu1(g[1]) * u[1], silu1(g[2]) * u[2], silu1(g[3]) * u[3]}; }

struct EpiZ {
    static constexpr bool PERM = true, AFTER_DRAIN = false;
    bf16_t* O; int ldc; int gelu_from;
    __device__ __forceinline__ void operator()(const f32x4 (&acc)[2][2][4][2], const Unit& u, int wr, int wc, int fr, int fq) const {
        const int row0 = u.pm * BM + wr * 64 + fr, col0 = u.pn * BM + wc * 32 + 8 * fq; const bool gel = u.pn >= gelu_from;
#pragma unroll
        for (int ai = 0; ai < 2; ++ai)
#pragma unroll
            for (int m = 0; m < 4; ++m) { bf16_t* rowp = O + (size_t)(row0 + ai * HALF + m * 16) * ldc + col0;
#pragma unroll
                for (int bj = 0; bj < 2; ++bj) { f32x4 v0 = acc[ai][bj][m][0], v1 = acc[ai][bj][m][1];
                    if (gel) { v0 = gelu4(v0); v1 = gelu4(v1); }
                    *(u32x4*)(rowp + bj * HALF) = pack8(v0, v1); } }
    }
};
struct EpiPlain {
    static constexpr bool PERM = true, AFTER_DRAIN = false;
    bf16_t* O; int ldc;
    __device__ __forceinline__ void operator()(const f32x4 (&acc)[2][2][4][2], const Unit& u, int wr, int wc, int fr, int fq) const {
        const int row0 = u.pm * BM + wr * 64 + fr, col0 = u.pn * BM + wc * 32 + 8 * fq;
#pragma unroll
        for (int ai = 0; ai < 2; ++ai)
#pragma unroll
            for (int m = 0; m < 4; ++m) { bf16_t* rowp = O + (size_t)(row0 + ai * HALF + m * 16) * ldc + col0;
#pragma unroll
                for (int bj = 0; bj < 2; ++bj) *(u32x4*)(rowp + bj * HALF) = pack8(acc[ai][bj][m][0], acc[ai][bj][m][1]); }
    }
};
__device__ __forceinline__ f32x4 bf4lo(unsigned a, unsigned b) { return (f32x4){__uint_as_float(a << 16), __uint_as_float(a & 0xffff0000u), __uint_as_float(b << 16), __uint_as_float(b & 0xffff0000u)}; }
template <bool RES32> struct EpiResB {
    static constexpr bool PERM = true, AFTER_DRAIN = false;
    const void* res; bf16_t* out; int ldc; float s;
    __device__ __forceinline__ void operator()(const f32x4 (&acc)[2][2][4][2], const Unit& u, int wr, int wc, int fr, int fq) const {
        const int row0 = u.pm * BM + wr * 64 + fr, col0 = u.pn * BM + wc * 32 + 8 * fq;
#pragma unroll
        for (int ai = 0; ai < 2; ++ai) { f32x4 r[4][2][2];
#pragma unroll
            for (int m = 0; m < 4; ++m) { const size_t off = (size_t)(row0 + ai * HALF + m * 16) * ldc + col0;
#pragma unroll
                for (int bj = 0; bj < 2; ++bj) {
                    if constexpr (RES32) { r[m][bj][0] = *(const f32x4*)((const float*)res + off + bj * HALF); r[m][bj][1] = *(const f32x4*)((const float*)res + off + bj * HALF + 4); }
                    else { const u32x4 w = *(const u32x4*)((const bf16_t*)res + off + bj * HALF); r[m][bj][0] = bf4lo(w.x, w.y); r[m][bj][1] = bf4lo(w.z, w.w); } } }
#pragma unroll
            for (int m = 0; m < 4; ++m) { const size_t off = (size_t)(row0 + ai * HALF + m * 16) * ldc + col0;
#pragma unroll
                for (int bj = 0; bj < 2; ++bj) *(u32x4*)(out + off + bj * HALF) = pack8(r[m][bj][0] + acc[ai][bj][m][0] * s, r[m][bj][1] + acc[ai][bj][m][1] * s); }
            asm volatile("" ::: "memory"); }
    }
};
struct EpiSwiGLU {
    static constexpr bool PERM = true, AFTER_DRAIN = false;
    bf16_t* O; int ldc;
    __device__ __forceinline__ void operator()(const f32x4 (&acc)[2][2][4][2], const Unit& u, int wr, int wc, int fr, int fq) const {
        const int row0 = u.pm * BM + wr * 64 + fr, col0 = u.pn * HALF + wc * 32 + 8 * fq;
#pragma unroll
        for (int ai = 0; ai < 2; ++ai)
#pragma unroll
            for (int m = 0; m < 4; ++m) { bf16_t* rowp = O + (size_t)(row0 + ai * HALF + m * 16) * ldc + col0;
                const f32x4 a0 = swiglu4(acc[ai][0][m][0], acc[ai][1][m][0]), a1 = swiglu4(acc[ai][0][m][1], acc[ai][1][m][1]);
                *(u32x4*)rowp = pack8(a0, a1); }
    }
};
struct EpiQKV {
    static constexpr bool PERM = true, AFTER_DRAIN = false;
    bf16_t* Q; bf16_t* Kk; bf16_t* V; int ldc; const float* rope; float qscale;
    __device__ __forceinline__ void operator()(const f32x4 (&acc)[2][2][4][2], const Unit& u, int wr, int wc, int fr, int fq) const {
        const int row0 = u.pm * BM + wr * 64 + fr;
        if (u.pn < 16) {
            bf16_t* base = (u.pn < 8) ? Q : Kk; const float sc = (u.pn < 8) ? qscale : 1.0f; const int col0 = (u.pn & 7) * BM + wc * 64 + 8 * fq;
#pragma unroll
            for (int ai = 0; ai < 2; ++ai)
#pragma unroll
                for (int m = 0; m < 4; ++m) { const int r = row0 + ai * HALF + m * 16; const float* cs = rope + (size_t)r * 64 + 8 * fq;
                    const f32x4 c0 = *(const f32x4*)(cs), c1 = *(const f32x4*)(cs + 4), s0 = *(const f32x4*)(cs + 32), s1 = *(const f32x4*)(cs + 36);
                    const f32x4 x10 = acc[ai][0][m][0], x11 = acc[ai][0][m][1], x20 = acc[ai][1][m][0], x21 = acc[ai][1][m][1];
                    const f32x4 o10 = (x10 * c0 - x20 * s0) * sc, o11 = (x11 * c1 - x21 * s1) * sc, o20 = (x20 * c0 + x10 * s0) * sc, o21 = (x21 * c1 + x11 * s1) * sc;
                    bf16_t* rowp = base + (size_t)r * ldc + col0;
                    *(u32x4*)rowp = pack8(o10, o11); *(u32x4*)(rowp + 32) = pack8(o20, o21); }
        } else {
            const int col0 = (u.pn - 16) * BM + wc * 32 + 8 * fq;
#pragma unroll
            for (int ai = 0; ai < 2; ++ai)
#pragma unroll
                for (int m = 0; m < 4; ++m) { bf16_t* rowp = V + (size_t)(row0 + ai * HALF + m * 16) * ldc + col0;
#pragma unroll
                    for (int bj = 0; bj < 2; ++bj) *(u32x4*)(rowp + bj * HALF) = pack8(acc[ai][bj][m][0], acc[ai][bj][m][1]); }
        }
    }
};
__device__ __forceinline__ f32x4 cvti4(f32x4 a, float f) { return __builtin_convertvector(__builtin_bit_cast(v4i_t, a), f32x4) * f; }
struct EpiQKVq {
    static constexpr bool PERM = true, AFTER_DRAIN = false;
    bf16_t* Q; bf16_t* Kk; bf16_t* V; int ldc; const float* rope; float qscale; const float* rowscale; float sw;
    __device__ __forceinline__ void operator()(const f32x4 (&acc)[2][2][4][2], const Unit& u, int wr, int wc, int fr, int fq) const {
        const int row0 = u.pm * BM + wr * 64 + fr;
        if (u.pn < 16) {
            bf16_t* base = (u.pn < 8) ? Q : Kk; const float sc = (u.pn < 8) ? qscale : 1.0f; const int col0 = (u.pn & 7) * BM + wc * 64 + 8 * fq;
#pragma unroll
            for (int ai = 0; ai < 2; ++ai)
#pragma unroll
                for (int m = 0; m < 4; ++m) { const int r = row0 + ai * HALF + m * 16; const float* cs = rope + (size_t)r * 64 + 8 * fq; const float f = rowscale[r] * sw;
                    const f32x4 c0 = *(const f32x4*)(cs), c1 = *(const f32x4*)(cs + 4), s0 = *(const f32x4*)(cs + 32), s1 = *(const f32x4*)(cs + 36);
                    const f32x4 x10 = cvti4(acc[ai][0][m][0], f), x11 = cvti4(acc[ai][0][m][1], f), x20 = cvti4(acc[ai][1][m][0], f), x21 = cvti4(acc[ai][1][m][1], f);
                    const f32x4 o10 = (x10 * c0 - x20 * s0) * sc, o11 = (x11 * c1 - x21 * s1) * sc, o20 = (x20 * c0 + x10 * s0) * sc, o21 = (x21 * c1 + x11 * s1) * sc;
                    bf16_t* rowp = base + (size_t)r * ldc + col0;
                    *(u32x4*)rowp = pack8(o10, o11); *(u32x4*)(rowp + 32) = pack8(o20, o21); }
        } else {
            const int col0 = (u.pn - 16) * BM + wc * 32 + 8 * fq;
#pragma unroll
            for (int ai = 0; ai < 2; ++ai)
#pragma unroll
                for (int m = 0; m < 4; ++m) { const int r = row0 + ai * HALF + m * 16; bf16_t* rowp = V + (size_t)r * ldc + col0; const float f = rowscale[r] * sw;
#pragma unroll
                    for (int bj = 0; bj < 2; ++bj) *(u32x4*)(rowp + bj * HALF) = pack8(cvti4(acc[ai][bj][m][0], f), cvti4(acc[ai][bj][m][1], f)); }
        }
    }
};
struct EpiResBq {
    static constexpr bool PERM = true, AFTER_DRAIN = false;
    bf16_t* xr; int ldc; const float* rowscale; float sw;
    __device__ __forceinline__ void operator()(const f32x4 (&acc)[2][2][4][2], const Unit& u, int wr, int wc, int fr, int fq) const {
        const int row0 = u.pm * BM + wr * 64 + fr, col0 = u.pn * BM + wc * 32 + 8 * fq;
#pragma unroll
        for (int ai = 0; ai < 2; ++ai) { u32x4 r[4][2]; float f[4];
#pragma unroll
            for (int m = 0; m < 4; ++m) { const int rr = row0 + ai * HALF + m * 16; const size_t off = (size_t)rr * ldc + col0; f[m] = rowscale[rr] * sw;
#pragma unroll
                for (int bj = 0; bj < 2; ++bj) r[m][bj] = *(const u32x4*)(xr + off + bj * HALF); }
#pragma unroll
            for (int m = 0; m < 4; ++m) { const size_t off = (size_t)(row0 + ai * HALF + m * 16) * ldc + col0;
#pragma unroll
                for (int bj = 0; bj < 2; ++bj) *(u32x4*)(xr + off + bj * HALF) = pack8(bf4lo(r[m][bj].x, r[m][bj].y) + cvti4(acc[ai][bj][m][0], f[m]), bf4lo(r[m][bj].z, r[m][bj].w) + cvti4(acc[ai][bj][m][1], f[m])); }
            asm volatile("" ::: "memory"); }
    }
};
__device__ __forceinline__ unsigned pk_fp8x4(float a, float b, float c, float d) { unsigned w = 0u; w = (unsigned)__builtin_amdgcn_cvt_pk_fp8_f32(a, b, (int)w, false); w = (unsigned)__builtin_amdgcn_cvt_pk_fp8_f32(c, d, (int)w, true); return w; }
typedef unsigned u32x2 __attribute__((ext_vector_type(2)));
struct EpiSwiGLU8 {
    static constexpr bool PERM = true, AFTER_DRAIN = false;
    unsigned char* O; int ldc; float s;
    __device__ __forceinline__ void operator()(const f32x4 (&acc)[2][2][4][2], const Unit& u, int wr, int wc, int fr, int fq) const {
        const int row0 = u.pm * BM + wr * 64 + fr, col0 = u.pn * HALF + wc * 32 + 8 * fq;
#pragma unroll
        for (int ai = 0; ai < 2; ++ai)
#pragma unroll
            for (int m = 0; m < 4; ++m) { unsigned char* rowp = O + (size_t)(row0 + ai * HALF + m * 16) * ldc + col0;
                const f32x4 a0 = swiglu4(acc[ai][0][m][0] * s, acc[ai][1][m][0] * s), a1 = swiglu4(acc[ai][0][m][1] * s, acc[ai][1][m][1] * s);
                u32x2 w; w.x = pk_fp8x4(a0[0], a0[1], a0[2], a0[3]); w.y = pk_fp8x4(a1[0], a1[1], a1[2], a1[3]);
                *(u32x2*)rowp = w; }
    }
};
struct EpiSwiGLUq {
    static constexpr bool PERM = true, AFTER_DRAIN = false;
    unsigned char* O; int ldc; const float* rowscale; float sg, su;
    __device__ __forceinline__ void operator()(const f32x4 (&acc)[2][2][4][2], const Unit& u, int wr, int wc, int fr, int fq) const {
        const int row0 = u.pm * BM + wr * 64 + fr, col0 = u.pn * HALF + wc * 32 + 8 * fq;
#pragma unroll
        for (int ai = 0; ai < 2; ++ai)
#pragma unroll
            for (int m = 0; m < 4; ++m) { const int r = row0 + ai * HALF + m * 16; unsigned char* rowp = O + (size_t)r * ldc + col0; const float rs = rowscale[r]; const float fg = rs * sg, fu = rs * su;
                const f32x4 g0 = __builtin_convertvector(__builtin_bit_cast(v4i_t, acc[ai][0][m][0]), f32x4) * fg, g1 = __builtin_convertvector(__builtin_bit_cast(v4i_t, acc[ai][0][m][1]), f32x4) * fg;
                const f32x4 u0 = __builtin_convertvector(__builtin_bit_cast(v4i_t, acc[ai][1][m][0]), f32x4) * fu, u1 = __builtin_convertvector(__builtin_bit_cast(v4i_t, acc[ai][1][m][1]), f32x4) * fu;
                const f32x4 a0 = swiglu4(g0, u0), a1 = swiglu4(g1, u1);
                u32x2 w; w.x = pk_fp8x4(a0[0], a0[1], a0[2], a0[3]); w.y = pk_fp8x4(a1[0], a1[1], a1[2], a1[3]);
                *(u32x2*)rowp = w; }
    }
};
struct EpiQKVq8 {
    static constexpr bool PERM = true, AFTER_DRAIN = false;
    unsigned char* Q; unsigned char* Kk; int ldc; const float* rope; float qscale; const float* rowscale; float sw;
    __device__ __forceinline__ void operator()(const f32x4 (&acc)[2][2][4][2], const Unit& u, int wr, int wc, int fr, int fq) const {
        const int row0 = u.pm * BM + wr * 64 + fr;
        unsigned char* base = (u.pn < 8) ? Q : Kk; const float sc = (u.pn < 8) ? qscale : 1.0f; const int col0 = (u.pn & 7) * BM + wc * 64 + 8 * fq;
#pragma unroll
        for (int ai = 0; ai < 2; ++ai)
#pragma unroll
            for (int m = 0; m < 4; ++m) { const int r = row0 + ai * HALF + m * 16; const float* cs = rope + (size_t)r * 64 + 8 * fq; const float f = rowscale[r] * sw;
                const f32x4 c0 = *(const f32x4*)(cs), c1 = *(const f32x4*)(cs + 4), s0 = *(const f32x4*)(cs + 32), s1 = *(const f32x4*)(cs + 36);
                const f32x4 x10 = cvti4(acc[ai][0][m][0], f), x11 = cvti4(acc[ai][0][m][1], f), x20 = cvti4(acc[ai][1][m][0], f), x21 = cvti4(acc[ai][1][m][1], f);
                const f32x4 o10 = (x10 * c0 - x20 * s0) * sc, o11 = (x11 * c1 - x21 * s1) * sc, o20 = (x20 * c0 + x10 * s0) * sc, o21 = (x21 * c1 + x11 * s1) * sc;
                unsigned char* rowp = base + (size_t)r * ldc + col0;
                u32x2 w1, w2; w1.x = pk_fp8x4(o10[0], o10[1], o10[2], o10[3]); w1.y = pk_fp8x4(o11[0], o11[1], o11[2], o11[3]); w2.x = pk_fp8x4(o20[0], o20[1], o20[2], o20[3]); w2.y = pk_fp8x4(o21[0], o21[1], o21[2], o21[3]);
                *(u32x2*)rowp = w1; *(u32x2*)(rowp + 32) = w2; }
    }
};
struct EpiVT {
    static constexpr bool PERM = true, AFTER_DRAIN = false;
    unsigned char* VT; const float* rowscale; float sw; int seq;
    __device__ __forceinline__ void operator()(const f32x4 (&acc)[2][2][4][2], const Unit& u, int wr, int wc, int fr, int fq) const {
        const int row0 = u.pm * BM + wr * 64 + fr;
#pragma unroll
        for (int bj = 0; bj < 2; ++bj) { const int c0 = u.pn * BM + bj * HALF + wc * 32 + 8 * fq;
            const f32x4 s0 = *(const f32x4*)(rowscale + c0) * sw, s1 = *(const f32x4*)(rowscale + c0 + 4) * sw;
            const int b = c0 / seq, pos = c0 % seq, k0 = pos & 63; const int basep = (pos & ~63) + 16 * ((k0 >> 5) & 1) + 4 * ((k0 & 31) >> 3);
#pragma unroll
            for (int ai = 0; ai < 2; ++ai)
#pragma unroll
                for (int m = 0; m < 4; ++m) { const int r = row0 + ai * HALF + m * 16;
                    const f32x4 v0 = __builtin_convertvector(__builtin_bit_cast(v4i_t, acc[ai][bj][m][0]), f32x4) * s0, v1 = __builtin_convertvector(__builtin_bit_cast(v4i_t, acc[ai][bj][m][1]), f32x4) * s1;
                    unsigned char* p = VT + ((size_t)(b * 16 + (r >> 7)) * 128 + (r & 127)) * seq + basep;
                    *(unsigned*)p = pk_fp8x4(v0[0], v0[1], v0[2], v0[3]); *(unsigned*)(p + 32) = pk_fp8x4(v1[0], v1[1], v1[2], v1[3]); } }
    }
};
struct EpiPlainS {
    static constexpr bool PERM = true, AFTER_DRAIN = false;
    bf16_t* O; int ldc; float s;
    __device__ __forceinline__ void operator()(const f32x4 (&acc)[2][2][4][2], const Unit& u, int wr, int wc, int fr, int fq) const {
        const int row0 = u.pm * BM + wr * 64 + fr, col0 = u.pn * BM + wc * 32 + 8 * fq;
#pragma unroll
        for (int ai = 0; ai < 2; ++ai)
#pragma unroll
            for (int m = 0; m < 4; ++m) { bf16_t* rowp = O + (size_t)(row0 + ai * HALF + m * 16) * ldc + col0;
#pragma unroll
                for (int bj = 0; bj < 2; ++bj) *(u32x4*)(rowp + bj * HALF) = pack8(acc[ai][bj][m][0] * s, acc[ai][bj][m][1] * s); }
    }
};
struct MoeOrder : StaticOrder {
    int tile0; const volatile PG8_LAS int* texp;
    __device__ __forceinline__ bool next(int i, Unit& u) const {
        if (!StaticOrder::next(i, u)) return false;
        u.be = __builtin_amdgcn_readfirstlane(texp[tile0 + u.pm]); return true;
    }
};
typedef int v4i_t __attribute__((ext_vector_type(4))); typedef int v8i_t __attribute__((ext_vector_type(8)));
__device__ __forceinline__ void mma8(f32x4& c, bf16x8 b0, bf16x8 b1, bf16x8 a0, bf16x8 a1, int sc) {
    const v4i_t x0 = __builtin_bit_cast(v4i_t, b0), x1 = __builtin_bit_cast(v4i_t, b1), y0 = __builtin_bit_cast(v4i_t, a0), y1 = __builtin_bit_cast(v4i_t, a1);
    const v8i_t X = __builtin_shufflevector(x0, x1, 0, 1, 2, 3, 4, 5, 6, 7), Y = __builtin_shufflevector(y0, y1, 0, 1, 2, 3, 4, 5, 6, 7);
    asm volatile("v_mfma_scale_f32_16x16x128_f8f6f4 %0, %1, %2, %0, %3, %3 op_sel_hi:[0,0,0]" : "+v"(c) : "v"(X), "v"(Y), "v"(sc));
}
__device__ __forceinline__ f32x4 mma_i8(bf16x8 b, bf16x8 a, f32x4 c) {
    return __builtin_bit_cast(f32x4, __builtin_amdgcn_mfma_i32_16x16x64_i8(__builtin_bit_cast(v4i_t, b), __builtin_bit_cast(v4i_t, a), __builtin_bit_cast(v4i_t, c), 0, 0, 0));
}
template <class Epi, class Sched, bool ALIGN_EPI = false, bool SP2 = false, bool FP8 = false, bool I8 = false>
__device__ __forceinline__ void gemm_phase(PG8_LAS unsigned char* lds, const Gemm g, const Sched& S, const Epi& E) {
    int tid_ = threadIdx.x; asm volatile("" : "+v"(tid_));
    const int tid = tid_, wid = __builtin_amdgcn_readfirstlane(tid >> 6), lane = tid & 63, wr = wid >> 2, wc = wid & 3, fr = lane & 15, fq = lane >> 4;
    const int K = g.K, nt = K / BK;
    unsigned voffA[2], voffB[2];
#pragma unroll
    for (int i = 0; i < 2; ++i) { int R, C; stage_rc(tid * 16 + i * 8192, R, C); const int Rb = Epi::PERM ? ((R & ~31) + perm32(R & 31)) : R;
        voffA[i] = (unsigned)(R * K + C) * 2u; voffB[i] = (unsigned)(Rb * K + C) * 2u; }
    const size_t kstep = (size_t)(BK * 2);
    const size_t hstep = (size_t)HALF * K * 2;
    const size_t tstep = 2 * hstep;
    const unsigned ldsw = (unsigned)wid * 1024u;
    const int aoff = lds_byte(wr * 64 + fr, fq * 8), boff = lds_byte(wc * 32 + fr, fq * 8);
#define PG8_SA(b, h) (((b) * 2 + (h)) * HTB)
#define PG8_SB(b, h) ((4 + (b) * 2 + (h)) * HTB)
#define PG8_STAGE(bufoff, gbase, voff) do { _Pragma("unroll") for (int _i = 0; _i < 2; ++_i) \
        __builtin_amdgcn_global_load_lds((const unsigned*)((const char*)(gbase) + (voff)[_i]), (PG8_LAS unsigned*)(lds + (bufoff) + ldsw + _i * 8192), 16, 0, 0); } while (0)
#define PG8_LDA(dst, b, h) do { _Pragma("unroll") for (int m = 0; m < 4; ++m) _Pragma("unroll") for (int k = 0; k < 2; ++k) dst[m][k] = *(const PG8_LAS bf16x8*)(lds + PG8_SA(b, h) + aoff + m * 2048 + k * 1024); } while (0)
#define PG8_LDB(dst, b, h) do { _Pragma("unroll") for (int n = 0; n < 2; ++n) _Pragma("unroll") for (int k = 0; k < 2; ++k) dst[n][k] = *(const PG8_LAS bf16x8*)(lds + PG8_SB(b, h) + boff + n * 2048 + k * 1024); } while (0)
#define PG8_MMA(ai, bj, At, Bt) do { __builtin_amdgcn_s_setprio(1); _Pragma("unroll") for (int m = 0; m < 4; ++m) _Pragma("unroll") for (int n = 0; n < 2; ++n) { \
        if constexpr (FP8) mma8(acc[ai][bj][m][n], Bt[n][0], Bt[n][1], At[m][0], At[m][1], sc8); \
        else if constexpr (I8) { _Pragma("unroll") for (int k = 0; k < 2; ++k) acc[ai][bj][m][n] = mma_i8(Bt[n][k], At[m][k], acc[ai][bj][m][n]); } \
        else { _Pragma("unroll") for (int k = 0; k < 2; ++k) acc[ai][bj][m][n] = __builtin_amdgcn_mfma_f32_16x16x32_bf16(Bt[n][k], At[m][k], acc[ai][bj][m][n], 0, 0, 0); } } __builtin_amdgcn_s_setprio(0); } while (0)
#define PG8_WAIT_V(n) asm volatile("s_waitcnt vmcnt(" #n ")" ::: "memory")
#define PG8_WAIT_L(n) asm volatile("s_waitcnt lgkmcnt(" #n ")" ::: "memory")
#define PG8_BAR __builtin_amdgcn_s_barrier()
#define PG8_SCHED __builtin_amdgcn_sched_barrier(0)
    int sc8 = 0x7F7F7F7F; asm volatile("" : "+v"(sc8));
    Unit cur, nxt; int ui = 0;
    if (!S.next(0, cur)) return;
    f32x4 acc[2][2][4][2];
#pragma unroll
    for (int a = 0; a < 2; ++a)
#pragma unroll
        for (int b = 0; b < 2; ++b)
#pragma unroll
            for (int m = 0; m < 4; ++m)
#pragma unroll
                for (int n = 0; n < 2; ++n) acc[a][b][m][n] = (f32x4){0.f, 0.f, 0.f, 0.f};
    bf16x8 At[4][2], B0[2][2], B1[2][2];
    const char* cA = (const char*)g.A + (size_t)cur.pm * tstep; const char* cB = (const char*)g.Bt + (size_t)cur.be * g.bstride + (size_t)cur.pn * tstep;
    S.a_ready(cur);
    if constexpr (SP2) {
        PG8_STAGE(PG8_SB(0, 0), cB, voffB); PG8_STAGE(PG8_SB(0, 1), cB + hstep, voffB); PG8_STAGE(PG8_SA(0, 0), cA, voffA); PG8_STAGE(PG8_SA(0, 1), cA + hstep, voffA);
        if (wr == 1) PG8_BAR;
        PG8_WAIT_V(2); PG8_BAR;
        PG8_STAGE(PG8_SB(1, 0), cB + kstep, voffB); PG8_STAGE(PG8_SA(1, 0), cA + kstep, voffA); PG8_STAGE(PG8_SB(1, 1), cB + hstep + kstep, voffB);
        PG8_WAIT_V(6); PG8_BAR;
    } else {
        PG8_STAGE(PG8_SB(0, 0), cB, voffB); PG8_STAGE(PG8_SA(0, 0), cA, voffA); PG8_STAGE(PG8_SB(0, 1), cB + hstep, voffB); PG8_STAGE(PG8_SA(0, 1), cA + hstep, voffA);
        if (wr == 1) PG8_BAR;
        PG8_WAIT_V(4); PG8_BAR;
        PG8_STAGE(PG8_SB(1, 0), cB + kstep, voffB); PG8_STAGE(PG8_SA(1, 0), cA + kstep, voffA); PG8_STAGE(PG8_SB(1, 1), cB + hstep + kstep, voffB);
        PG8_WAIT_V(6); PG8_BAR;
    }
    for (;;) {
        const bool has_next = S.next(ui + 1, nxt);
        const char* nA = has_next ? (const char*)g.A + (size_t)nxt.pm * tstep : cA; const char* nB = has_next ? (const char*)g.Bt + (size_t)nxt.be * g.bstride + (size_t)nxt.pn * tstep : cB;
        for (int t = 0; t < nt; t += 2) {
            const bool last = (t == nt - 2);
            const char* a1 = cA + (size_t)(t + 1) * kstep;
            const char* a2 = last ? nA : cA + (size_t)(t + 2) * kstep; const char* b2 = last ? nB : cB + (size_t)(t + 2) * kstep;
            const char* a3 = a2 + kstep; const char* b3 = b2 + kstep;
            if (last && has_next) S.a_ready(nxt);
            if constexpr (SP2) {
            PG8_LDB(B0, 0, 0); PG8_LDB(B1, 0, 1); PG8_SCHED; PG8_LDA(At, 0, 0); PG8_STAGE(PG8_SA(1, 1), a1 + hstep, voffA);
            PG8_WAIT_V(8); PG8_WAIT_L(0); PG8_BAR; PG8_MMA(0, 0, At, B0); PG8_MMA(0, 1, At, B1); PG8_BAR; PG8_SCHED;
            PG8_LDA(At, 0, 1); PG8_STAGE(PG8_SB(0, 0), b2, voffB); PG8_STAGE(PG8_SB(0, 1), b2 + hstep, voffB); PG8_STAGE(PG8_SA(0, 0), a2, voffA);
            PG8_WAIT_V(8); PG8_WAIT_L(0); PG8_BAR; PG8_MMA(1, 0, At, B0); PG8_MMA(1, 1, At, B1); PG8_BAR; PG8_SCHED;
            PG8_LDB(B0, 1, 0); PG8_LDB(B1, 1, 1); PG8_SCHED; PG8_LDA(At, 1, 0); PG8_STAGE(PG8_SA(0, 1), a2 + hstep, voffA);
            PG8_WAIT_V(8); PG8_WAIT_L(0); PG8_BAR; PG8_MMA(0, 0, At, B0); PG8_MMA(0, 1, At, B1); PG8_BAR; PG8_SCHED;
            PG8_LDA(At, 1, 1); PG8_STAGE(PG8_SB(1, 0), b3, voffB); PG8_STAGE(PG8_SB(1, 1), b3 + hstep, voffB); PG8_STAGE(PG8_SA(1, 0), a3, voffA);
            PG8_WAIT_V(8); PG8_WAIT_L(0); PG8_BAR; PG8_MMA(1, 0, At, B0); PG8_MMA(1, 1, At, B1); PG8_BAR; PG8_SCHED;
            } else {
            PG8_LDB(B0, 0, 0); PG8_SCHED; PG8_LDA(At, 0, 0); PG8_STAGE(PG8_SA(1, 1), a1 + hstep, voffA);
            PG8_WAIT_L(8); PG8_BAR; PG8_WAIT_L(0); PG8_MMA(0, 0, At, B0); PG8_BAR; PG8_SCHED;
            PG8_LDB(B1, 0, 1); PG8_STAGE(PG8_SB(0, 0), b2, voffB);
            PG8_BAR; PG8_WAIT_L(0); PG8_MMA(0, 1, At, B1); PG8_BAR;
            PG8_LDA(At, 0, 1); PG8_STAGE(PG8_SA(0, 0), a2, voffA);
            PG8_BAR; PG8_WAIT_L(0); PG8_MMA(1, 0, At, B0); PG8_BAR; PG8_SCHED;
            PG8_STAGE(PG8_SB(0, 1), b2 + hstep, voffB);
            PG8_WAIT_V(6); PG8_BAR; PG8_MMA(1, 1, At, B1); PG8_BAR;
            PG8_LDB(B0, 1, 0); PG8_SCHED; PG8_LDA(At, 1, 0); PG8_STAGE(PG8_SA(0, 1), a2 + hstep, voffA);
            PG8_WAIT_L(8); PG8_BAR; PG8_WAIT_L(0); PG8_MMA(0, 0, At, B0); PG8_BAR; PG8_SCHED;
            PG8_LDB(B1, 1, 1); PG8_STAGE(PG8_SB(1, 0), b3, voffB);
            PG8_BAR; PG8_WAIT_L(0); PG8_MMA(0, 1, At, B1); PG8_BAR;
            PG8_LDA(At, 1, 1); PG8_STAGE(PG8_SA(1, 0), a3, voffA);
            PG8_BAR; PG8_WAIT_L(0); PG8_MMA(1, 0, At, B0); PG8_BAR; PG8_SCHED;
            PG8_STAGE(PG8_SB(1, 1), b3 + hstep, voffB);
            PG8_WAIT_V(6); PG8_BAR; PG8_MMA(1, 1, At, B1); PG8_BAR;
            }
        }
        if constexpr (ALIGN_EPI) { if (wr == 0) PG8_BAR; }
        if constexpr (FP8) asm volatile("s_nop 15\n\ts_nop 15" ::: "memory");
        if constexpr (!Epi::AFTER_DRAIN) { E(acc, cur, wr, wc, fr, fq); S.done(cur); }
        if (!has_next) break;
#pragma unroll
        for (int a = 0; a < 2; ++a)
#pragma unroll
            for (int b = 0; b < 2; ++b)
#pragma unroll
                for (int m = 0; m < 4; ++m)
#pragma unroll
                    for (int n = 0; n < 2; ++n) acc[a][b][m][n] = (f32x4){0.f, 0.f, 0.f, 0.f};
        cur = nxt; cA = nA; cB = nB; ++ui;
        if constexpr (ALIGN_EPI) { if (wr == 1) PG8_BAR; }
    }
    PG8_WAIT_V(0);
    if constexpr (!ALIGN_EPI) { if (wr == 0) PG8_BAR; }
    PG8_BAR;
    if constexpr (Epi::AFTER_DRAIN) { E.fused(acc, cur, wr, wc, fr, fq, lds, wid, lane); S.done(cur); }
#undef PG8_SA
#undef PG8_SB
#undef PG8_STAGE
#undef PG8_LDA
#undef PG8_LDB
#undef PG8_MMA
#undef PG8_WAIT_V
#undef PG8_WAIT_L
#undef PG8_BAR
#undef PG8_SCHED
}
}

#ifndef PG8_SP2
#define PG8_SP2 true
#endif
#include <hip/hip_bf16.h>
#include <cmath>
namespace attn_body {
using bf16=__hip_bfloat16;
using bf16x8=__attribute__((ext_vector_type(8)))short;
using s16x4=__attribute__((ext_vector_type(4)))short;
using f32x16=__attribute__((ext_vector_type(16)))float;
using u32x4=__attribute__((ext_vector_type(4)))unsigned;
constexpr int BATCH=2,NHEAD=16,SEQ=16384,D=64,DM=2048;
constexpr int NW=8,QBLK=32,QB=QBLK*NW,KVBLK=64,NQB=SEQ/QB;
constexpr int ATTN_PITCH=DM, ATTN_UNIT_ROWS=QB;
__device__ __forceinline__ int crow(int r,int hi){return (r&3)+8*(r>>2)+4*hi;}
#define SBAR() __builtin_amdgcn_sched_barrier(0)
__device__ __forceinline__ void cmask(f32x16&p0,f32x16&p1,int jb,int qrel,int hi){
  const float NEG=-INFINITY; int kb=64*jb+4*hi;
  #pragma unroll
  for(int r=0;r<16;++r){int kv=kb+(r&3)+8*(r>>2); if(kv>qrel)p0[r]=NEG; if(kv+32>qrel)p1[r]=NEG;}
}

constexpr int NSLOT=3, SLOTB=8192;
constexpr int LDS_K=0, LDS_V=NSLOT*SLOTB, LDS_WS=2*NSLOT*SLOTB, LDS_OST=LDS_WS+NW*64*4, LDS_BYTES=LDS_OST+NW*4096;
constexpr int ATTN_PARAM_OFF=131072+2048;
constexpr float C2=0.125f*1.4426950408889634f;
__device__ __forceinline__ void glds16(const void*gsrc,unsigned lds_dst){unsigned keep;
  asm volatile("s_mov_b32 %0, m0\n\ts_mov_b32 m0, %2\n\ts_nop 0\n\tglobal_load_lds_dwordx4 %1, off\n\ts_mov_b32 m0, %0":"=&s"(keep):"v"(gsrc),"s"(lds_dst):"memory");}
__device__ __forceinline__ float max3f(float a,float b,float c){float r;asm("v_max3_f32 %0, %1, %2, %3":"=v"(r):"v"(a),"v"(b),"v"(c));return r;}
__device__ __forceinline__ float max2f(float a,float b){float r;asm("v_max_f32_e32 %0, %1, %2":"=v"(r):"v"(a),"v"(b));return r;}
__device__ __forceinline__ float fadd_s(float a,float b){float r;asm("v_add_f32_e32 %0, %1, %2":"=v"(r):"v"(a),"v"(b));return r;}
__device__ __forceinline__ float fsub_s(float a,float b){float r;asm("v_sub_f32_e32 %0, %1, %2":"=v"(r):"v"(a),"v"(b));return r;}
typedef float f32x2_t __attribute__((ext_vector_type(2))); typedef __bf16 bf16x2_t __attribute__((ext_vector_type(2)));
__device__ __forceinline__ unsigned cvtpk_s(float lo,float hi){f32x2_t v={lo,hi};bf16x2_t b=__builtin_convertvector(v,bf16x2_t);return __builtin_bit_cast(unsigned,b);}
__device__ __forceinline__ void glds16s(const void*sbase,unsigned voff,unsigned lds_dst){unsigned keep;
  asm volatile("s_mov_b32 %0, m0\n\ts_mov_b32 m0, %2\n\ts_nop 0\n\tglobal_load_lds_dwordx4 %1, %3\n\ts_mov_b32 m0, %0":"=&s"(keep):"v"(voff),"s"(lds_dst),"s"(sbase):"memory");}
#define WAIT_BAR(N) asm volatile("s_waitcnt vmcnt(" #N ") lgkmcnt(0)\n\ts_barrier":::"memory")

__device__ __forceinline__ void qkt(f32x16&p0,f32x16&p1,const char*Kslot,const bf16x8*qr,const f32x16&negm,int r32,int hi){
  const char*kb=Kslot+hi*1024+r32*16;
  #pragma unroll
  for(int d0=0;d0<4;++d0){
    const bf16x8 b0=*reinterpret_cast<const bf16x8*>(kb+d0*2048);
    const bf16x8 b1=*reinterpret_cast<const bf16x8*>(kb+d0*2048+512);
    if(d0==0){p0=__builtin_amdgcn_mfma_f32_32x32x16_bf16(b0,qr[0],negm,0,0,0);p1=__builtin_amdgcn_mfma_f32_32x32x16_bf16(b1,qr[0],negm,0,0,0);}
    else{p0=__builtin_amdgcn_mfma_f32_32x32x16_bf16(b0,qr[d0],p0,0,0,0);p1=__builtin_amdgcn_mfma_f32_32x32x16_bf16(b1,qr[d0],p1,0,0,0);}}
}
typedef __attribute__((address_space(3))) const char* lds_cptr;
typedef short v4i16_t __attribute__((ext_vector_type(4)));
__device__ __forceinline__ void kload8(bf16x8*kf,lds_cptr kp){
  kf[0]=*(const __attribute__((address_space(3))) bf16x8*)(kp);      kf[1]=*(const __attribute__((address_space(3))) bf16x8*)(kp+512);
  kf[2]=*(const __attribute__((address_space(3))) bf16x8*)(kp+2048); kf[3]=*(const __attribute__((address_space(3))) bf16x8*)(kp+2560);
  kf[4]=*(const __attribute__((address_space(3))) bf16x8*)(kp+4096); kf[5]=*(const __attribute__((address_space(3))) bf16x8*)(kp+4608);
  kf[6]=*(const __attribute__((address_space(3))) bf16x8*)(kp+6144); kf[7]=*(const __attribute__((address_space(3))) bf16x8*)(kp+6656);
}
__device__ __forceinline__ void kload2(bf16x8*kf,lds_cptr kp,int j){ kf[2*j]=*(const __attribute__((address_space(3))) bf16x8*)(kp+j*2048); kf[2*j+1]=*(const __attribute__((address_space(3))) bf16x8*)(kp+j*2048+512); }
__device__ __forceinline__ s16x4 vtr(lds_cptr p){ return __builtin_bit_cast(s16x4,__builtin_amdgcn_ds_read_tr16_b64_v4i16((__attribute__((address_space(3))) v4i16_t*)p)); }
__device__ __forceinline__ float rowmax(const f32x16&p0,const f32x16&p1){
  float a=max3f(p0[0],p0[1],p1[0]),b=max3f(p0[2],p0[3],p1[1]);a=max3f(a,p1[2],p1[3]);
  #pragma unroll
  for(int r=4;r<16;r+=4){a=max3f(a,p0[r],p0[r+1]);b=max3f(b,p0[r+2],p0[r+3]);a=max3f(a,p1[r],p1[r+1]);b=max3f(b,p1[r+2],p1[r+3]);}
  const float m=max2f(a,b);
  auto rr=__builtin_amdgcn_permlane32_swap(__float_as_uint(m),__float_as_uint(m),false,false);
  return max2f(__uint_as_float(rr[0]),__uint_as_float(rr[1]));
}
typedef int v8i_a __attribute__((ext_vector_type(8))); typedef int v4i_a __attribute__((ext_vector_type(4)));
#define MFMA8(ACC,A,B) asm volatile("s_nop 1\n\tv_mfma_scale_f32_32x32x64_f8f6f4 %0, %1, %2, %0, %3, %3 op_sel_hi:[0,0,0]":"+v"(ACC):"v"(A),"v"(B),"v"(sc8_))
#ifndef ATTN_STORE16
#define ATTN_STORE16(p,v) (*(u32x4*)(p)=(v))
#endif
template<int THRL,bool TRAIL> __device__ __forceinline__ void attn_unit(int b,int h,int qb,const unsigned char*Q,const unsigned char*__restrict__ K,const unsigned char*__restrict__ VT,bf16*O,char*shm){
  int tid_=threadIdx.x; asm volatile("":"+v"(tid_)); const int tid=tid_,lane=tid&63,r32=lane&31,hi=lane>>5; const int wid=__builtin_amdgcn_readfirstlane(tid>>6);
  const long rowbase=(long)b*SEQ; const int q0=qb*QB;
  const unsigned char*Qw=Q+(rowbase+q0+wid*QBLK)*DM+h*D;
  const unsigned char*Kh=K+rowbase*DM+h*D;
  const unsigned lds0=(unsigned)(uintptr_t)shm;
  float*wsf=(float*)(shm+LDS_WS)+wid*64;
  const int krow_=8*wid+((lane&31)>>2); const unsigned koff=(unsigned)(krow_*DM+(((lane&3)^((krow_>>2)&3))*16));
  const int vrow_=16*wid+(lane>>2); const unsigned voff=(unsigned)(vrow_*SEQ+(((lane&3)^((vrow_>>2)&3))*16));
  const unsigned kdst=lds0+LDS_K+wid*512, vdst=lds0+LDS_V+wid*1024;
  #define DMA_K(t,slot) do{ if(lane<32) glds16s(Kh+(long)(t)*KVBLK*DM,koff,(unsigned)__builtin_amdgcn_readfirstlane(kdst+(slot))); }while(0)
  #define DMA_V(t,slot) glds16s(VT+(long)(t)*KVBLK,voff,(unsigned)__builtin_amdgcn_readfirstlane(vdst+(slot)))
  int sc8_=0x7F7F7F7F; asm volatile("":"+v"(sc8_));
  v8i_a kf0,kf1;
  const lds_cptr shm3=(lds_cptr)shm; const lds_cptr kpa=shm3+LDS_K+r32*64+(((2*hi)^((r32>>2)&3))*16), kpb=shm3+LDS_K+r32*64+(((2*hi+1)^((r32>>2)&3))*16); const lds_cptr vpa=shm3+LDS_V+r32*64+(((2*hi)^((r32>>2)&3))*16), vpb=shm3+LDS_V+r32*64+(((2*hi+1)^((r32>>2)&3))*16);
  const int NT=(q0+QB)/KVBLK;
  DMA_K(0,0);DMA_V(0,0);DMA_K(1,SLOTB);
  v8i_a qf; { const v4i_a a_=*reinterpret_cast<const v4i_a*>(Qw+(long)r32*DM+32*hi), b_=*reinterpret_cast<const v4i_a*>(Qw+(long)r32*DM+32*hi+16); qf=__builtin_shufflevector(a_,b_,0,1,2,3,4,5,6,7); }
  #define KLD(KF,n,SL) do{ const v4i_a a_=*(const __attribute__((address_space(3))) v4i_a*)(kpa+(SL)+(n)*2048), b_=*(const __attribute__((address_space(3))) v4i_a*)(kpb+(SL)+(n)*2048); KF=__builtin_shufflevector(a_,b_,0,1,2,3,4,5,6,7); }while(0)
  #define QK8(DD,KF) asm volatile("s_nop 1\n\tv_mfma_scale_f32_32x32x64_f8f6f4 %0, %1, %2, %3, %4, %4 op_sel_hi:[0,0,0]":"=&v"(DD):"v"(KF),"v"(qf),"v"(negm),"v"(sc8_))
  float mhat=0.f; float z_=0.f; asm volatile("":"+v"(z_)); const f32x16 zv_={z_,z_,z_,z_,z_,z_,z_,z_,z_,z_,z_,z_,z_,z_,z_,z_};     f32x16 o[4];o[0]=zv_;o[1]=zv_;o[2]=zv_;o[3]=zv_;f32x16 negm=zv_;asm volatile("":"+v"(negm)); f32x16 osum=zv_;
  int one8_=0x38383838; asm volatile("":"+v"(one8_)); const v8i_a onesv={one8_,one8_,one8_,one8_,one8_,one8_,one8_,one8_};
  const int qrel=wid*QBLK+r32;
  #define CMASK(P0,P1,t) do{int jb_=(t)-(NT-4); if(jb_>=0)cmask(P0,P1,jb_,qrel,hi);}while(0)
  bool resc=false;
  #define START(P0,P1) do{ const float rm=rowmax(P0,P1); resc=false; \
    { const float dl=rm; mhat=fadd_s(mhat,dl); \
      _Pragma("unroll") for(int r=0;r<16;++r){P0[r]=fsub_s(P0[r],dl);P1[r]=fsub_s(P1[r],dl);} \
      _Pragma("unroll") for(int r=0;r<16;++r)negm[r]=-mhat; asm volatile("":"+v"(negm)); } \
    _Pragma("unroll") for(int r=0;r<16;++r)P0[r]=__builtin_amdgcn_exp2f(P0[r]); }while(0)
  #define RESC() do{ if(resc){ asm volatile("s_waitcnt lgkmcnt(0)\n\ts_nop 15\n\ts_nop 15":::"memory"); \
      _Pragma("unroll") for(int r=0;r<16;++r){const float f_=wsf[crow(r,hi)]; o[0][r]*=f_;o[1][r]*=f_;o[2][r]*=f_;o[3][r]*=f_;osum[r]*=f_;} } }while(0)
  f32x16 pA0,pA1,pB0,pB1;
  int sl_prev=0,sl_cur=0,sl_next=SLOTB;
  #define ROT() do{sl_prev=sl_cur;sl_cur=sl_next;sl_next=(sl_next==(NSLOT-1)*SLOTB)?0:sl_next+SLOTB;}while(0)
  DMA_K(2,2*SLOTB);
  WAIT_BAR(4);
  KLD(kf0,0,0); KLD(kf1,1,0); QK8(pA0,kf0); QK8(pA1,kf1); asm volatile("s_nop 15\n\ts_nop 15":"+v"(pA0),"+v"(pA1));CMASK(pA0,pA1,0);
  START(pA0,pA1);
  _Pragma("unroll") for(int r=0;r<8;++r)pA1[r]=__builtin_amdgcn_exp2f(pA1[r]);
  WAIT_BAR(0);
  DMA_K(3,0);DMA_V(1,SLOTB);
  ROT();
  KLD(kf0,0,sl_cur); KLD(kf1,1,sl_cur);
  WAIT_BAR(2);
  v8i_a pfv=onesv, vf0, vf1, vf2, vf3;
  #define KEEP(x) asm volatile(""::"v"(x))
  #define PKF(i,P,B) do{ int w_=__builtin_amdgcn_cvt_pk_fp8_f32(P[B],P[B+1],pfv[i],false); pfv[i]=__builtin_amdgcn_cvt_pk_fp8_f32(P[B+2],P[B+3],w_,true); }while(0)
  #define PIN(x) asm volatile("":"+v"(x))
  #define MX3(a,b,c) __builtin_fmaxf(__builtin_fmaxf((a),(b)),(c))
  #define GAPA(MF,A0,A1,A2,A3,PK) do{ MF; PK; SBAR(); }while(0)
  #define EX(v) __builtin_amdgcn_exp2f(v)
  #define EX8(X,B) do{ X[B]=EX(X[B]); X[B+1]=EX(X[B+1]); X[B+2]=EX(X[B+2]); X[B+3]=EX(X[B+3]); X[B+4]=EX(X[B+4]); X[B+5]=EX(X[B+5]); X[B+6]=EX(X[B+6]); X[B+7]=EX(X[B+7]); PIN(X); }while(0)
  #define VLD(VF,db) do{ const v4i_a a_=*(const __attribute__((address_space(3))) v4i_a*)(vp_a_+(db)*2048), b_=*(const __attribute__((address_space(3))) v4i_a*)(vp_b_+(db)*2048); VF=__builtin_shufflevector(a_,b_,0,1,2,3,4,5,6,7); }while(0)
  #define KRDP(G,KF,n) do{ if(G){ KLD(KF,n,sl_next); } }while(0)
  #define SEC_A(C0,C1,P0,P1,VL) do{ \
    PKF(0,P0,0); PKF(1,P0,4); PKF(2,P0,8); PKF(3,P0,12); PKF(4,P1,0); PKF(5,P1,4); \
    QK8(C0,kf0); SBAR(); \
    if(VL){ VLD(vf0,0); KEEP(kf0); SBAR(); } \
    QK8(C1,kf1); EX8(P1,8); PKF(6,P1,8); PKF(7,P1,12); SBAR(); \
    PIN(pfv); asm volatile("s_nop 7":"+v"(C0),"+v"(C1)); }while(0)
  #define SEC_DMA(t,GK,GV) do{ if(GK){DMA_K((t)+3,sl_cur);} if(GV){DMA_V((t)+1,sl_next);} }while(0)
  #define SEC_MAX(C0,C1) do{ float a=MX3(C0[0],C0[1],C1[0]),b=MX3(C0[2],C0[3],C1[1]); a=MX3(a,C1[2],C1[3]); \
      _Pragma("unroll") for(int r=4;r<16;r+=4){a=MX3(a,C0[r],C0[r+1]);b=MX3(b,C0[r+2],C0[r+3]);a=MX3(a,C1[r],C1[r+1]);b=MX3(b,C1[r+2],C1[r+3]);} \
      float rm=__builtin_fmaxf(a,b); { auto rr=__builtin_amdgcn_permlane32_swap(__float_as_uint(rm),__float_as_uint(rm),false,false); rm=__builtin_fmaxf(__uint_as_float(rr[0]),__uint_as_float(rr[1])); } \
      resc=false; \
      if(__builtin_expect(__any(rm>(float)THRL),0)){ const float dl=__builtin_fmaxf(rm,0.f); mhat+=dl; \
        _Pragma("unroll") for(int r=0;r<16;++r){C0[r]-=dl;C1[r]-=dl;} \
        _Pragma("unroll") for(int r=0;r<16;++r)negm[r]=-mhat; asm volatile("":"+v"(negm)); \
        const float f=__builtin_amdgcn_exp2f(-dl); if(hi==0)wsf[r32]=f; resc=true; } }while(0)
  #define SEC_B(C0,C1,GL) do{ \
    VLD(vf1,1); KEEP(kf1); SBAR(); MFMA8(o[0],pfv,vf0); KRDP(GL,kf0,0); KEEP(vf0); EX8(C0,0); SBAR(); \
    VLD(vf2,2); KEEP(vf0); SBAR(); MFMA8(o[1],pfv,vf1); KRDP(GL,kf1,1); KEEP(vf1); EX8(C0,8); SBAR(); \
    VLD(vf3,3); KEEP(vf1); SBAR(); MFMA8(o[2],pfv,vf2); EX8(C1,0); SBAR(); \
    MFMA8(o[3],pfv,vf3); SBAR(); \
    MFMA8(osum,pfv,onesv); SBAR(); }while(0)
  #define STEP(C0,C1,P0,P1,t,GK,GV,GL) do{ SBAR(); \
    const lds_cptr vp_a_=vpa+sl_prev, vp_b_=vpb+sl_prev; \
    SEC_A(C0,C1,P0,P1,true); \
    SEC_DMA(t,GK,GV); \
    CMASK(C0,C1,t); \
    SEC_MAX(C0,C1); \
    SBAR(); \
    SEC_B(C0,C1,GL); \
    }while(0)
  #define STEP_T(C0,C1,N0,N1,t,GK,GV,GL,GA) do{ SBAR(); \
    const lds_cptr vp_a_=vpa+sl_prev, vp_b_=vpb+sl_prev; \
    SEC_DMA(t,GK,GV); \
    VLD(vf0,0); SBAR(); \
    SEC_MAX(C0,C1); \
    SBAR(); \
    SEC_B(C0,C1,GL); \
    if(GA){ SEC_A(N0,N1,C0,C1,false); CMASK(N0,N1,(t)+1); } \
    }while(0)
  int t=1;
  constexpr bool trail_=TRAIL;
  if constexpr(trail_){ const lds_cptr vp_a_=vpa, vp_b_=vpb; SEC_A(pB0,pB1,pA0,pA1,false); CMASK(pB0,pB1,1); }
  #undef CMASK
  #define CMASK(P0,P1,t) do{}while(0)
  if constexpr(!trail_){
    for(;t+5<NT;t+=2){
      STEP(pB0,pB1,pA0,pA1,t,true,true,true);     WAIT_BAR(2); RESC(); ROT();
      STEP(pA0,pA1,pB0,pB1,t+1,true,true,true);   WAIT_BAR(2); RESC(); ROT();
    }
  } else {
    for(;t+5<NT;t+=2){
      STEP_T(pB0,pB1,pA0,pA1,t,true,true,true,true);     WAIT_BAR(2); RESC(); ROT();
      STEP_T(pA0,pA1,pB0,pB1,t+1,true,true,true,true);   WAIT_BAR(2); RESC(); ROT();
    }
  }
  #undef CMASK
  #define CMASK(P0,P1,t) do{int jb_=(t)-(NT-4); if(jb_>=0)cmask(P0,P1,jb_,qrel,hi);}while(0)
  #define ENDW(tt) do{ if((tt)+3<NT){WAIT_BAR(2);} else if((tt)+2<NT){WAIT_BAR(1);} else {WAIT_BAR(0);} }while(0)
  if constexpr(!trail_){
    for(;t+1<NT;t+=2){
      STEP(pB0,pB1,pA0,pA1,t,(t+3<NT),(t+1<NT),(t+1<NT));       ENDW(t);   RESC(); ROT();
      STEP(pA0,pA1,pB0,pB1,t+1,(t+4<NT),(t+2<NT),(t+2<NT));     ENDW(t+1); RESC(); ROT();
    }
    STEP(pB0,pB1,pA0,pA1,NT-1,false,false,false); RESC();
  } else {
    for(;t+1<NT;t+=2){
      STEP_T(pB0,pB1,pA0,pA1,t,(t+3<NT),(t+1<NT),(t+1<NT),true);       ENDW(t);   RESC(); ROT();
      STEP_T(pA0,pA1,pB0,pB1,t+1,(t+4<NT),(t+2<NT),(t+2<NT),true);     ENDW(t+1); RESC(); ROT();
    }
    STEP_T(pB0,pB1,pA0,pA1,NT-1,false,false,false,false); RESC();
  }
  {
    EX8(pB1,8); PKF(0,pB0,0);PKF(1,pB0,4);PKF(2,pB0,8);PKF(3,pB0,12);PKF(4,pB1,0);PKF(5,pB1,4);PKF(6,pB1,8);PKF(7,pB1,12); PIN(pfv);
    const lds_cptr vp_a_=vpa+sl_cur, vp_b_=vpb+sl_cur;
    VLD(vf0,0); VLD(vf1,1); VLD(vf2,2); VLD(vf3,3); SBAR(); MFMA8(o[0],pfv,vf0); MFMA8(o[1],pfv,vf1); MFMA8(o[2],pfv,vf2); MFMA8(o[3],pfv,vf3); MFMA8(osum,pfv,onesv); SBAR();
    asm volatile("s_nop 15\n\ts_nop 15\n\ts_nop 15\n\ts_nop 15\n\ts_nop 7":"+v"(o[0]),"+v"(o[1]),"+v"(o[2]),"+v"(o[3]),"+v"(osum)); }
  #undef PKF
  #undef EX8
  #undef VLD
  #undef PAF
  #undef VFR
  #undef PIN
  #undef MX3
  #undef GAPA
  #undef GAPB
  #undef EX
  #undef KRDP
  #undef KLD
  #undef QK8
  #undef KRD
  #undef STEP
  #undef STEP_T
  #undef SEC_A
  #undef KEEP
  #undef SEC_B
  #undef SEC_MAX
  #undef SEC_DMA
  #undef ENDW
  float rli[16];
  #pragma unroll
  for(int r=0;r<16;++r)rli[r]=__builtin_amdgcn_rcpf(osum[r]);
  bf16*Ow=O+(rowbase+q0+wid*QBLK)*DM+h*D;
  { bf16*stg=(bf16*)(shm+LDS_OST)+wid*2048;
    #pragma unroll
    for(int hh=0;hh<2;++hh){
    #pragma unroll
    for(int r=0;r<16;++r){const int orow=crow(r,hi);
      #pragma unroll
      for(int d0=0;d0<2;++d0)stg[orow*64+d0*32+r32]=__float2bfloat16(o[2*hh+d0][r]*rli[r]);}
    asm volatile("s_waitcnt lgkmcnt(0)":::"memory");
    #pragma unroll
    for(int i=0;i<4;++i){const int row=i*8+(lane>>3),ch=lane&7; const u32x4 v=*(const u32x4*)(stg+row*64+ch*8); ATTN_STORE16(Ow+(long)row*DM+hh*64+ch*8,v);}
    asm volatile("s_waitcnt lgkmcnt(0)":::"memory"); } }
  asm volatile("s_waitcnt lgkmcnt(0)\n\ts_barrier":::"memory");
  #undef DMA_K
  #undef DMA_V
  #undef CMASK
  #undef START
  #undef RESC
  #undef ROT
}
constexpr int ATTN_LDS_BYTES=LDS_BYTES;
struct AttnUnit { int b, h, c, qb; };
struct DiffOrder {
  int vcu;
  __device__ __forceinline__ explicit DiffOrder(int v):vcu(v){}
  __device__ __forceinline__ bool next(int i,AttnUnit&u)const{ if(i>=16)return false; const int r=i>>2,k=i&3,x=vcu>>5,loc=vcu&31,j=loc&15; const int bh=r*8+x;
    u.b=bh>>4; u.h=bh&15; u.c=loc>>4; const int pair=j+16*(k>>1); u.qb=(k&1)?63-pair:pair; return true; }
};
#undef SBAR
#undef WAIT_BAR
}
#define GAS __attribute__((address_space(1)))
#define LAS __attribute__((address_space(3)))
typedef unsigned short bf16;
typedef unsigned v4u __attribute__((ext_vector_type(4)));
typedef float f32x4 __attribute__((ext_vector_type(4)));
typedef short bf16x8 __attribute__((ext_vector_type(8)));
typedef GAS unsigned gu32;
typedef GAS unsigned long long gu64;
#define RLX_AGENT __ATOMIC_RELAXED, __HIP_MEMORY_SCOPE_AGENT
#define LDS_WAIT() asm volatile("s_waitcnt lgkmcnt(0)" ::: "memory")
#define VM_WAIT() asm volatile("s_waitcnt vmcnt(0)" ::: "memory")
__device__ __forceinline__ unsigned long long rt() { return __builtin_amdgcn_s_memrealtime(); }
__device__ __forceinline__ unsigned f2bf(float f) { unsigned u = __builtin_bit_cast(unsigned, f); return (u + 0x7fffu + ((u >> 16) & 1u)) >> 16; }
__device__ __forceinline__ unsigned pk2(float lo, float hi) { return f2bf(lo) | (f2bf(hi) << 16); }

#define XB_TMO      128
#define XB_XCNT(j)  (256  + 64 * (j))
#define XB_XSUB(j)  (1280 + 64 * (j))
#define XB_XGEN(j)  (2304 + 64 * (j))
#define XB_TOP      3328
#define XB_TOPGEN   3392
#define XCD_BAR_WORDS 3456
#define XB_SPIN_CAP (1u << 18)

__device__ __forceinline__ unsigned xb_ld(unsigned* p)              { return __hip_atomic_load(p, __ATOMIC_RELAXED, __HIP_MEMORY_SCOPE_AGENT); }
__device__ __forceinline__ unsigned xb_add(unsigned* p, unsigned v) { return __hip_atomic_fetch_add(p, v, __ATOMIC_RELAXED, __HIP_MEMORY_SCOPE_AGENT); }
__device__ __forceinline__ unsigned xb_xcc_id() { return (unsigned)__builtin_amdgcn_s_getreg((3 << 11) | 20) & 0xFu; }
#define XB_SPIN(cond, bar) do { unsigned _sp = 0; while (cond) { __builtin_amdgcn_s_sleep(1); \
    if ((++_sp & 255u) == 0u) { if (xb_ld(&(bar)[XB_TMO])) break; if (_sp > XB_SPIN_CAP) { atomicAdd(&(bar)[XB_TMO], 1u); break; } } } } while (0)

struct XcdBarrier {
    unsigned* bar; unsigned x;
    volatile LAS unsigned* st;
};

__device__ __forceinline__ XcdBarrier xcd_barrier_post(unsigned* bar, volatile LAS unsigned* st) {
    XcdBarrier b; b.bar = bar; b.x = xb_xcc_id(); b.st = st;
    if (threadIdx.x == 0) (void)xb_add(&bar[XB_XCNT(b.x)], 1u);
    return b;
}
__device__ __forceinline__ void xcd_barrier_complete(unsigned* bar, unsigned x, unsigned& nloc, unsigned& nx) {
    const unsigned G = gridDim.x * gridDim.y * gridDim.z;
    unsigned sum, cnt, mine, sp = 0u;
    for (;;) {
        sum = 0u; cnt = 0u; mine = 0u;
#pragma unroll
        for (unsigned j = 0; j < 16; ++j) { const unsigned c = xb_ld(&bar[XB_XCNT(j)]); sum += c; cnt += (c > 0u) ? 1u : 0u; mine = (j == x) ? c : mine; }
        if (sum == G) break;
        __builtin_amdgcn_s_sleep(1);
        if ((++sp & 255u) == 0u) { if (xb_ld(&bar[XB_TMO])) break; if (sp > XB_SPIN_CAP) { atomicAdd(&bar[XB_TMO], 1u); break; } }
    }
    nloc = mine > 0u ? mine : 1u; nx = cnt > 0u ? cnt : 1u;
}

__device__ __forceinline__ void xcd_barrier(const XcdBarrier& b) {
    asm volatile("s_waitcnt vmcnt(0)" ::: "memory");
    __syncthreads();
    if (threadIdx.x == 0) {
        unsigned* bar = b.bar;
        __builtin_amdgcn_s_waitcnt(0);
        unsigned nloc = b.st[0], nx = b.st[1];
        if (nloc == 0u) { xcd_barrier_complete(bar, b.x, nloc, nx); b.st[0] = nloc; b.st[1] = nx; }
        const unsigned old = xb_add(&bar[XB_XSUB(b.x)], 1u);
        const unsigned gen = old / nloc;
        if (old + 1u == (gen + 1u) * nloc) {
            __builtin_amdgcn_fence(__ATOMIC_RELEASE, "agent");
            asm volatile("s_waitcnt vmcnt(0)" ::: "memory");
            const unsigned og = xb_add(&bar[XB_TOP], 1u);
            const unsigned tg = og / nx;
            if (og + 1u == (tg + 1u) * nx) xb_add(&bar[XB_TOPGEN], 1u);
            else XB_SPIN(xb_ld(&bar[XB_TOPGEN]) == tg, bar);
            __builtin_amdgcn_fence(__ATOMIC_ACQUIRE, "agent");
            xb_add(&bar[XB_XGEN(b.x)], 1u);
            asm volatile("s_waitcnt vmcnt(0)" ::: "memory");
        } else {
            XB_SPIN(xb_ld(&bar[XB_XGEN(b.x)]) == gen, bar);
            __builtin_amdgcn_fence(__ATOMIC_ACQUIRE, "agent");
            asm volatile("s_waitcnt vmcnt(0)" ::: "memory");
        }
    }
    __syncthreads();
}
constexpr int NWAVES = 8;
constexpr int BATCH = 2, SEQ = 16384, D = 2048, M = BATCH * SEQ;
constexpr int ZW = 3072, PW = 1024, GW = 1024, FF = 5632, NE = 8, NQKV = 3 * D;
constexpr int CHUNK_TILES = 64, MAX_TILES = 264;
constexpr float EPS = 1e-5f;
constexpr float LAMBDA_INIT = 0.35550906759096927f;
constexpr size_t MiB = 1u << 20;
constexpr size_t WS_CTL = 0, CTL_ZERO_BYTES = 1 * MiB;
constexpr size_t WS_ROPE = 2 * MiB;
constexpr size_t WS_TOK = 10 * MiB;
constexpr size_t WS_WSP = 12 * MiB, WS_WPOOL = 12 * MiB + 512 * 1024;
constexpr size_t WS_WIN = 16 * MiB, WS_WOUT = 28 * MiB, WS_WGU = 36 * MiB, WS_WD = 80 * MiB, WS_WQKV = 102 * MiB, WS_WO = 126 * MiB, WS_WEGU = 134 * MiB, WS_WED = 486 * MiB;
constexpr size_t WS_XR = 320 * MiB;
constexpr size_t WS_A = 662 * MiB;
constexpr size_t WS_B = 790 * MiB;
constexpr size_t WS_Z = WS_B, WS_Y1 = WS_B + 192 * MiB, WS_ACT = WS_B;
constexpr size_t WS_Q = WS_B, WS_K = WS_B + 128 * MiB, WS_V = WS_B + 256 * MiB, WS_O0 = WS_B + 384 * MiB, WS_O1 = WS_B + 512 * MiB;
constexpr size_t WS_XP = WS_A, WS_YM = 794 * MiB, WS_ACTC = 1058 * MiB;
constexpr size_t WS_END = 1430 * MiB;
constexpr float W8_SCALE = 32.0f;
static_assert(WS_XP + (size_t)MAX_TILES * 256 * D <= WS_YM && WS_YM + (size_t)MAX_TILES * 256 * D * 2 <= WS_ACTC && WS_ACTC + (size_t)MAX_TILES * 256 * FF <= WS_END, "moe map");
static_assert(WS_ACT + (size_t)M * FF * 2 <= WS_END && WS_Y1 + (size_t)M * D * 2 <= WS_END && WS_WED + (size_t)NE * D * FF <= WS_A && WS_WEGU + (size_t)NE * 2 * FF * D <= WS_XR && WS_XR + (size_t)M * D * 2 <= WS_WED, "map");
constexpr int CW_TMO = 0, CW_CODE = 1, CW_BAR = 4096, CW_GCNT = 16384;
constexpr int RING_OFF = 0, RING_BYTES = 131072;
constexpr int LDSCTL_OFF = RING_BYTES, MISC_OFF = LDSCTL_OFF + 320;
constexpr int LDS_BYTES = 147456;
constexpr int LW_TS = 0, LW_SEG = 16, LW_TEXP = 128;
constexpr int LW_WSC = 48;
constexpr size_t WS_HSCALE = WS_TOK + 896 * 1024;

struct Frame {
    LAS unsigned char* lds;
    volatile LAS unsigned* MISC;
    gu32* ctl;
    int tid, lane, wave;
    int vcu, G;
};

__device__ __forceinline__ float wave_sum(float v) {
#pragma unroll
    for (int o = 1; o < 64; o <<= 1) v += __shfl_xor(v, o);
    return v;
}
__device__ __forceinline__ float bf2f(unsigned short b) { return __uint_as_float((unsigned)b << 16); }
__device__ __forceinline__ float bflo(unsigned w) { return __uint_as_float(w << 16); }
__device__ __forceinline__ float bfhi(unsigned w) { return __uint_as_float(w & 0xffff0000u); }

__device__ __forceinline__ int map_gate(int n) { return 256 * (n >> 7) + (n & 127); }
__device__ __forceinline__ int map_up(int n) { return 256 * (n >> 7) + 128 + (n & 127); }
__device__ __forceinline__ int map_qkv(int n) {
    if (n >= 2 * D) return n;
    const int sec = n / D, cs = n % D, tile = cs >> 8, hh = (cs & 255) >> 6, d = cs & 63;
    return sec * D + tile * 256 + (d >> 5) * 128 + hh * 32 + (d & 31);
}
template <int MODE, bool FP8> __device__ __forceinline__ void p0_matrix(const float* W, int K, int N, void* WTv, float scale, LAS float* scr, int lane, int it) {
    const int nblk = N / 64, kb = it / nblk, nb = it % nblk, k0 = 64 * kb, n0 = 64 * nb;
    f32x4 v[16];
#pragma unroll
    for (int i = 0; i < 16; ++i) v[i] = *(const GAS f32x4*)(W + (size_t)(k0 + 4 * i + (lane >> 4)) * N + n0 + 4 * (lane & 15));
#pragma unroll
    for (int i = 0; i < 16; ++i) { const int k = 4 * i + (lane >> 4); *(LAS f32x4*)(scr + k * 64 + ((4 * (lane & 15) + 4 * k) & 63)) = v[i]; }
    LDS_WAIT(); asm volatile("" ::: "memory");
    const int ns = n0 + (lane & 32); const int dr = (MODE == 0 ? ns : MODE == 1 ? map_gate(ns) : MODE == 2 ? map_up(ns) : map_qkv(ns)) + (lane & 31);
#define P0_EL(k) scr[(k) * 64 + ((lane + 4 * (k)) & 63)]
    if constexpr (FP8) { GAS v4u* dst = (GAS v4u*)((unsigned char*)WTv + (size_t)dr * K + k0);
#pragma unroll
        for (int c = 0; c < 4; ++c) { v4u o;
            o.x = pg8::pk_fp8x4(P0_EL(16 * c + 0) * scale, P0_EL(16 * c + 1) * scale, P0_EL(16 * c + 2) * scale, P0_EL(16 * c + 3) * scale);
            o.y = pg8::pk_fp8x4(P0_EL(16 * c + 4) * scale, P0_EL(16 * c + 5) * scale, P0_EL(16 * c + 6) * scale, P0_EL(16 * c + 7) * scale);
            o.z = pg8::pk_fp8x4(P0_EL(16 * c + 8) * scale, P0_EL(16 * c + 9) * scale, P0_EL(16 * c + 10) * scale, P0_EL(16 * c + 11) * scale);
            o.w = pg8::pk_fp8x4(P0_EL(16 * c + 12) * scale, P0_EL(16 * c + 13) * scale, P0_EL(16 * c + 14) * scale, P0_EL(16 * c + 15) * scale);
            dst[c] = o; }
    } else { GAS v4u* dst = (GAS v4u*)((bf16*)WTv + (size_t)dr * K + k0);
#pragma unroll
        for (int c = 0; c < 8; ++c) { v4u o; o.x = pk2(P0_EL(8 * c + 0), P0_EL(8 * c + 1)); o.y = pk2(P0_EL(8 * c + 2), P0_EL(8 * c + 3)); o.z = pk2(P0_EL(8 * c + 4), P0_EL(8 * c + 5)); o.w = pk2(P0_EL(8 * c + 6), P0_EL(8 * c + 7));
            dst[c] = o; }
    }
#undef P0_EL
    LDS_WAIT(); asm volatile("" ::: "memory");
}
template <int MODE> __device__ __forceinline__ void p0_matrix8w(const float* W, int K, int N, unsigned char* WT, float scale, LAS float* scr, int lane, int it) {
    const int nblk = N / 32, kb = it / nblk, nb = it % nblk, k0 = 128 * kb, n0 = 32 * nb;
    f32x4 v[16];
#pragma unroll
    for (int i = 0; i < 16; ++i) v[i] = *(const GAS f32x4*)(W + (size_t)(k0 + 8 * i + (lane >> 3)) * N + n0 + 4 * (lane & 7));
#pragma unroll
    for (int i = 0; i < 16; ++i) { const int k = 8 * i + (lane >> 3); *(LAS f32x4*)(scr + k * 32 + ((4 * (lane & 7) + 4 * k) & 31)) = v[i]; }
    LDS_WAIT(); asm volatile("" ::: "memory");
    const int n = lane & 31, kh = lane >> 5; const int dr = (MODE == 0 ? n0 : MODE == 1 ? map_gate(n0) : map_up(n0)) + n;
    GAS v4u* dst = (GAS v4u*)(WT + (size_t)dr * K + k0 + 64 * kh);
#define P0_EL(k) (scr[(64 * kh + (k)) * 32 + ((n + 4 * (64 * kh + (k))) & 31)] * scale)
#pragma unroll
    for (int c = 0; c < 4; ++c) { v4u o;
        o.x = pg8::pk_fp8x4(P0_EL(16 * c + 0), P0_EL(16 * c + 1), P0_EL(16 * c + 2), P0_EL(16 * c + 3)); o.y = pg8::pk_fp8x4(P0_EL(16 * c + 4), P0_EL(16 * c + 5), P0_EL(16 * c + 6), P0_EL(16 * c + 7));
        o.z = pg8::pk_fp8x4(P0_EL(16 * c + 8), P0_EL(16 * c + 9), P0_EL(16 * c + 10), P0_EL(16 * c + 11)); o.w = pg8::pk_fp8x4(P0_EL(16 * c + 12), P0_EL(16 * c + 13), P0_EL(16 * c + 14), P0_EL(16 * c + 15));
        dst[c] = o; }
#undef P0_EL
    LDS_WAIT(); asm volatile("" ::: "memory");
}
__device__ __forceinline__ unsigned pk_i8x4(float a, float b, float c, float d) {
    const int i0 = __float2int_rn(fminf(fmaxf(a, -127.f), 127.f)), i1 = __float2int_rn(fminf(fmaxf(b, -127.f), 127.f)), i2 = __float2int_rn(fminf(fmaxf(c, -127.f), 127.f)), i3 = __float2int_rn(fminf(fmaxf(d, -127.f), 127.f));
    return (unsigned)(i0 & 255) | ((unsigned)(i1 & 255) << 8) | ((unsigned)(i2 & 255) << 16) | ((unsigned)i3 << 24);
}
template <int MODE> __device__ __forceinline__ void p0_matrix_i8w(const float* W, int K, int N, unsigned char* WT, float inv, LAS float* scr, int lane, int it) {
    const int nblk = N / 32, kb = it / nblk, nb = it % nblk, k0 = 128 * kb, n0 = 32 * nb;
    f32x4 v[16];
#pragma unroll
    for (int i = 0; i < 16; ++i) v[i] = *(const GAS f32x4*)(W + (size_t)(k0 + 8 * i + (lane >> 3)) * N + n0 + 4 * (lane & 7));
#pragma unroll
    for (int i = 0; i < 16; ++i) { const int k = 8 * i + (lane >> 3); *(LAS f32x4*)(scr + k * 32 + ((4 * (lane & 7) + 4 * k) & 31)) = v[i]; }
    LDS_WAIT(); asm volatile("" ::: "memory");
    const int n = lane & 31, kh = lane >> 5; const int dr = (MODE == 0 ? n0 : MODE == 1 ? map_gate(n0) : MODE == 2 ? map_up(n0) : map_qkv(n0)) + n;
    GAS v4u* dst = (GAS v4u*)(WT + (size_t)dr * K + k0 + 64 * kh);
#define P0_EL(k) (scr[(64 * kh + (k)) * 32 + ((n + 4 * (64 * kh + (k))) & 31)] * inv)
#pragma unroll
    for (int c = 0; c < 4; ++c) { v4u o;
        o.x = pk_i8x4(P0_EL(16 * c + 0), P0_EL(16 * c + 1), P0_EL(16 * c + 2), P0_EL(16 * c + 3)); o.y = pk_i8x4(P0_EL(16 * c + 4), P0_EL(16 * c + 5), P0_EL(16 * c + 6), P0_EL(16 * c + 7));
        o.z = pk_i8x4(P0_EL(16 * c + 8), P0_EL(16 * c + 9), P0_EL(16 * c + 10), P0_EL(16 * c + 11)); o.w = pk_i8x4(P0_EL(16 * c + 12), P0_EL(16 * c + 13), P0_EL(16 * c + 14), P0_EL(16 * c + 15));
        dst[c] = o; }
#undef P0_EL
    LDS_WAIT(); asm volatile("" ::: "memory");
}
__device__ __forceinline__ float rms_row_to_bf16(const float* xrow, const float* gain, bf16* orow, int lane) {
    const GAS f32x4* xr = (const GAS f32x4*)xrow + lane; const GAS f32x4* gr = (const GAS f32x4*)gain + lane;
    f32x4 v[8]; float s = 0.f;
#pragma unroll
    for (int j = 0; j < 8; ++j) { v[j] = xr[64 * j]; s += (v[j].x * v[j].x + v[j].y * v[j].y) + (v[j].z * v[j].z + v[j].w * v[j].w); }
    const float rstd = 1.f / sqrtf(wave_sum(s) * (1.f / D) + EPS);
    GAS unsigned long long* o8 = (GAS unsigned long long*)orow + lane;
#pragma unroll
    for (int j = 0; j < 8; ++j) { const f32x4 g = gr[64 * j];
        o8[64 * j] = (unsigned long long)pk2(v[j].x * rstd * g.x, v[j].y * rstd * g.y) | ((unsigned long long)pk2(v[j].z * rstd * g.z, v[j].w * rstd * g.w) << 32); }
    return rstd;
}
__device__ __forceinline__ void norm_phase(Frame& F, const float* x, const float* gain, bf16* out) {
    const int gw = F.vcu * NWAVES + F.wave, NGW = F.G * NWAVES, lane = F.lane;
    const GAS f32x4* gr = (const GAS f32x4*)gain + lane;
    f32x4 v[8], nx[8];
    if (gw < M) { const GAS f32x4* xr = (const GAS f32x4*)(x + (size_t)gw * D) + lane;
#pragma unroll
        for (int j = 0; j < 8; ++j) v[j] = xr[64 * j]; }
    for (int m = gw; m < M; m += NGW) {
        const int mn = (m + NGW < M) ? m + NGW : m; const GAS f32x4* xn = (const GAS f32x4*)(x + (size_t)mn * D) + lane;
#pragma unroll
        for (int j = 0; j < 8; ++j) nx[j] = xn[64 * j];
        float s = 0.f;
#pragma unroll
        for (int j = 0; j < 8; ++j) s += (v[j].x * v[j].x + v[j].y * v[j].y) + (v[j].z * v[j].z + v[j].w * v[j].w);
        const float rstd = 1.f / sqrtf(wave_sum(s) * (1.f / D) + EPS);
        GAS unsigned long long* o8 = (GAS unsigned long long*)(out + (size_t)m * D) + lane;
#pragma unroll
        for (int j = 0; j < 8; ++j) { const f32x4 g = gr[64 * j];
            o8[64 * j] = (unsigned long long)pk2(v[j].x * rstd * g.x, v[j].y * rstd * g.y) | ((unsigned long long)pk2(v[j].z * rstd * g.z, v[j].w * rstd * g.w) << 32); }
#pragma unroll
        for (int j = 0; j < 8; ++j) v[j] = nx[j];
    }
}
__device__ __forceinline__ void norm_phase_b(Frame& F, const bf16* x, const float* gain, bf16* out) {
    const int gw = F.vcu * NWAVES + F.wave, NGW = F.G * NWAVES, lane = F.lane;
    const GAS f32x4* gr = (const GAS f32x4*)gain + 2 * lane;
    v4u v[4], nx[4];
    if (gw < M) { const GAS v4u* xr = (const GAS v4u*)(x + (size_t)gw * D) + lane;
#pragma unroll
        for (int j = 0; j < 4; ++j) v[j] = xr[64 * j]; }
    for (int m = gw; m < M; m += NGW) {
        const int mn = (m + NGW < M) ? m + NGW : m; const GAS v4u* xn = (const GAS v4u*)(x + (size_t)mn * D) + lane;
#pragma unroll
        for (int j = 0; j < 4; ++j) nx[j] = xn[64 * j];
        float s = 0.f; f32x4 a[4][2];
#pragma unroll
        for (int j = 0; j < 4; ++j) { a[j][0] = pg8::bf4lo(v[j].x, v[j].y); a[j][1] = pg8::bf4lo(v[j].z, v[j].w);
            s += (a[j][0].x * a[j][0].x + a[j][0].y * a[j][0].y) + (a[j][0].z * a[j][0].z + a[j][0].w * a[j][0].w) + (a[j][1].x * a[j][1].x + a[j][1].y * a[j][1].y) + (a[j][1].z * a[j][1].z + a[j][1].w * a[j][1].w); }
        const float rstd = 1.f / sqrtf(wave_sum(s) * (1.f / D) + EPS);
        GAS v4u* o = (GAS v4u*)(out + (size_t)m * D) + lane;
#pragma unroll
        for (int j = 0; j < 4; ++j) { const f32x4 g0 = gr[128 * j], g1 = gr[128 * j + 1]; v4u w;
            w.x = pk2(a[j][0].x * rstd * g0.x, a[j][0].y * rstd * g0.y); w.y = pk2(a[j][0].z * rstd * g0.z, a[j][0].w * rstd * g0.w);
            w.z = pk2(a[j][1].x * rstd * g1.x, a[j][1].y * rstd * g1.y); w.w = pk2(a[j][1].z * rstd * g1.z, a[j][1].w * rstd * g1.w); o[64 * j] = w; }
#pragma unroll
        for (int j = 0; j < 4; ++j) v[j] = nx[j];
    }
}
typedef unsigned v2u_f __attribute__((ext_vector_type(2)));
__device__ __forceinline__ void norm_phase_q(Frame& F, const bf16* x, const float* gain, unsigned char* out, float* rowscale) {
    const int gw = F.vcu * NWAVES + F.wave, NGW = F.G * NWAVES, lane = F.lane;
    const GAS f32x4* gr = (const GAS f32x4*)gain + 2 * lane;
    v4u v[4], nx[4];
    if (gw < M) { const GAS v4u* xr = (const GAS v4u*)(x + (size_t)gw * D) + lane;
#pragma unroll
        for (int j = 0; j < 4; ++j) v[j] = xr[64 * j]; }
    for (int m = gw; m < M; m += NGW) {
        const int mn = (m + NGW < M) ? m + NGW : m; const GAS v4u* xn = (const GAS v4u*)(x + (size_t)mn * D) + lane;
#pragma unroll
        for (int j = 0; j < 4; ++j) nx[j] = xn[64 * j];
        float s = 0.f; f32x4 a[4][2];
#pragma unroll
        for (int j = 0; j < 4; ++j) { a[j][0] = pg8::bf4lo(v[j].x, v[j].y); a[j][1] = pg8::bf4lo(v[j].z, v[j].w);
            s += (a[j][0].x * a[j][0].x + a[j][0].y * a[j][0].y) + (a[j][0].z * a[j][0].z + a[j][0].w * a[j][0].w) + (a[j][1].x * a[j][1].x + a[j][1].y * a[j][1].y) + (a[j][1].z * a[j][1].z + a[j][1].w * a[j][1].w); }
        const float rstd = 1.f / sqrtf(wave_sum(s) * (1.f / D) + EPS);
        float amax = 0.f;
#pragma unroll
        for (int j = 0; j < 4; ++j)
#pragma unroll
            for (int q = 0; q < 2; ++q) { const f32x4 g = gr[128 * j + q]; a[j][q] = (f32x4){a[j][q].x * rstd * g.x, a[j][q].y * rstd * g.y, a[j][q].z * rstd * g.z, a[j][q].w * rstd * g.w};
                amax = fmaxf(amax, fmaxf(fmaxf(fabsf(a[j][q].x), fabsf(a[j][q].y)), fmaxf(fabsf(a[j][q].z), fabsf(a[j][q].w)))); }
#pragma unroll
        for (int o = 1; o < 64; o <<= 1) amax = fmaxf(amax, __shfl_xor(amax, o));
        amax = fmaxf(amax, 1e-20f); const float inv = 127.0f / amax;
        GAS v2u_f* o8 = (GAS v2u_f*)(out + (size_t)m * D) + lane;
#pragma unroll
        for (int j = 0; j < 4; ++j) { v2u_f w; w.x = pk_i8x4(a[j][0].x * inv, a[j][0].y * inv, a[j][0].z * inv, a[j][0].w * inv); w.y = pk_i8x4(a[j][1].x * inv, a[j][1].y * inv, a[j][1].z * inv, a[j][1].w * inv); o8[64 * j] = w; }
        if (lane == 0) rowscale[m] = amax * (1.0f / 127.0f);
#pragma unroll
        for (int j = 0; j < 4; ++j) v[j] = nx[j];
    }
}
struct P0Args { const float *w_in, *w_out, *w_gate, *w_up, *w_down, *w_qkv, *w_o, *w_pool, *we_gate, *we_up, *we_down, *w_spatial; const int* positions; const float* x; const float* norm_mix; };
__device__ __forceinline__ void p0_prologue(Frame& F, const P0Args& a, unsigned char* ws) {
    LAS float* scr = (LAS float*)(F.lds + RING_OFF + F.wave * 16384);
    const int gw = F.vcu * NWAVES + F.wave, NGW = F.G * NWAVES, lane = F.lane;
    norm_phase(F, a.x, a.norm_mix, (bf16*)(ws + WS_A));
    constexpr int I_IN = (D / 64) * (ZW / 64), I_DD = (D / 64) * (D / 64), I_FF = (D / 64) * (FF / 64), I_QKV = (D / 64) * (NQKV / 64), I_POOL = 4 * 4;
    constexpr int N_DENSE = I_IN + I_DD + 3 * I_FF + I_QKV + I_DD + 4 * I_POOL, N_ALL = N_DENSE + NE * 3 * I_FF;
    { LAS float* red = (LAS float*)(F.lds + RING_OFF + 131072 - 128);     volatile LAS float* LWf = (volatile LAS float*)(F.lds + LDSCTL_OFF);
      float sg_ = 0.f, su_ = 0.f, sq_ = 0.f, so_ = 0.f;
      for (int i = F.tid; i < 16384; i += 512) { const float g_ = a.w_gate[i], u_ = a.w_up[i], q_ = a.w_qkv[i], o_ = a.w_o[i]; sg_ += g_ * g_; su_ += u_ * u_; sq_ += q_ * q_; so_ += o_ * o_; }
      sg_ = wave_sum(sg_); su_ = wave_sum(su_); sq_ = wave_sum(sq_); so_ = wave_sum(so_);
      if (lane == 0) { red[4 * F.wave] = sg_; red[4 * F.wave + 1] = su_; red[4 * F.wave + 2] = sq_; red[4 * F.wave + 3] = so_; }
      __syncthreads();
      if (F.tid == 0) { float tg = 0.f, tu = 0.f, tq = 0.f, to = 0.f; for (int w_ = 0; w_ < NWAVES; ++w_) { tg += red[4 * w_]; tu += red[4 * w_ + 1]; tq += red[4 * w_ + 2]; to += red[4 * w_ + 3]; }
          LWf[LW_WSC + 3] = 4.0f * sqrtf(to * (1.0f / 16384.0f)) * (1.0f / 127.0f);
          LWf[LW_WSC] = 4.0f * sqrtf(tg * (1.0f / 16384.0f)) * (1.0f / 127.0f); LWf[LW_WSC + 1] = 4.0f * sqrtf(tu * (1.0f / 16384.0f)) * (1.0f / 127.0f); LWf[LW_WSC + 2] = 4.0f * sqrtf(tq * (1.0f / 16384.0f)) * (1.0f / 127.0f); }
      __syncthreads(); }
    const float inv_g = 1.0f / ((volatile LAS float*)(F.lds + LDSCTL_OFF))[LW_WSC], inv_u = 1.0f / ((volatile LAS float*)(F.lds + LDSCTL_OFF))[LW_WSC + 1];
    const float inv_q = 1.0f / ((volatile LAS float*)(F.lds + LDSCTL_OFF))[LW_WSC + 2];
    const float inv_o = 1.0f / ((volatile LAS float*)(F.lds + LDSCTL_OFF))[LW_WSC + 3];
    for (int it = gw; it < N_ALL; it += NGW) {
        int r = it;
        if (r < I_IN) { p0_matrix<0, false>(a.w_in, D, ZW, ws + WS_WIN, 1.f, scr, lane, r); continue; } r -= I_IN;
        if (r < I_DD) { p0_matrix<0, false>(a.w_out, D, D, ws + WS_WOUT, 1.f, scr, lane, r); continue; } r -= I_DD;
        if (r < I_FF) { p0_matrix_i8w<1>(a.w_gate, D, FF, ws + WS_WGU, inv_g, scr, lane, r); continue; } r -= I_FF;
        if (r < I_FF) { p0_matrix_i8w<2>(a.w_up, D, FF, ws + WS_WGU, inv_u, scr, lane, r); continue; } r -= I_FF;
        if (r < I_FF) { p0_matrix8w<0>(a.w_down, FF, D, ws + WS_WD, W8_SCALE, scr, lane, r); continue; } r -= I_FF;
        if (r < I_QKV) { p0_matrix_i8w<3>(a.w_qkv, D, NQKV, ws + WS_WQKV, inv_q, scr, lane, r); continue; } r -= I_QKV;
        if (r < I_DD) { p0_matrix_i8w<0>(a.w_o, D, D, ws + WS_WO, inv_o, scr, lane, r); continue; } r -= I_DD;
        if (r < 4 * I_POOL) { const int g = r / I_POOL; p0_matrix<0, false>(a.w_pool + (size_t)g * 65536, 256, 256, ws + WS_WPOOL + (size_t)g * 65536 * 2, 1.f, scr, lane, r % I_POOL); continue; } r -= 4 * I_POOL;
        { constexpr int I8 = (D / 128) * (FF / 32); static_assert(I8 == I_FF && (FF / 128) * (D / 32) == I_FF, "same item count in both item shapes");
          const int e = r / (3 * I_FF), q = r % (3 * I_FF), which = q / I_FF, ii = q % I_FF;
          if (which == 0) p0_matrix8w<1>(a.we_gate + (size_t)e * D * FF, D, FF, ws + WS_WEGU + (size_t)e * 2 * FF * D, W8_SCALE, scr, lane, ii);
          else if (which == 1) p0_matrix8w<2>(a.we_up + (size_t)e * D * FF, D, FF, ws + WS_WEGU + (size_t)e * 2 * FF * D, W8_SCALE, scr, lane, ii);
          else p0_matrix8w<0>(a.we_down + (size_t)e * FF * D, FF, D, ws + WS_WED + (size_t)e * D * FF, W8_SCALE, scr, lane, ii); }
    }
    { bf16* wsp = (bf16*)(ws + WS_WSP); const int gt = F.vcu * NWAVES * 64 + F.tid, NT = F.G * NWAVES * 64;
      for (int i = gt; i < 8 * 128 * 128; i += NT) { const int t = (i >> 7) & 127, s = i & 127; wsp[i] = (bf16)(s <= t ? f2bf(a.w_spatial[i]) : 0u); }
      float* rope = (float*)(ws + WS_ROPE);
      for (int i = gt; i < M * 32; i += NT) { const int r = i >> 5, k = i & 31;
          const float inv = exp2f(-(float)k * (13.287712379549449f / 32.0f)); const float ang = (float)a.positions[r] * inv;
          const double rev = (double)ang * 0.15915494309189535; const float fr = (float)(rev - rint(rev));
          rope[(size_t)r * 64 + k] = __builtin_amdgcn_cosf(fr); rope[(size_t)r * 64 + 32 + k] = __builtin_amdgcn_sinf(fr); } }
}

typedef unsigned v2u __attribute__((ext_vector_type(2)));
__device__ __forceinline__ void p2_mixer(Frame& F, const bf16* Z, bf16* Y, const bf16* WpT, const float* pscale, const bf16* Wsp, const float* bsp, const float* lng, const float* lnb) {
    constexpr int ZP = 136;
    LAS bf16* ZS = (LAS bf16*)(F.lds);
    LAS bf16* PL = (LAS bf16*)(F.lds + 144 * ZP * 2);
    LAS bf16* VT = (LAS bf16*)(F.lds);
    LAS float* ST = (LAS float*)(F.lds + 81920);
    const int tid = F.tid, lane = F.lane, w = F.wave, fr = lane & 15, fq = lane >> 4;
    for (int unit = F.vcu; unit < M / 128; unit += F.G) {
        const int r0 = unit * 128, tpos0 = r0 % SEQ; const bool first = tpos0 == 0;
        for (int g = 0; g < 4; ++g) {
            const int win = 2 << g;
            f32x4 acc[2][8];
#pragma unroll
            for (int a = 0; a < 2; ++a)
#pragma unroll
                for (int b = 0; b < 8; ++b) acc[a][b] = (f32x4){0.f, 0.f, 0.f, 0.f};
            for (int kh = 0; kh < 2; ++kh) {
                __syncthreads();
                for (int i = tid; i < 144 * 16; i += 512) { const int row = i >> 4, ch = i & 15; v4u v = (v4u){0u, 0u, 0u, 0u};
                    if (!(first && row < 16)) v = *(const GAS v4u*)(Z + (size_t)(r0 - 16 + row) * ZW + g * 256 + kh * 128 + ch * 8);
                    *(LAS v4u*)(ZS + row * ZP + ch * 8) = v; }
                __syncthreads();
                { const int ch = tid & 15, tq = tid >> 4;
#pragma unroll 1
                  for (int k = 0; k < 4; ++k) { const int t = tq + 32 * k; float s[8];
#pragma unroll
                      for (int j = 0; j < 8; ++j) s[j] = 0.f;
                      for (int j = 0; j < win; ++j) { const v4u v = *(const LAS v4u*)(ZS + (t + 16 - j) * ZP + ch * 8);
                          s[0] += bflo(v.x); s[1] += bfhi(v.x); s[2] += bflo(v.y); s[3] += bfhi(v.y); s[4] += bflo(v.z); s[5] += bfhi(v.z); s[6] += bflo(v.w); s[7] += bfhi(v.w); }
                      const v4u zc = *(const LAS v4u*)(ZS + (t + 16) * ZP + ch * 8); const int tp = tpos0 + t; const float inv = 1.0f / (float)(tp + 1 < win ? tp + 1 : win);
                      v4u o; o.x = pk2(s[0] * inv - bflo(zc.x), s[1] * inv - bfhi(zc.x)); o.y = pk2(s[2] * inv - bflo(zc.y), s[3] * inv - bfhi(zc.y));
                      o.z = pk2(s[4] * inv - bflo(zc.z), s[5] * inv - bfhi(zc.z)); o.w = pk2(s[6] * inv - bflo(zc.w), s[7] * inv - bfhi(zc.w));
                      *(LAS v4u*)(PL + t * ZP + ch * 8) = o; } }
                __syncthreads();
#pragma unroll 1
                for (int ks = 0; ks < 4; ++ks) { bf16x8 af[2];
#pragma unroll
                    for (int db = 0; db < 2; ++db) af[db] = *(const GAS bf16x8*)(WpT + ((size_t)g * 256 + 32 * w + 16 * db + fr) * 256 + kh * 128 + 32 * ks + 8 * fq);
#pragma unroll
                    for (int tb = 0; tb < 8; ++tb) { const bf16x8 bv = *(const LAS bf16x8*)(PL + (16 * tb + fr) * ZP + 32 * ks + 8 * fq);
#pragma unroll
                        for (int db = 0; db < 2; ++db) acc[db][tb] = __builtin_amdgcn_mfma_f32_16x16x32_bf16(af[db], bv, acc[db][tb], 0, 0, 0); } }
            }
#pragma unroll
            for (int db = 0; db < 2; ++db) { const int col = g * 256 + 32 * w + 16 * db + 4 * fq; const f32x4 sc = *(const GAS f32x4*)(pscale + col);
#pragma unroll
                for (int tb = 0; tb < 8; ++tb) { const f32x4 v = acc[db][tb] * sc; v2u o; o.x = pk2(v[0], v[1]); o.y = pk2(v[2], v[3]);
                    *(GAS v2u*)(Y + (size_t)(r0 + 16 * tb + fr) * D + col) = o; } }
        }
        __syncthreads();
        for (int k = 0; k < 16; ++k) { const int t = 16 * w + k; const GAS v4u* vr = (const GAS v4u*)(Z + (size_t)(r0 + t) * ZW + PW + GW) + lane; const v4u a = vr[0], b = vr[64];
            float x[16] = {bflo(a.x), bfhi(a.x), bflo(a.y), bfhi(a.y), bflo(a.z), bfhi(a.z), bflo(a.w), bfhi(a.w), bflo(b.x), bfhi(b.x), bflo(b.y), bfhi(b.y), bflo(b.z), bfhi(b.z), bflo(b.w), bfhi(b.w)};
            float s = 0.f;
#pragma unroll
            for (int j = 0; j < 16; ++j) s += x[j];
            const float mean = wave_sum(s) * (1.0f / GW); float q = 0.f;
#pragma unroll
            for (int j = 0; j < 16; ++j) { const float d = x[j] - mean; q += d * d; }
            const float rstd = 1.0f / sqrtf(wave_sum(q) * (1.0f / GW) + EPS);
            if (lane == 0) { ST[2 * t] = mean; ST[2 * t + 1] = rstd; } }
        __syncthreads();
        for (int g = 0; g < 8; ++g) {
#pragma unroll 1
            for (int k = 0; k < 4; ++k) { const int i = tid + 512 * k, s = i >> 4, ch = i & 15;
                const v4u v = *(const GAS v4u*)(Z + (size_t)(r0 + s) * ZW + PW + GW + g * 128 + ch * 8); const float mean = ST[2 * s], rstd = ST[2 * s + 1];
                const f32x4 g0 = *(const GAS f32x4*)(lng + g * 128 + ch * 8), g1 = *(const GAS f32x4*)(lng + g * 128 + ch * 8 + 4), b0 = *(const GAS f32x4*)(lnb + g * 128 + ch * 8), b1 = *(const GAS f32x4*)(lnb + g * 128 + ch * 8 + 4);
                LAS bf16* vt = VT + (ch * 8) * ZP + s;
                vt[0 * ZP] = (bf16)f2bf((bflo(v.x) - mean) * rstd * g0[0] + b0[0]); vt[1 * ZP] = (bf16)f2bf((bfhi(v.x) - mean) * rstd * g0[1] + b0[1]);
                vt[2 * ZP] = (bf16)f2bf((bflo(v.y) - mean) * rstd * g0[2] + b0[2]); vt[3 * ZP] = (bf16)f2bf((bfhi(v.y) - mean) * rstd * g0[3] + b0[3]);
                vt[4 * ZP] = (bf16)f2bf((bflo(v.z) - mean) * rstd * g1[0] + b1[0]); vt[5 * ZP] = (bf16)f2bf((bfhi(v.z) - mean) * rstd * g1[1] + b1[1]);
                vt[6 * ZP] = (bf16)f2bf((bflo(v.w) - mean) * rstd * g1[2] + b1[2]); vt[7 * ZP] = (bf16)f2bf((bfhi(v.w) - mean) * rstd * g1[3] + b1[3]); }
            __syncthreads();
            f32x4 acc[8];
#pragma unroll
            for (int b = 0; b < 8; ++b) acc[b] = (f32x4){0.f, 0.f, 0.f, 0.f};
            const int nks = (w >> 1) + 1;
#pragma unroll 1
            for (int ks = 0; ks < nks; ++ks) { const bf16x8 bw = *(const GAS bf16x8*)(Wsp + ((size_t)g * 128 + 16 * w + fr) * 128 + 32 * ks + 8 * fq);
#pragma unroll
                for (int cb = 0; cb < 8; ++cb) { const bf16x8 av = *(const LAS bf16x8*)(VT + (16 * cb + fr) * ZP + 32 * ks + 8 * fq);
                    acc[cb] = __builtin_amdgcn_mfma_f32_16x16x32_bf16(av, bw, acc[cb], 0, 0, 0); } }
            { const int t = 16 * w + fr; const float bias = bsp[g * 128 + t];
#pragma unroll
              for (int cb = 0; cb < 8; ++cb) { const int c = g * 128 + 16 * cb + 4 * fq; const v2u uu = *(const GAS v2u*)(Z + (size_t)(r0 + t) * ZW + PW + c);
                  v2u o; o.x = pk2(bflo(uu.x) * (acc[cb][0] + bias), bfhi(uu.x) * (acc[cb][1] + bias)); o.y = pk2(bflo(uu.y) * (acc[cb][2] + bias), bfhi(uu.y) * (acc[cb][3] + bias));
                  *(GAS v2u*)(Y + (size_t)(r0 + t) * D + PW + c) = o; } }
            __syncthreads();
        }
    }
}

__device__ __forceinline__ void p10_combine(Frame& F, const bf16* O0, const bf16* O1, unsigned char* O, float* rowscale, const float* lq1, const float* lk1, const float* lq2, const float* lk2, const float* subg) {
    const int gw = F.vcu * NWAVES + F.wave, NGW = F.G * NWAVES, lane = F.lane;
    const float s1 = wave_sum(lq1[lane] * lk1[lane]), s2 = wave_sum(lq2[lane] * lk2[lane]);
    const float lam = expf(s1) - expf(s2) + LAMBDA_INIT;
    const int e0 = (lane & 15) * 8;
    const f32x4 g0 = *(const GAS f32x4*)(subg + e0), g1 = *(const GAS f32x4*)(subg + e0 + 4);
    const float post = 1.0f - LAMBDA_INIT;
    for (int m = gw; m < M; m += NGW) {
        const GAS v4u* a = (const GAS v4u*)(O0 + (size_t)m * D) + lane; const GAS v4u* b = (const GAS v4u*)(O1 + (size_t)m * D) + lane; GAS v2u* o = (GAS v2u*)(O + (size_t)m * D) + lane;
        float val[4][8]; float amax = 0.f;
#pragma unroll
        for (int j = 0; j < 4; ++j) { const v4u x = a[64 * j], y = b[64 * j]; float d[8];
            d[0] = bflo(x.x) - lam * bflo(y.x); d[1] = bfhi(x.x) - lam * bfhi(y.x); d[2] = bflo(x.y) - lam * bflo(y.y); d[3] = bfhi(x.y) - lam * bfhi(y.y);
            d[4] = bflo(x.z) - lam * bflo(y.z); d[5] = bfhi(x.z) - lam * bfhi(y.z); d[6] = bflo(x.w) - lam * bflo(y.w); d[7] = bfhi(x.w) - lam * bfhi(y.w);
            float q = 0.f;
#pragma unroll
            for (int i = 0; i < 8; ++i) q += d[i] * d[i];
            q += __shfl_xor(q, 1); q += __shfl_xor(q, 2); q += __shfl_xor(q, 4); q += __shfl_xor(q, 8);
            const float r = post / sqrtf(q * (1.0f / 128.0f) + EPS);
            val[j][0] = d[0] * r * g0[0]; val[j][1] = d[1] * r * g0[1]; val[j][2] = d[2] * r * g0[2]; val[j][3] = d[3] * r * g0[3];
            val[j][4] = d[4] * r * g1[0]; val[j][5] = d[5] * r * g1[1]; val[j][6] = d[6] * r * g1[2]; val[j][7] = d[7] * r * g1[3];
#pragma unroll
            for (int i = 0; i < 8; ++i) amax = fmaxf(amax, fabsf(val[j][i])); }
#pragma unroll
        for (int sft = 1; sft < 64; sft <<= 1) amax = fmaxf(amax, __shfl_xor(amax, sft));
        amax = fmaxf(amax, 1e-20f); const float inv = 127.0f / amax;
#pragma unroll
        for (int j = 0; j < 4; ++j) { v2u w; w.x = pk_i8x4(val[j][0] * inv, val[j][1] * inv, val[j][2] * inv, val[j][3] * inv); w.y = pk_i8x4(val[j][4] * inv, val[j][5] * inv, val[j][6] * inv, val[j][7] * inv); o[64 * j] = w; }
        if (lane == 0) rowscale[m] = amax * (1.0f / 127.0f);
    }
}

__device__ __forceinline__ void p12a_route(Frame& F, const bf16* X, const float* gain, const float* wrt, unsigned char* ws) {
    LAS float* WR = (LAS float*)(F.lds);
    LAS int* SEL = (LAS int*)(F.lds + 65536);
    LAS int* RNK = (LAS int*)(F.lds + 65536 + 1024);
    LAS int* LCNT = (LAS int*)(F.lds + 65536 + 2048);
    int* tok_e = (int*)(ws + WS_TOK); int* tok_p = tok_e + 2 * M; float* tok_w = (float*)(tok_p + 2 * M); float* tok_rstd = tok_w + 2 * M;
    const int tid = F.tid, lane = F.lane, w = F.wave;
    for (int i = tid; i < D * NE; i += 512) WR[(i & 7) * D + (i >> 3)] = wrt[i];
    if (tid < 16) LCNT[tid] = 0;
    __syncthreads();
    const int rows_per_blk = M / F.G;
    const int rbase = F.vcu * rows_per_blk;
    const GAS f32x4* gr = (const GAS f32x4*)gain + 2 * lane;
    for (int li = w; li < rows_per_blk; li += NWAVES) { const int m = rbase + li;
        const GAS v4u* xr = (const GAS v4u*)(X + (size_t)m * D) + lane;
        f32x4 v[4][2]; float s = 0.f;
#pragma unroll
        for (int j = 0; j < 4; ++j) { const v4u t = xr[64 * j]; v[j][0] = pg8::bf4lo(t.x, t.y); v[j][1] = pg8::bf4lo(t.z, t.w);
#pragma unroll
            for (int q = 0; q < 2; ++q) s += (v[j][q].x * v[j][q].x + v[j][q].y * v[j][q].y) + (v[j][q].z * v[j][q].z + v[j][q].w * v[j][q].w); }
        const float rstd = 1.f / sqrtf(wave_sum(s) * (1.f / D) + EPS);
        float lg[8];
#pragma unroll
        for (int e = 0; e < 8; ++e) lg[e] = 0.f;
#pragma unroll
        for (int j = 0; j < 4; ++j)
#pragma unroll
            for (int q = 0; q < 2; ++q) { const f32x4 g = gr[128 * j + q]; const f32x4 h = (f32x4){v[j][q].x * rstd * g.x, v[j][q].y * rstd * g.y, v[j][q].z * rstd * g.z, v[j][q].w * rstd * g.w};
#pragma unroll
                for (int e = 0; e < 8; ++e) { const f32x4 wv = *(const LAS f32x4*)(WR + e * D + 8 * (64 * j + lane) + 4 * q); lg[e] += (h.x * wv.x + h.y * wv.y) + (h.z * wv.z + h.w * wv.w); } }
#pragma unroll
        for (int e = 0; e < 8; ++e) lg[e] = wave_sum(lg[e]);
        if (lane == 0) {
            int e0 = 0; float v0 = lg[0];
#pragma unroll
            for (int e = 1; e < 8; ++e) if (lg[e] > v0) { v0 = lg[e]; e0 = e; }
            int e1 = -1; float v1 = -INFINITY;
#pragma unroll
            for (int e = 0; e < 8; ++e) if (e != e0 && (e1 < 0 || lg[e] > v1)) { v1 = lg[e]; e1 = e; }
            const float w1 = 1.0f / (1.0f + expf(v0 - v1)), w0 = 1.0f - w1;
            SEL[2 * li] = e0; SEL[2 * li + 1] = e1; tok_w[2 * m] = w0; tok_w[2 * m + 1] = w1; tok_rstd[m] = rstd; }
    }
    __syncthreads();
    if (tid < 2 * rows_per_blk) RNK[tid] = __hip_atomic_fetch_add(LCNT + SEL[tid], 1, __ATOMIC_RELAXED, __HIP_MEMORY_SCOPE_WORKGROUP);
    __syncthreads();
    if (tid < 8) LCNT[8 + tid] = (int)__hip_atomic_fetch_add(F.ctl + CW_GCNT + 64 * tid, (unsigned)LCNT[tid], RLX_AGENT);
    __syncthreads();
    if (tid < 2 * rows_per_blk) { const int e = SEL[tid]; tok_e[2 * rbase + tid] = e; tok_p[2 * rbase + tid] = LCNT[8 + e] + RNK[tid]; }
    __syncthreads();
}
__device__ __forceinline__ void p12b_gather(Frame& F, const bf16* X, const float* gain, unsigned char* ws) {
    volatile LAS int* LW = (volatile LAS int*)(F.lds + LDSCTL_OFF);
    if (F.tid == 0) { int ts = 0; LW[LW_TS] = 0; LW[LW_SEG] = 0;
        for (int e = 0; e < 8; ++e) { const unsigned c = __hip_atomic_load(F.ctl + CW_GCNT + 64 * e, RLX_AGENT); const int t0 = ts; ts += (int)((c + 255u) >> 8); LW[LW_TS + e + 1] = ts; LW[LW_SEG + e + 1] = ts * 256;
            for (int t = t0; t < ts && t < MAX_TILES; ++t) LW[LW_TEXP + t] = e; } }
    __syncthreads();
    int* tok_e = (int*)(ws + WS_TOK); int* tok_p = tok_e + 2 * M; float* tok_w = (float*)(tok_p + 2 * M); float* tok_rstd = tok_w + 2 * M;
    unsigned char* Xp = ws + WS_XP;
    const int gw = F.vcu * NWAVES + F.wave, NGW = F.G * NWAVES, lane = F.lane;
    const GAS f32x4* gr = (const GAS f32x4*)gain + 2 * lane;
    for (int m = gw; m < M; m += NGW) {
        const int e0 = tok_e[2 * m], e1 = tok_e[2 * m + 1]; const int p0 = LW[LW_SEG + e0] + tok_p[2 * m], p1 = LW[LW_SEG + e1] + tok_p[2 * m + 1]; const float rstd = tok_rstd[m];
        const GAS v4u* xr = (const GAS v4u*)(X + (size_t)m * D) + lane;
        GAS v2u* d0 = (GAS v2u*)(Xp + (size_t)p0 * D) + lane; GAS v2u* d1 = (GAS v2u*)(Xp + (size_t)p1 * D) + lane;
#pragma unroll
        for (int j = 0; j < 4; ++j) { const v4u t = xr[64 * j]; const f32x4 a = pg8::bf4lo(t.x, t.y), b = pg8::bf4lo(t.z, t.w), g0 = gr[128 * j], g1 = gr[128 * j + 1];
            v2u o; o.x = pg8::pk_fp8x4(a.x * rstd * g0.x, a.y * rstd * g0.y, a.z * rstd * g0.z, a.w * rstd * g0.w); o.y = pg8::pk_fp8x4(b.x * rstd * g1.x, b.y * rstd * g1.y, b.z * rstd * g1.z, b.w * rstd * g1.w);
            d0[64 * j] = o; d1[64 * j] = o; }
        asm volatile("" ::: "memory");
        if (lane == 0) { tok_p[2 * m] = p0; tok_p[2 * m + 1] = p1; }
    }
}
__device__ __forceinline__ void p15_final(Frame& F, const bf16* X, float* out, const float* gain, unsigned char* ws, bool poison) {
    const int* tok_e = (const int*)(ws + WS_TOK); const int* tok_p = tok_e + 2 * M; const float* tok_w = (const float*)(tok_p + 2 * M);
    const bf16* Ym = (const bf16*)(ws + WS_YM);
    const int gw = F.vcu * NWAVES + F.wave, NGW = F.G * NWAVES, lane = F.lane;
    const GAS f32x4* gr = (const GAS f32x4*)gain + 2 * lane;
    v4u x[4], xn[4], a[4], an[4], b[4], bn[4]; float w0 = 0.f, w1 = 0.f, w0n, w1n;
#define P15_LOAD(m_, X_, A_, B_, W0_, W1_) do { const int p0_ = tok_p[2 * (m_)], p1_ = tok_p[2 * (m_) + 1]; W0_ = tok_w[2 * (m_)]; W1_ = tok_w[2 * (m_) + 1]; \
        const GAS v4u* xr_ = (const GAS v4u*)(X + (size_t)(m_) * D) + lane; const GAS v4u* y0_ = (const GAS v4u*)(Ym + (size_t)p0_ * D) + lane; const GAS v4u* y1_ = (const GAS v4u*)(Ym + (size_t)p1_ * D) + lane; \
        _Pragma("unroll") for (int j = 0; j < 4; ++j) { X_[j] = xr_[64 * j]; A_[j] = y0_[64 * j]; B_[j] = y1_[64 * j]; } } while (0)
    if (gw < M) P15_LOAD(gw, x, a, b, w0, w1);
    for (int m = gw; m < M; m += NGW) {
        const int mn = (m + NGW < M) ? m + NGW : m;
        P15_LOAD(mn, xn, an, bn, w0n, w1n);
        f32x4 v[4][2]; float s = 0.f;
#pragma unroll
        for (int j = 0; j < 4; ++j) {
            v[j][0] = pg8::bf4lo(x[j].x, x[j].y) + pg8::bf4lo(a[j].x, a[j].y) * w0 + pg8::bf4lo(b[j].x, b[j].y) * w1;
            v[j][1] = pg8::bf4lo(x[j].z, x[j].w) + pg8::bf4lo(a[j].z, a[j].w) * w0 + pg8::bf4lo(b[j].z, b[j].w) * w1;
#pragma unroll
            for (int q = 0; q < 2; ++q) s += (v[j][q].x * v[j][q].x + v[j][q].y * v[j][q].y) + (v[j][q].z * v[j][q].z + v[j][q].w * v[j][q].w); }
        float rstd = 1.f / sqrtf(wave_sum(s) * (1.f / D) + EPS);
        if (poison) rstd = __builtin_nanf("");
        GAS f32x4* xo = (GAS f32x4*)(out + (size_t)m * D) + 2 * lane;
#pragma unroll
        for (int j = 0; j < 4; ++j)
#pragma unroll
            for (int q = 0; q < 2; ++q) { const f32x4 g = gr[128 * j + q]; xo[128 * j + q] = (f32x4){v[j][q].x * rstd * g.x, v[j][q].y * rstd * g.y, v[j][q].z * rstd * g.z, v[j][q].w * rstd * g.w}; }
#pragma unroll
        for (int j = 0; j < 4; ++j) { x[j] = xn[j]; a[j] = an[j]; b[j] = bn[j]; }
        w0 = w0n; w1 = w1n;
    }
#undef P15_LOAD
}
struct Args { const void* in[29]; float* out; unsigned char* ws; };
__global__ void __launch_bounds__(NWAVES * 64, 2) hybrid_fwd(Args args) {
    extern __shared__ __attribute__((aligned(16))) unsigned char lds[];
    Frame F;
    F.lds = (LAS unsigned char*)lds;
    F.MISC = (volatile LAS unsigned*)(F.lds + MISC_OFF);
    F.tid = threadIdx.x; F.lane = F.tid & 63; F.wave = __builtin_amdgcn_readfirstlane(F.tid >> 6);
    F.G = gridDim.x; { const int bx = blockIdx.x; F.vcu = (F.G % 8 == 0) ? (bx % 8) * (F.G / 8) + bx / 8 : bx; }
    unsigned char* ws = args.ws;
    F.ctl = (gu32*)(ws + WS_CTL);
    for (int u = F.tid; u < (LDS_BYTES - LDSCTL_OFF) / 4; u += NWAVES * 64) ((LAS unsigned*)(F.lds + LDSCTL_OFF))[u] = 0u;
    __syncthreads();
    XcdBarrier bar = xcd_barrier_post((unsigned*)(F.ctl + CW_BAR), F.MISC + 8);
#define GRID_BAR() do { xcd_barrier(bar); int t_ = threadIdx.x; asm volatile("" : "+v"(t_)); F.tid = t_; F.lane = t_ & 63; } while (0)
    const float* x = (const float*)args.in[0]; float* out = args.out;
    bf16* const A = (bf16*)(ws + WS_A); bf16* const XR = (bf16*)(ws + WS_XR);
    typedef pg8::bf16_t pb;

    { P0Args a; a.w_in = (const float*)args.in[3]; a.w_out = (const float*)args.in[10]; a.w_gate = (const float*)args.in[12]; a.w_up = (const float*)args.in[13]; a.w_down = (const float*)args.in[14];
      a.w_qkv = (const float*)args.in[16]; a.w_o = (const float*)args.in[22]; a.w_pool = (const float*)args.in[4]; a.we_gate = (const float*)args.in[25]; a.we_up = (const float*)args.in[26]; a.we_down = (const float*)args.in[27];
      a.w_spatial = (const float*)args.in[8]; a.positions = (const int*)args.in[1]; a.x = x; a.norm_mix = (const float*)args.in[2];
      p0_prologue(F, a, ws); }
    GRID_BAR();
    { pg8::Gemm g{(const pb*)A, (const pb*)(ws + WS_WIN), D, 0}; pg8::StaticOrder S; S.init(M, ZW, F.G, (int)blockIdx.x);
      pg8::EpiZ E{(pb*)(ws + WS_Z), ZW, PW / 256};
      pg8::gemm_phase<pg8::EpiZ, pg8::StaticOrder, true, true>(F.lds + RING_OFF, g, S, E); }
    GRID_BAR();
    p2_mixer(F, (const bf16*)(ws + WS_Z), (bf16*)(ws + WS_Y1), (const bf16*)(ws + WS_WPOOL), (const float*)args.in[5], (const bf16*)(ws + WS_WSP), (const float*)args.in[9], (const float*)args.in[6], (const float*)args.in[7]);
    GRID_BAR();
    { pg8::Gemm g{(const pb*)(ws + WS_Y1), (const pb*)(ws + WS_WOUT), D, 0}; pg8::StaticOrder S; S.init(M, D, F.G, (int)blockIdx.x);
      pg8::EpiResB<true> E{x, (pb*)XR, D, 1.0f};
      pg8::gemm_phase<pg8::EpiResB<true>, pg8::StaticOrder, true, true>(F.lds + RING_OFF, g, S, E); }
    GRID_BAR();
    norm_phase_q(F, XR, (const float*)args.in[11], (unsigned char*)A, (float*)(ws + WS_HSCALE));
    GRID_BAR();
    { pg8::Gemm g{(const pb*)A, (const pb*)(ws + WS_WGU), D / 2, 0}; pg8::StaticOrder S; S.init(M, 2 * FF, F.G, (int)blockIdx.x);
      volatile LAS float* LWf = (volatile LAS float*)(F.lds + LDSCTL_OFF);
      pg8::EpiSwiGLUq E{ws + WS_ACT, FF, (const float*)(ws + WS_HSCALE), LWf[LW_WSC], LWf[LW_WSC + 1]};
      pg8::gemm_phase<pg8::EpiSwiGLUq, pg8::StaticOrder, true, true, false, true>(F.lds + RING_OFF, g, S, E); }
    GRID_BAR();
    { pg8::Gemm g{(const pb*)(ws + WS_ACT), (const pb*)(ws + WS_WD), FF / 2, 0}; pg8::StaticOrder S; S.init(M, D, F.G, (int)blockIdx.x);
      pg8::EpiResB<false> E{(const pb*)XR, (pb*)XR, D, 1.0f / W8_SCALE};
      pg8::gemm_phase<pg8::EpiResB<false>, pg8::StaticOrder, true, true, true>(F.lds + RING_OFF, g, S, E); }
    GRID_BAR();
    norm_phase_q(F, XR, (const float*)args.in[15], (unsigned char*)A, (float*)(ws + WS_HSCALE));
    GRID_BAR();
    { pg8::Gemm g{(const pb*)A, (const pb*)(ws + WS_WQKV), D / 2, 0}; pg8::StaticOrder S; S.init(M, 2 * D, F.G, (int)blockIdx.x);
      pg8::EpiQKVq8 E{ws + WS_Q, ws + WS_K, D, (const float*)(ws + WS_ROPE), attn_body::C2, (const float*)(ws + WS_HSCALE), ((volatile LAS float*)(F.lds + LDSCTL_OFF))[LW_WSC + 2]};
      pg8::gemm_phase<pg8::EpiQKVq8, pg8::StaticOrder, true, true, false, true>(F.lds + RING_OFF, g, S, E); }
    { pg8::Gemm g{(const pb*)(ws + WS_WQKV + (size_t)2 * D * D), (const pb*)A, D / 2, 0}; pg8::StaticOrder S; S.init(D, M, F.G, (int)blockIdx.x);
      pg8::EpiVT E{ws + WS_V, (const float*)(ws + WS_HSCALE), ((volatile LAS float*)(F.lds + LDSCTL_OFF))[LW_WSC + 2], SEQ};
      pg8::gemm_phase<pg8::EpiVT, pg8::StaticOrder, true, true, false, true>(F.lds + RING_OFF, g, S, E); }
    GRID_BAR();
    { const attn_body::DiffOrder S(F.vcu); attn_body::AttnUnit u;
      const unsigned char* Qb = ws + WS_Q; const unsigned char* Kb = ws + WS_K;     const unsigned char* VTb = ws + WS_V;
#define ATTN_UNITS(TRAIL) for (int i = 0; S.next(i, u); ++i) { const int qc = (u.h * 2 + u.c) * 64, vc = u.h * 128; \
          attn_body::bf16* Ob = (attn_body::bf16*)(ws + (u.c ? WS_O1 : WS_O0)); \
          attn_body::attn_unit<8, TRAIL>(u.b, 0, u.qb, Qb + qc, Kb + qc, VTb + (size_t)(u.b * 16 + u.h) * 128 * SEQ, Ob + vc, (char*)lds + RING_OFF); }
      if (F.wave < 4) { ATTN_UNITS(false) } else { ATTN_UNITS(true) }
#undef ATTN_UNITS
    }
    GRID_BAR();
    p10_combine(F, (const bf16*)(ws + WS_O0), (const bf16*)(ws + WS_O1), (unsigned char*)A, (float*)(ws + WS_HSCALE), (const float*)args.in[17], (const float*)args.in[18], (const float*)args.in[19], (const float*)args.in[20], (const float*)args.in[21]);
    GRID_BAR();
    { pg8::Gemm g{(const pb*)A, (const pb*)(ws + WS_WO), D / 2, 0}; pg8::StaticOrder S; S.init(M, D, F.G, (int)blockIdx.x);
      pg8::EpiResBq E{(pb*)XR, D, (const float*)(ws + WS_HSCALE), ((volatile LAS float*)(F.lds + LDSCTL_OFF))[LW_WSC + 3]};
      pg8::gemm_phase<pg8::EpiResBq, pg8::StaticOrder, true, true, false, true>(F.lds + RING_OFF, g, S, E); }
    GRID_BAR();
    p12a_route(F, XR, (const float*)args.in[23], (const float*)args.in[24], ws);
    GRID_BAR();
    p12b_gather(F, XR, (const float*)args.in[23], ws);
    GRID_BAR();
    { volatile LAS int* LW = (volatile LAS int*)(F.lds + LDSCTL_OFF); const int n_tiles = __builtin_amdgcn_readfirstlane(LW[LW_TS + 8]);
      { pg8::Gemm g{(const pb*)(ws + WS_XP), (const pb*)(ws + WS_WEGU), D / 2, (size_t)2 * FF * D}; pg8::MoeOrder S; S.init(n_tiles * 256, 2 * FF, F.G, (int)blockIdx.x); S.tile0 = 0;
        S.texp = (const volatile LAS int*)(F.lds + LDSCTL_OFF) + LW_TEXP;
        pg8::EpiSwiGLU8 E{ws + WS_ACTC, FF, 1.0f / W8_SCALE};
        pg8::gemm_phase<pg8::EpiSwiGLU8, pg8::MoeOrder, true, true, true>(F.lds + RING_OFF, g, S, E); }
      GRID_BAR();
      { pg8::Gemm g{(const pb*)(ws + WS_ACTC), (const pb*)(ws + WS_WED), FF / 2, (size_t)D * FF}; pg8::MoeOrder S; S.init(n_tiles * 256, D, F.G, (int)blockIdx.x); S.tile0 = 0;
        S.texp = (const volatile LAS int*)(F.lds + LDSCTL_OFF) + LW_TEXP;
        pg8::EpiPlainS E{(pb*)(ws + WS_YM), D, 1.0f / W8_SCALE};
        pg8::gemm_phase<pg8::EpiPlainS, pg8::MoeOrder, true, true, true>(F.lds + RING_OFF, g, S, E); }
      GRID_BAR();
    }
    { const bool poison = __hip_atomic_load(F.ctl + CW_BAR + XB_TMO, RLX_AGENT) != 0u;
      p15_final(F, XR, out, (const float*)args.in[28], ws, poison); }
}

extern "C" void kernel_launch(void* const* d_in, const int* in_sizes, int n_in, void* d_out, int out_size, void* d_ws, size_t ws_size, hipStream_t stream) {
    static int grid = 0;
    if (grid == 0) {
        if (n_in != 29 || in_sizes[0] != M * D || out_size != M * D || ws_size < WS_END) { fprintf(stderr, "kernel_launch: unexpected shapes (n_in %d, in0 %d, out %d, ws %zu < %zu); nothing launched\n", n_in, n_in > 0 ? in_sizes[0] : -1, out_size, ws_size, (size_t)WS_END); grid = -1; return; }
        int dev = 0, cus = 0, per_cu = 0;
        if (hipGetDevice(&dev) != hipSuccess || hipDeviceGetAttribute(&cus, hipDeviceAttributeMultiprocessorCount, dev) != hipSuccess) { grid = -1; return; }
        if (hipFuncSetAttribute((const void*)hybrid_fwd, hipFuncAttributeMaxDynamicSharedMemorySize, LDS_BYTES) != hipSuccess) { fprintf(stderr, "kernel_launch: hipFuncSetAttribute failed\n"); grid = -1; return; }
        if (hipOccupancyMaxActiveBlocksPerMultiprocessor(&per_cu, (const void*)hybrid_fwd, NWAVES * 64, LDS_BYTES) != hipSuccess || per_cu < 1) fprintf(stderr, "kernel_launch: occupancy query says %d\n", per_cu);
        (void)hipGetLastError();
        if (cus < 256) { fprintf(stderr, "kernel_launch: needs 256 CUs, device has %d\n", cus); grid = -1; return; }
        grid = 256;
    }
    if (grid < 0) return;
    if (hipMemsetAsync((char*)d_ws + WS_CTL, 0, CTL_ZERO_BYTES, stream) != hipSuccess) return;
    Args a{};
    for (int i = 0; i < 29; ++i) a.in[i] = d_in[i];
    a.out = (float*)d_out; a.ws = (unsigned char*)d_ws;
    hipLaunchKernelGGL(hybrid_fwd, dim3(grid), dim3(NWAVES * 64), LDS_BYTES, stream, a);
    const hipError_t le = hipPeekAtLastError();
    if (le != hipSuccess) fprintf(stderr, "kernel_launch: launch failed: %s\n", hipGetErrorName(le));
}
```

```cpp
#include <hip/hip_runtime.h>
#include <hip/hip_bf16.h>
#include <cstdio>
#include <cstdint>
#include <cmath>
namespace pg8 {
#define PG8_LAS __attribute__((address_space(3)))
typedef unsigned short bf16_t;
typedef short bf16x8 __attribute__((ext_vector_type(8)));
typedef float f32x4 __attribute__((ext_vector_type(4)));
typedef unsigned u32x4 __attribute__((ext_vector_type(4)));
constexpr int BM = 256, BK = 64, HALF = 128, HTB = HALF * BK * 2  , STAGE_BYTES = 8 * HTB, NXCD = 8, WGM = 8;

__host__ __device__ __forceinline__ int lds_byte(int r, int c) { const int st = (r >> 4) * 2 + (c >> 5), rr = r & 15, cc = c & 31, ob = rr * 64 + cc * 2; return st * 1024 + (ob ^ (((ob >> 9) & 1) << 5)); }
__host__ __device__ __forceinline__ void stage_rc(int b, int& R, int& C) { const int st = b / 1024, sb = b % 1024, swz = sb ^ (((sb >> 9) & 1) << 5); R = (st >> 1) * 16 + swz / 64; C = (st & 1) * 32 + (swz % 64) / 2; }
__host__ __device__ __forceinline__ int perm32(int rho) { const int n = rho >> 4, i = rho & 15; return 8 * (i >> 2) + 4 * n + (i & 3); }

struct Unit { int pm, pn, be; };
struct Gemm { const bf16_t* A; const bf16_t* Bt; int K; size_t bstride; };

struct StaticOrder {
    int nM, nN, nwg, G, c;
    __host__ __device__ void init(int M, int N, int G_, int c_) { nM = M / BM; nN = N / BM; nwg = nM * nN; G = G_; c = c_; }
    __host__ __device__ bool next(int i, Unit& u) const {
        const long L = (long)i * G + c; if (L >= nwg) return false;
        int wgid = (int)L; { const int q = nwg / NXCD, r = nwg % NXCD, xcd = wgid % NXCD, off = wgid / NXCD; wgid = (xcd < r ? xcd * (q + 1) : r * (q + 1) + (xcd - r) * q) + off; }
        const int nig = WGM * nN, gid = wgid / nig, fm = gid * WGM, gsz = (nM - fm) < WGM ? (nM - fm) : WGM;
        u.pm = fm + ((wgid % nig) % gsz); u.pn = (wgid % nig) / gsz; u.be = 0; return true;
    }
    __device__ __forceinline__ void a_ready(const Unit&) const {}
    __device__ __forceinline__ void done(const Unit&) const {}
};

__device__ __forceinline__ unsigned cvt_pk_bf16(float lo, float hi) { unsigned r; asm volatile("v_cvt_pk_bf16_f32 %0, %1, %2" : "=v"(r) : "v"(lo), "v"(hi)); return r; }
typedef float f32x2 __attribute__((ext_vector_type(2)));
__device__ __forceinline__ f32x2 gelu_pk(f32x2 v) {
    const f32x2 av = __builtin_elementwise_abs(v), d = av * 0.2316418882f + 1.0f;
    f32x2 t; t.x = __builtin_amdgcn_rcpf(d.x); t.y = __builtin_amdgcn_rcpf(d.y);
    f32x2 q = t * 0.5307027145f + (-0.7265760135f); q = q * t + 0.7107068705f; q = q * t + (-0.142248368f); q = q * t + 0.127414796f; q = q * t;
    const f32x2 s = (v * v) * (-0.72134752044f);
    f32x2 e; e.x = __builtin_amdgcn_exp2f(s.x); e.y = __builtin_amdgcn_exp2f(s.y);
    const f32x2 m = v * (q * e), r = v - m;
    f32x2 o; o.x = v.x < 0.f ? m.x : r.x; o.y = v.y < 0.f ? m.y : r.y; return o;
}

typedef int v4i_t __attribute__((ext_vector_type(4)));
__device__ __forceinline__ u32x4 pack8(f32x4 v0, f32x4 v1) { u32x4 w; w.x = cvt_pk_bf16(v0[0], v0[1]); w.y = cvt_pk_bf16(v0[2], v0[3]); w.z = cvt_pk_bf16(v1[0], v1[1]); w.w = cvt_pk_bf16(v1[2], v1[3]); return w; }
__device__ __forceinline__ f32x4 gelu4(f32x4 v) { const f32x2 a = gelu_pk((f32x2){v[0], v[1]}), b = gelu_pk((f32x2){v[2], v[3]}); return (f32x4){a.x, a.y, b.x, b.y}; }
__device__ __forceinline__ float silu1(float x) { return x * __builtin_amdgcn_rcpf(1.0f + __builtin_amdgcn_exp2f(x * -1.4426950408889634f)); }
__device__ __forceinline__ f32x4 swiglu4(f32x4 g, f32x4 u) { return (f32x4){silu1(g[0]) * u[0], silu1(g[1]) * u[1], silu1(g[2]) * u[2], silu1(g[3]) * u[3]}; }

struct EpiZ {
    static constexpr bool PERM = true, AFTER_DRAIN = false;
    bf16_t* O; int ldc; int gelu_from;
    __device__ __forceinline__ void operator()(const f32x4 (&acc)[2][2][4][2], const Unit& u, int wr, int wc, int fr, int fq) const {
        const int row0 = u.pm * BM + wr * 64 + fr, col0 = u.pn * BM + wc * 32 + 8 * fq; const bool gel = u.pn >= gelu_from;
#pragma unroll
        for (int ai = 0; ai < 2; ++ai)
#pragma unroll
            for (int m = 0; m < 4; ++m) { bf16_t* rowp = O + (size_t)(row0 + ai * HALF + m * 16) * ldc + col0;
#pragma unroll
                for (int bj = 0; bj < 2; ++bj) { f32x4 v0 = acc[ai][bj][m][0], v1 = acc[ai][bj][m][1];
                    if (gel) { v0 = gelu4(v0); v1 = gelu4(v1); }
                    *(u32x4*)(rowp + bj * HALF) = pack8(v0, v1); } }
    }
};
struct EpiPlain {
    static constexpr bool PERM = true, AFTER_DRAIN = false;
    bf16_t* O; int ldc;
    __device__ __forceinline__ void operator()(const f32x4 (&acc)[2][2][4][2], const Unit& u, int wr, int wc, int fr, int fq) const {
        const int row0 = u.pm * BM + wr * 64 + fr, col0 = u.pn * BM + wc * 32 + 8 * fq;
#pragma unroll
        for (int ai = 0; ai < 2; ++ai)
#pragma unroll
            for (int m = 0; m < 4; ++m) { bf16_t* rowp = O + (size_t)(row0 + ai * HALF + m * 16) * ldc + col0;
#pragma unroll
                for (int bj = 0; bj < 2; ++bj) *(u32x4*)(rowp + bj * HALF) = pack8(acc[ai][bj][m][0], acc[ai][bj][m][1]); }
    }
};
__device__ __forceinline__ f32x4 bf4lo(unsigned a, unsigned b) { return (f32x4){__uint_as_float(a << 16), __uint_as_float(a & 0xffff0000u), __uint_as_float(b << 16), __uint_as_float(b & 0xffff0000u)}; }
template <bool RES32> struct EpiResB {
    static constexpr bool PERM = true, AFTER_DRAIN = false;
    const void* res; bf16_t* out; int ldc; float s;
    __device__ __forceinline__ void operator()(const f32x4 (&acc)[2][2][4][2], const Unit& u, int wr, int wc, int fr, int fq) const {
        const int row0 = u.pm * BM + wr * 64 + fr, col0 = u.pn * BM + wc * 32 + 8 * fq;
#pragma unroll
        for (int ai = 0; ai < 2; ++ai) { f32x4 r[4][2][2];
#pragma unroll
            for (int m = 0; m < 4; ++m) { const size_t off = (size_t)(row0 + ai * HALF + m * 16) * ldc + col0;
#pragma unroll
                for (int bj = 0; bj < 2; ++bj) {
                    if constexpr (RES32) { r[m][bj][0] = *(const f32x4*)((const float*)res + off + bj * HALF); r[m][bj][1] = *(const f32x4*)((const float*)res + off + bj * HALF + 4); }
                    else { const u32x4 w = *(const u32x4*)((const bf16_t*)res + off + bj * HALF); r[m][bj][0] = bf4lo(w.x, w.y); r[m][bj][1] = bf4lo(w.z, w.w); } } }
#pragma unroll
            for (int m = 0; m < 4; ++m) { const size_t off = (size_t)(row0 + ai * HALF + m * 16) * ldc + col0;
#pragma unroll
                for (int bj = 0; bj < 2; ++bj) *(u32x4*)(out + off + bj * HALF) = pack8(r[m][bj][0] + acc[ai][bj][m][0] * s, r[m][bj][1] + acc[ai][bj][m][1] * s); }
            asm volatile("" ::: "memory"); }
    }
};
struct EpiSwiGLU {
    static constexpr bool PERM = true, AFTER_DRAIN = false;
    bf16_t* O; int ldc;
    __device__ __forceinline__ void operator()(const f32x4 (&acc)[2][2][4][2], const Unit& u, int wr, int wc, int fr, int fq) const {
        const int row0 = u.pm * BM + wr * 64 + fr, col0 = u.pn * HALF + wc * 32 + 8 * fq;
#pragma unroll
        for (int ai = 0; ai < 2; ++ai)
#pragma unroll
            for (int m = 0; m < 4; ++m) { bf16_t* rowp = O + (size_t)(row0 + ai * HALF + m * 16) * ldc + col0;
                const f32x4 a0 = swiglu4(acc[ai][0][m][0], acc[ai][1][m][0]), a1 = swiglu4(acc[ai][0][m][1], acc[ai][1][m][1]);
                *(u32x4*)rowp = pack8(a0, a1); }
    }
};
struct EpiQKV {
    static constexpr bool PERM = true, AFTER_DRAIN = false;
    bf16_t* Q; bf16_t* Kk; bf16_t* V; int ldc; const float* rope; float qscale;
    __device__ __forceinline__ void operator()(const f32x4 (&acc)[2][2][4][2], const Unit& u, int wr, int wc, int fr, int fq) const {
        const int row0 = u.pm * BM + wr * 64 + fr;
        if (u.pn < 16) {
            bf16_t* base = (u.pn < 8) ? Q : Kk; const float sc = (u.pn < 8) ? qscale : 1.0f; const int col0 = (u.pn & 7) * BM + wc * 64 + 8 * fq;
#pragma unroll
            for (int ai = 0; ai < 2; ++ai)
#pragma unroll
                for (int m = 0; m < 4; ++m) { const int r = row0 + ai * HALF + m * 16; const float* cs = rope + (size_t)r * 64 + 8 * fq;
                    const f32x4 c0 = *(const f32x4*)(cs), c1 = *(const f32x4*)(cs + 4), s0 = *(const f32x4*)(cs + 32), s1 = *(const f32x4*)(cs + 36);
                    const f32x4 x10 = acc[ai][0][m][0], x11 = acc[ai][0][m][1], x20 = acc[ai][1][m][0], x21 = acc[ai][1][m][1];
                    const f32x4 o10 = (x10 * c0 - x20 * s0) * sc, o11 = (x11 * c1 - x21 * s1) * sc, o20 = (x20 * c0 + x10 * s0) * sc, o21 = (x21 * c1 + x11 * s1) * sc;
                    bf16_t* rowp = base + (size_t)r * ldc + col0;
                    *(u32x4*)rowp = pack8(o10, o11); *(u32x4*)(rowp + 32) = pack8(o20, o21); }
        } else {
            const int col0 = (u.pn - 16) * BM + wc * 32 + 8 * fq;
#pragma unroll
            for (int ai = 0; ai < 2; ++ai)
#pragma unroll
                for (int m = 0; m < 4; ++m) { bf16_t* rowp = V + (size_t)(row0 + ai * HALF + m * 16) * ldc + col0;
#pragma unroll
                    for (int bj = 0; bj < 2; ++bj) *(u32x4*)(rowp + bj * HALF) = pack8(acc[ai][bj][m][0], acc[ai][bj][m][1]); }
        }
    }
};
__device__ __forceinline__ f32x4 cvti4(f32x4 a, float f) { return __builtin_convertvector(__builtin_bit_cast(v4i_t, a), f32x4) * f; }
struct EpiQKVq {
    static constexpr bool PERM = true, AFTER_DRAIN = false;
    bf16_t* Q; bf16_t* Kk; bf16_t* V; int ldc; const float* rope; float qscale; const float* rowscale; float sw;
    __device__ __forceinline__ void operator()(const f32x4 (&acc)[2][2][4][2], const Unit& u, int wr, int wc, int fr, int fq) const {
        const int row0 = u.pm * BM + wr * 64 + fr;
        if (u.pn < 16) {
            bf16_t* base = (u.pn < 8) ? Q : Kk; const float sc = (u.pn < 8) ? qscale : 1.0f; const int col0 = (u.pn & 7) * BM + wc * 64 + 8 * fq;
#pragma unroll
            for (int ai = 0; ai < 2; ++ai)
#pragma unroll
                for (int m = 0; m < 4; ++m) { const int r = row0 + ai * HALF + m * 16; const float* cs = rope + (size_t)r * 64 + 8 * fq; const float f = rowscale[r] * sw;
                    const f32x4 c0 = *(const f32x4*)(cs), c1 = *(const f32x4*)(cs + 4), s0 = *(const f32x4*)(cs + 32), s1 = *(const f32x4*)(cs + 36);
                    const f32x4 x10 = cvti4(acc[ai][0][m][0], f), x11 = cvti4(acc[ai][0][m][1], f), x20 = cvti4(acc[ai][1][m][0], f), x21 = cvti4(acc[ai][1][m][1], f);
                    const f32x4 o10 = (x10 * c0 - x20 * s0) * sc, o11 = (x11 * c1 - x21 * s1) * sc, o20 = (x20 * c0 + x10 * s0) * sc, o21 = (x21 * c1 + x11 * s1) * sc;
                    bf16_t* rowp = base + (size_t)r * ldc + col0;
                    *(u32x4*)rowp = pack8(o10, o11); *(u32x4*)(rowp + 32) = pack8(o20, o21); }
        } else {
            const int col0 = (u.pn - 16) * BM + wc * 32 + 8 * fq;
#pragma unroll
            for (int ai = 0; ai < 2; ++ai)
#pragma unroll
                for (int m = 0; m < 4; ++m) { const int r = row0 + ai * HALF + m * 16; bf16_t* rowp = V + (size_t)r * ldc + col0; const float f = rowscale[r] * sw;
#pragma unroll
                    for (int bj = 0; bj < 2; ++bj) *(u32x4*)(rowp + bj * HALF) = pack8(cvti4(acc[ai][bj][m][0], f), cvti4(acc[ai][bj][m][1], f)); }
        }
    }
};
struct EpiResBq {
    static constexpr bool PERM = true, AFTER_DRAIN = false;
    bf16_t* xr; int ldc; const float* rowscale; float sw;
    __device__ __forceinline__ void operator()(const f32x4 (&acc)[2][2][4][2], const Unit& u, int wr, int wc, int fr, int fq) const {
        const int row0 = u.pm * BM + wr * 64 + fr, col0 = u.pn * BM + wc * 32 + 8 * fq;
#pragma unroll
        for (int ai = 0; ai < 2; ++ai) { u32x4 r[4][2]; float f[4];
#pragma unroll
            for (int m = 0; m < 4; ++m) { const int rr = row0 + ai * HALF + m * 16; const size_t off = (size_t)rr * ldc + col0; f[m] = rowscale[rr] * sw;
#pragma unroll
                for (int bj = 0; bj < 2; ++bj) r[m][bj] = *(const u32x4*)(xr + off + bj * HALF); }
#pragma unroll
            for (int m = 0; m < 4; ++m) { const size_t off = (size_t)(row0 + ai * HALF + m * 16) * ldc + col0;
#pragma unroll
                for (int bj = 0; bj < 2; ++bj) *(u32x4*)(xr + off + bj * HALF) = pack8(bf4lo(r[m][bj].x, r[m][bj].y) + cvti4(acc[ai][bj][m][0], f[m]), bf4lo(r[m][bj].z, r[m][bj].w) + cvti4(acc[ai][bj][m][1], f[m])); }
            asm volatile("" ::: "memory"); }
    }
};
__device__ __forceinline__ unsigned pk_fp8x4(float a, float b, float c, float d) { unsigned w = 0u; w = (unsigned)__builtin_amdgcn_cvt_pk_fp8_f32(a, b, (int)w, false); w = (unsigned)__builtin_amdgcn_cvt_pk_fp8_f32(c, d, (int)w, true); return w; }
typedef unsigned u32x2 __attribute__((ext_vector_type(2)));
struct EpiSwiGLU8 {
    static constexpr bool PERM = true, AFTER_DRAIN = false;
    unsigned char* O; int ldc; float s;
    __device__ __forceinline__ void operator()(const f32x4 (&acc)[2][2][4][2], const Unit& u, int wr, int wc, int fr, int fq) const {
        const int row0 = u.pm * BM + wr * 64 + fr, col0 = u.pn * HALF + wc * 32 + 8 * fq;
#pragma unroll
        for (int ai = 0; ai < 2; ++ai)
#pragma unroll
            for (int m = 0; m < 4; ++m) { unsigned char* rowp = O + (size_t)(row0 + ai * HALF + m * 16) * ldc + col0;
                const f32x4 a0 = swiglu4(acc[ai][0][m][0] * s, acc[ai][1][m][0] * s), a1 = swiglu4(acc[ai][0][m][1] * s, acc[ai][1][m][1] * s);
                u32x2 w; w.x = pk_fp8x4(a0[0], a0[1], a0[2], a0[3]); w.y = pk_fp8x4(a1[0], a1[1], a1[2], a1[3]);
                *(u32x2*)rowp = w; }
    }
};
struct EpiSwiGLUq {
    static constexpr bool PERM = true, AFTER_DRAIN = false;
    unsigned char* O; int ldc; const float* rowscale; float sg, su;
    __device__ __forceinline__ void operator()(const f32x4 (&acc)[2][2][4][2], const Unit& u, int wr, int wc, int fr, int fq) const {
        const int row0 = u.pm * BM + wr * 64 + fr, col0 = u.pn * HALF + wc * 32 + 8 * fq;
#pragma unroll
        for (int ai = 0; ai < 2; ++ai)
#pragma unroll
            for (int m = 0; m < 4; ++m) { const int r = row0 + ai * HALF + m * 16; unsigned char* rowp = O + (size_t)r * ldc + col0; const float rs = rowscale[r]; const float fg = rs * sg, fu = rs * su;
                const f32x4 g0 = __builtin_convertvector(__builtin_bit_cast(v4i_t, acc[ai][0][m][0]), f32x4) * fg, g1 = __builtin_convertvector(__builtin_bit_cast(v4i_t, acc[ai][0][m][1]), f32x4) * fg;
                const f32x4 u0 = __builtin_convertvector(__builtin_bit_cast(v4i_t, acc[ai][1][m][0]), f32x4) * fu, u1 = __builtin_convertvector(__builtin_bit_cast(v4i_t, acc[ai][1][m][1]), f32x4) * fu;
                const f32x4 a0 = swiglu4(g0, u0), a1 = swiglu4(g1, u1);
                u32x2 w; w.x = pk_fp8x4(a0[0], a0[1], a0[2], a0[3]); w.y = pk_fp8x4(a1[0], a1[1], a1[2], a1[3]);
                *(u32x2*)rowp = w; }
    }
};
struct EpiQKVq8 {
    static constexpr bool PERM = true, AFTER_DRAIN = false;
    unsigned char* Q; unsigned char* Kk; int ldc; const float* rope; float qscale; const float* rowscale; float sw;
    __device__ __forceinline__ void operator()(const f32x4 (&acc)[2][2][4][2], const Unit& u, int wr, int wc, int fr, int fq) const {
        const int row0 = u.pm * BM + wr * 64 + fr;
        unsigned char* base = (u.pn < 8) ? Q : Kk; const float sc = (u.pn < 8) ? qscale : 1.0f; const int col0 = (u.pn & 7) * BM + wc * 64 + 8 * fq;
#pragma unroll
        for (int ai = 0; ai < 2; ++ai)
#pragma unroll
            for (int m = 0; m < 4; ++m) { const int r = row0 + ai * HALF + m * 16; const float* cs = rope + (size_t)r * 64 + 8 * fq; const float f = rowscale[r] * sw;
                const f32x4 c0 = *(const f32x4*)(cs), c1 = *(const f32x4*)(cs + 4), s0 = *(const f32x4*)(cs + 32), s1 = *(const f32x4*)(cs + 36);
                const f32x4 x10 = cvti4(acc[ai][0][m][0], f), x11 = cvti4(acc[ai][0][m][1], f), x20 = cvti4(acc[ai][1][m][0], f), x21 = cvti4(acc[ai][1][m][1], f);
                const f32x4 o10 = (x10 * c0 - x20 * s0) * sc, o11 = (x11 * c1 - x21 * s1) * sc, o20 = (x20 * c0 + x10 * s0) * sc, o21 = (x21 * c1 + x11 * s1) * sc;
                unsigned char* rowp = base + (size_t)r * ldc + col0;
                u32x2 w1, w2; w1.x = pk_fp8x4(o10[0], o10[1], o10[2], o10[3]); w1.y = pk_fp8x4(o11[0], o11[1], o11[2], o11[3]); w2.x = pk_fp8x4(o20[0], o20[1], o20[2], o20[3]); w2.y = pk_fp8x4(o21[0], o21[1], o21[2], o21[3]);
                *(u32x2*)rowp = w1; *(u32x2*)(rowp + 32) = w2; }
    }
};
struct EpiVT {
    static constexpr bool PERM = true, AFTER_DRAIN = false;
    unsigned char* VT; const float* rowscale; float sw; int seq;
    __device__ __forceinline__ void operator()(const f32x4 (&acc)[2][2][4][2], const Unit& u, int wr, int wc, int fr, int fq) const {
        const int row0 = u.pm * BM + wr * 64 + fr;
#pragma unroll
        for (int bj = 0; bj < 2; ++bj) { const int c0 = u.pn * BM + bj * HALF + wc * 32 + 8 * fq;
            const f32x4 s0 = *(const f32x4*)(rowscale + c0) * sw, s1 = *(const f32x4*)(rowscale + c0 + 4) * sw;
            const int b = c0 / seq, pos = c0 % seq, k0 = pos & 63; const int basep = (pos & ~63) + 16 * ((k0 >> 5) & 1) + 4 * ((k0 & 31) >> 3);
#pragma unroll
            for (int ai = 0; ai < 2; ++ai)
#pragma unroll
                for (int m = 0; m < 4; ++m) { const int r = row0 + ai * HALF + m * 16;
                    const f32x4 v0 = __builtin_convertvector(__builtin_bit_cast(v4i_t, acc[ai][bj][m][0]), f32x4) * s0, v1 = __builtin_convertvector(__builtin_bit_cast(v4i_t, acc[ai][bj][m][1]), f32x4) * s1;
                    unsigned char* p = VT + ((size_t)(b * 16 + (r >> 7)) * 128 + (r & 127)) * seq + basep;
                    *(unsigned*)p = pk_fp8x4(v0[0], v0[1], v0[2], v0[3]); *(unsigned*)(p + 32) = pk_fp8x4(v1[0], v1[1], v1[2], v1[3]); } }
    }
};
struct EpiPlainS {
    static constexpr bool PERM = true, AFTER_DRAIN = false;
    bf16_t* O; int ldc; float s;
    __device__ __forceinline__ void operator()(const f32x4 (&acc)[2][2][4][2], const Unit& u, int wr, int wc, int fr, int fq) const {
        const int row0 = u.pm * BM + wr * 64 + fr, col0 = u.pn * BM + wc * 32 + 8 * fq;
#pragma unroll
        for (int ai = 0; ai < 2; ++ai)
#pragma unroll
            for (int m = 0; m < 4; ++m) { bf16_t* rowp = O + (size_t)(row0 + ai * HALF + m * 16) * ldc + col0;
#pragma unroll
                for (int bj = 0; bj < 2; ++bj) *(u32x4*)(rowp + bj * HALF) = pack8(acc[ai][bj][m][0] * s, acc[ai][bj][m][1] * s); }
    }
};
struct MoeOrder : StaticOrder {
    int tile0; const volatile PG8_LAS int* texp;
    __device__ __forceinline__ bool next(int i, Unit& u) const {
        if (!StaticOrder::next(i, u)) return false;
        u.be = __builtin_amdgcn_readfirstlane(texp[tile0 + u.pm]); return true;
    }
};
typedef int v4i_t __attribute__((ext_vector_type(4))); typedef int v8i_t __attribute__((ext_vector_type(8)));
__device__ __forceinline__ void mma8(f32x4& c, bf16x8 b0, bf16x8 b1, bf16x8 a0, bf16x8 a1, int sc) {
    const v4i_t x0 = __builtin_bit_cast(v4i_t, b0), x1 = __builtin_bit_cast(v4i_t, b1), y0 = __builtin_bit_cast(v4i_t, a0), y1 = __builtin_bit_cast(v4i_t, a1);
    const v8i_t X = __builtin_shufflevector(x0, x1, 0, 1, 2, 3, 4, 5, 6, 7), Y = __builtin_shufflevector(y0, y1, 0, 1, 2, 3, 4, 5, 6, 7);
    asm volatile("v_mfma_scale_f32_16x16x128_f8f6f4 %0, %1, %2, %0, %3, %3 op_sel_hi:[0,0,0]" : "+v"(c) : "v"(X), "v"(Y), "v"(sc));
}
__device__ __forceinline__ f32x4 mma_i8(bf16x8 b, bf16x8 a, f32x4 c) {
    return __builtin_bit_cast(f32x4, __builtin_amdgcn_mfma_i32_16x16x64_i8(__builtin_bit_cast(v4i_t, b), __builtin_bit_cast(v4i_t, a), __builtin_bit_cast(v4i_t, c), 0, 0, 0));
}
template <class Epi, class Sched, bool ALIGN_EPI = false, bool SP2 = false, bool FP8 = false, bool I8 = false>
__device__ __forceinline__ void gemm_phase(PG8_LAS unsigned char* lds, const Gemm g, const Sched& S, const Epi& E) {
    int tid_ = threadIdx.x; asm volatile("" : "+v"(tid_));
    const int tid = tid_, wid = __builtin_amdgcn_readfirstlane(tid >> 6), lane = tid & 63, wr = wid >> 2, wc = wid & 3, fr = lane & 15, fq = lane >> 4;
    const int K = g.K, nt = K / BK;
    unsigned voffA[2], voffB[2];
#pragma unroll
    for (int i = 0; i < 2; ++i) { int R, C; stage_rc(tid * 16 + i * 8192, R, C); const int Rb = Epi::PERM ? ((R & ~31) + perm32(R & 31)) : R;
        voffA[i] = (unsigned)(R * K + C) * 2u; voffB[i] = (unsigned)(Rb * K + C) * 2u; }
    const size_t kstep = (size_t)(BK * 2);
    const size_t hstep = (size_t)HALF * K * 2;
    const size_t tstep = 2 * hstep;
    const unsigned ldsw = (unsigned)wid * 1024u;
    const int aoff = lds_byte(wr * 64 + fr, fq * 8), boff = lds_byte(wc * 32 + fr, fq * 8);
#define PG8_SA(b, h) (((b) * 2 + (h)) * HTB)
#define PG8_SB(b, h) ((4 + (b) * 2 + (h)) * HTB)
#define PG8_STAGE(bufoff, gbase, voff) do { _Pragma("unroll") for (int _i = 0; _i < 2; ++_i) \
        __builtin_amdgcn_global_load_lds((const unsigned*)((const char*)(gbase) + (voff)[_i]), (PG8_LAS unsigned*)(lds + (bufoff) + ldsw + _i * 8192), 16, 0, 0); } while (0)
#define PG8_LDA(dst, b, h) do { _Pragma("unroll") for (int m = 0; m < 4; ++m) _Pragma("unroll") for (int k = 0; k < 2; ++k) dst[m][k] = *(const PG8_LAS bf16x8*)(lds + PG8_SA(b, h) + aoff + m * 2048 + k * 1024); } while (0)
#define PG8_LDB(dst, b, h) do { _Pragma("unroll") for (int n = 0; n < 2; ++n) _Pragma("unroll") for (int k = 0; k < 2; ++k) dst[n][k] = *(const PG8_LAS bf16x8*)(lds + PG8_SB(b, h) + boff + n * 2048 + k * 1024); } while (0)
#define PG8_MMA(ai, bj, At, Bt) do { __builtin_amdgcn_s_setprio(1); _Pragma("unroll") for (int m = 0; m < 4; ++m) _Pragma("unroll") for (int n = 0; n < 2; ++n) { \
        if constexpr (FP8) mma8(acc[ai][bj][m][n], Bt[n][0], Bt[n][1], At[m][0], At[m][1], sc8); \
        else if constexpr (I8) { _Pragma("unroll") for (int k = 0; k < 2; ++k) acc[ai][bj][m][n] = mma_i8(Bt[n][k], At[m][k], acc[ai][bj][m][n]); } \
        else { _Pragma("unroll") for (int k = 0; k < 2; ++k) acc[ai][bj][m][n] = __builtin_amdgcn_mfma_f32_16x16x32_bf16(Bt[n][k], At[m][k], acc[ai][bj][m][n], 0, 0, 0); } } __builtin_amdgcn_s_setprio(0); } while (0)
#define PG8_WAIT_V(n) asm volatile("s_waitcnt vmcnt(" #n ")" ::: "memory")
#define PG8_WAIT_L(n) asm volatile("s_waitcnt lgkmcnt(" #n ")" ::: "memory")
#define PG8_BAR __builtin_amdgcn_s_barrier()
#define PG8_SCHED __builtin_amdgcn_sched_barrier(0)
    int sc8 = 0x7F7F7F7F; asm volatile("" : "+v"(sc8));
    Unit cur, nxt; int ui = 0;
    if (!S.next(0, cur)) return;
    f32x4 acc[2][2][4][2];
#pragma unroll
    for (int a = 0; a < 2; ++a)
#pragma unroll
        for (int b = 0; b < 2; ++b)
#pragma unroll
            for (int m = 0; m < 4; ++m)
#pragma unroll
                for (int n = 0; n < 2; ++n) acc[a][b][m][n] = (f32x4){0.f, 0.f, 0.f, 0.f};
    bf16x8 At[4][2], B0[2][2], B1[2][2];
    const char* cA = (const char*)g.A + (size_t)cur.pm * tstep; const char* cB = (const char*)g.Bt + (size_t)cur.be * g.bstride + (size_t)cur.pn * tstep;
    S.a_ready(cur);
    if constexpr (SP2) {
        PG8_STAGE(PG8_SB(0, 0), cB, voffB); PG8_STAGE(PG8_SB(0, 1), cB + hstep, voffB); PG8_STAGE(PG8_SA(0, 0), cA, voffA); PG8_STAGE(PG8_SA(0, 1), cA + hstep, voffA);
        if (wr == 1) PG8_BAR;
        PG8_WAIT_V(2); PG8_BAR;
        PG8_STAGE(PG8_SB(1, 0), cB + kstep, voffB); PG8_STAGE(PG8_SA(1, 0), cA + kstep, voffA); PG8_STAGE(PG8_SB(1, 1), cB + hstep + kstep, voffB);
        PG8_WAIT_V(6); PG8_BAR;
    } else {
        PG8_STAGE(PG8_SB(0, 0), cB, voffB); PG8_STAGE(PG8_SA(0, 0), cA, voffA); PG8_STAGE(PG8_SB(0, 1), cB + hstep, voffB); PG8_STAGE(PG8_SA(0, 1), cA + hstep, voffA);
        if (wr == 1) PG8_BAR;
        PG8_WAIT_V(4); PG8_BAR;
        PG8_STAGE(PG8_SB(1, 0), cB + kstep, voffB); PG8_STAGE(PG8_SA(1, 0), cA + kstep, voffA); PG8_STAGE(PG8_SB(1, 1), cB + hstep + kstep, voffB);
        PG8_WAIT_V(6); PG8_BAR;
    }
    for (;;) {
        const bool has_next = S.next(ui + 1, nxt);
        const char* nA = has_next ? (const char*)g.A + (size_t)nxt.pm * tstep : cA; const char* nB = has_next ? (const char*)g.Bt + (size_t)nxt.be * g.bstride + (size_t)nxt.pn * tstep : cB;
        for (int t = 0; t < nt; t += 2) {
            const bool last = (t == nt - 2);
            const char* a1 = cA + (size_t)(t + 1) * kstep;
            const char* a2 = last ? nA : cA + (size_t)(t + 2) * kstep; const char* b2 = last ? nB : cB + (size_t)(t + 2) * kstep;
            const char* a3 = a2 + kstep; const char* b3 = b2 + kstep;
            if (last && has_next) S.a_ready(nxt);
            if constexpr (SP2) {
            PG8_LDB(B0, 0, 0); PG8_LDB(B1, 0, 1); PG8_SCHED; PG8_LDA(At, 0, 0); PG8_STAGE(PG8_SA(1, 1), a1 + hstep, voffA);
            PG8_WAIT_V(8); PG8_WAIT_L(0); PG8_BAR; PG8_MMA(0, 0, At, B0); PG8_MMA(0, 1, At, B1); PG8_BAR; PG8_SCHED;
            PG8_LDA(At, 0, 1); PG8_STAGE(PG8_SB(0, 0), b2, voffB); PG8_STAGE(PG8_SB(0, 1), b2 + hstep, voffB); PG8_STAGE(PG8_SA(0, 0), a2, voffA);
            PG8_WAIT_V(8); PG8_WAIT_L(0); PG8_BAR; PG8_MMA(1, 0, At, B0); PG8_MMA(1, 1, At, B1); PG8_BAR; PG8_SCHED;
            PG8_LDB(B0, 1, 0); PG8_LDB(B1, 1, 1); PG8_SCHED; PG8_LDA(At, 1, 0); PG8_STAGE(PG8_SA(0, 1), a2 + hstep, voffA);
            PG8_WAIT_V(8); PG8_WAIT_L(0); PG8_BAR; PG8_MMA(0, 0, At, B0); PG8_MMA(0, 1, At, B1); PG8_BAR; PG8_SCHED;
            PG8_LDA(At, 1, 1); PG8_STAGE(PG8_SB(1, 0), b3, voffB); PG8_STAGE(PG8_SB(1, 1), b3 + hstep, voffB); PG8_STAGE(PG8_SA(1, 0), a3, voffA);
            PG8_WAIT_V(8); PG8_WAIT_L(0); PG8_BAR; PG8_MMA(1, 0, At, B0); PG8_MMA(1, 1, At, B1); PG8_BAR; PG8_SCHED;
            } else {
            PG8_LDB(B0, 0, 0); PG8_SCHED; PG8_LDA(At, 0, 0); PG8_STAGE(PG8_SA(1, 1), a1 + hstep, voffA);
            PG8_WAIT_L(8); PG8_BAR; PG8_WAIT_L(0); PG8_MMA(0, 0, At, B0); PG8_BAR; PG8_SCHED;
            PG8_LDB(B1, 0, 1); PG8_STAGE(PG8_SB(0, 0), b2, voffB);
            PG8_BAR; PG8_WAIT_L(0); PG8_MMA(0, 1, At, B1); PG8_BAR;
            PG8_LDA(At, 0, 1); PG8_STAGE(PG8_SA(0, 0), a2, voffA);
            PG8_BAR; PG8_WAIT_L(0); PG8_MMA(1, 0, At, B0); PG8_BAR; PG8_SCHED;
            PG8_STAGE(PG8_SB(0, 1), b2 + hstep, voffB);
            PG8_WAIT_V(6); PG8_BAR; PG8_MMA(1, 1, At, B1); PG8_BAR;
            PG8_LDB(B0, 1, 0); PG8_SCHED; PG8_LDA(At, 1, 0); PG8_STAGE(PG8_SA(0, 1), a2 + hstep, voffA);
            PG8_WAIT_L(8); PG8_BAR; PG8_WAIT_L(0); PG8_MMA(0, 0, At, B0); PG8_BAR; PG8_SCHED;
            PG8_LDB(B1, 1, 1); PG8_STAGE(PG8_SB(1, 0), b3, voffB);
            PG8_BAR; PG8_WAIT_L(0); PG8_MMA(0, 1, At, B1); PG8_BAR;
            PG8_LDA(At, 1, 1); PG8_STAGE(PG8_SA(1, 0), a3, voffA);
            PG8_BAR; PG8_WAIT_L(0); PG8_MMA(1, 0, At, B0); PG8_BAR; PG8_SCHED;
            PG8_STAGE(PG8_SB(1, 1), b3 + hstep, voffB);
            PG8_WAIT_V(6); PG8_BAR; PG8_MMA(1, 1, At, B1); PG8_BAR;
            }
        }
        if constexpr (ALIGN_EPI) { if (wr == 0) PG8_BAR; }
        if constexpr (FP8) asm volatile("s_nop 15\n\ts_nop 15" ::: "memory");
        if constexpr (!Epi::AFTER_DRAIN) { E(acc, cur, wr, wc, fr, fq); S.done(cur); }
        if (!has_next) break;
#pragma unroll
        for (int a = 0; a < 2; ++a)
#pragma unroll
            for (int b = 0; b < 2; ++b)
#pragma unroll
                for (int m = 0; m < 4; ++m)
#pragma unroll
                    for (int n = 0; n < 2; ++n) acc[a][b][m][n] = (f32x4){0.f, 0.f, 0.f, 0.f};
        cur = nxt; cA = nA; cB = nB; ++ui;
        if constexpr (ALIGN_EPI) { if (wr == 1) PG8_BAR; }
    }
    PG8_WAIT_V(0);
    if constexpr (!ALIGN_EPI) { if (wr == 0) PG8_BAR; }
    PG8_BAR;
    if constexpr (Epi::AFTER_DRAIN) { E.fused(acc, cur, wr, wc, fr, fq, lds, wid, lane); S.done(cur); }
#undef PG8_SA
#undef PG8_SB
#undef PG8_STAGE
#undef PG8_LDA
#undef PG8_LDB
#undef PG8_MMA
#undef PG8_WAIT_V
#undef PG8_WAIT_L
#undef PG8_BAR
#undef PG8_SCHED
}
}

#ifndef PG8_SP2
#define PG8_SP2 true
#endif
#include <hip/hip_bf16.h>
#include <cmath>
namespace attn_body {
using bf16=__hip_bfloat16;
using bf16x8=__attribute__((ext_vector_type(8)))short;
using s16x4=__attribute__((ext_vector_type(4)))short;
using f32x16=__attribute__((ext_vector_type(16)))float;
using u32x4=__attribute__((ext_vector_type(4)))unsigned;
constexpr int BATCH=2,NHEAD=16,SEQ=16384,D=64,DM=2048;
constexpr int NW=8,QBLK=32,QB=QBLK*NW,KVBLK=64,NQB=SEQ/QB;
constexpr int ATTN_PITCH=DM, ATTN_UNIT_ROWS=QB;
__device__ __forceinline__ int crow(int r,int hi){return (r&3)+8*(r>>2)+4*hi;}
#define SBAR() __builtin_amdgcn_sched_barrier(0)
__device__ __forceinline__ void cmask(f32x16&p0,f32x16&p1,int jb,int qrel,int hi){
  const float NEG=-INFINITY; int kb=64*jb+4*hi;
  #pragma unroll
  for(int r=0;r<16;++r){int kv=kb+(r&3)+8*(r>>2); if(kv>qrel)p0[r]=NEG; if(kv+32>qrel)p1[r]=NEG;}
}

constexpr int NSLOT=3, SLOTB=8192;
constexpr int LDS_K=0, LDS_V=NSLOT*SLOTB, LDS_WS=2*NSLOT*SLOTB, LDS_OST=LDS_WS+NW*64*4, LDS_BYTES=LDS_OST+NW*4096;
constexpr int ATTN_PARAM_OFF=131072+2048;
constexpr float C2=0.125f*1.4426950408889634f;
__device__ __forceinline__ void glds16(const void*gsrc,unsigned lds_dst){unsigned keep;
  asm volatile("s_mov_b32 %0, m0\n\ts_mov_b32 m0, %2\n\ts_nop 0\n\tglobal_load_lds_dwordx4 %1, off\n\ts_mov_b32 m0, %0":"=&s"(keep):"v"(gsrc),"s"(lds_dst):"memory");}
__device__ __forceinline__ float max3f(float a,float b,float c){float r;asm("v_max3_f32 %0, %1, %2, %3":"=v"(r):"v"(a),"v"(b),"v"(c));return r;}
__device__ __forceinline__ float max2f(float a,float b){float r;asm("v_max_f32_e32 %0, %1, %2":"=v"(r):"v"(a),"v"(b));return r;}
__device__ __forceinline__ float fadd_s(float a,float b){float r;asm("v_add_f32_e32 %0, %1, %2":"=v"(r):"v"(a),"v"(b));return r;}
__device__ __forceinline__ float fsub_s(float a,float b){float r;asm("v_sub_f32_e32 %0, %1, %2":"=v"(r):"v"(a),"v"(b));return r;}
typedef float f32x2_t __attribute__((ext_vector_type(2))); typedef __bf16 bf16x2_t __attribute__((ext_vector_type(2)));
__device__ __forceinline__ unsigned cvtpk_s(float lo,float hi){f32x2_t v={lo,hi};bf16x2_t b=__builtin_convertvector(v,bf16x2_t);return __builtin_bit_cast(unsigned,b);}
__device__ __forceinline__ void glds16s(const void*sbase,unsigned voff,unsigned lds_dst){unsigned keep;
  asm volatile("s_mov_b32 %0, m0\n\ts_mov_b32 m0, %2\n\ts_nop 0\n\tglobal_load_lds_dwordx4 %1, %3\n\ts_mov_b32 m0, %0":"=&s"(keep):"v"(voff),"s"(lds_dst),"s"(sbase):"memory");}
#define WAIT_BAR(N) asm volatile("s_waitcnt vmcnt(" #N ") lgkmcnt(0)\n\ts_barrier":::"memory")

__device__ __forceinline__ void qkt(f32x16&p0,f32x16&p1,const char*Kslot,const bf16x8*qr,const f32x16&negm,int r32,int hi){
  const char*kb=Kslot+hi*1024+r32*16;
  #pragma unroll
  for(int d0=0;d0<4;++d0){
    const bf16x8 b0=*reinterpret_cast<const bf16x8*>(kb+d0*2048);
    const bf16x8 b1=*reinterpret_cast<const bf16x8*>(kb+d0*2048+512);
    if(d0==0){p0=__builtin_amdgcn_mfma_f32_32x32x16_bf16(b0,qr[0],negm,0,0,0);p1=__builtin_amdgcn_mfma_f32_32x32x16_bf16(b1,qr[0],negm,0,0,0);}
    else{p0=__builtin_amdgcn_mfma_f32_32x32x16_bf16(b0,qr[d0],p0,0,0,0);p1=__builtin_amdgcn_mfma_f32_32x32x16_bf16(b1,qr[d0],p1,0,0,0);}}
}
typedef __attribute__((address_space(3))) const char* lds_cptr;
typedef short v4i16_t __attribute__((ext_vector_type(4)));
__device__ __forceinline__ void kload8(bf16x8*kf,lds_cptr kp){
  kf[0]=*(const __attribute__((address_space(3))) bf16x8*)(kp);      kf[1]=*(const __attribute__((address_space(3))) bf16x8*)(kp+512);
  kf[2]=*(const __attribute__((address_space(3))) bf16x8*)(kp+2048); kf[3]=*(const __attribute__((address_space(3))) bf16x8*)(kp+2560);
  kf[4]=*(const __attribute__((address_space(3))) bf16x8*)(kp+4096); kf[5]=*(const __attribute__((address_space(3))) bf16x8*)(kp+4608);
  kf[6]=*(const __attribute__((address_space(3))) bf16x8*)(kp+6144); kf[7]=*(const __attribute__((address_space(3))) bf16x8*)(kp+6656);
}
__device__ __forceinline__ void kload2(bf16x8*kf,lds_cptr kp,int j){ kf[2*j]=*(const __attribute__((address_space(3))) bf16x8*)(kp+j*2048); kf[2*j+1]=*(const __attribute__((address_space(3))) bf16x8*)(kp+j*2048+512); }
__device__ __forceinline__ s16x4 vtr(lds_cptr p){ return __builtin_bit_cast(s16x4,__builtin_amdgcn_ds_read_tr16_b64_v4i16((__attribute__((address_space(3))) v4i16_t*)p)); }
__device__ __forceinline__ float rowmax(const f32x16&p0,const f32x16&p1){
  float a=max3f(p0[0],p0[1],p1[0]),b=max3f(p0[2],p0[3],p1[1]);a=max3f(a,p1[2],p1[3]);
  #pragma unroll
  for(int r=4;r<16;r+=4){a=max3f(a,p0[r],p0[r+1]);b=max3f(b,p0[r+2],p0[r+3]);a=max3f(a,p1[r],p1[r+1]);b=max3f(b,p1[r+2],p1[r+3]);}
  const float m=max2f(a,b);
  auto rr=__builtin_amdgcn_permlane32_swap(__float_as_uint(m),__float_as_uint(m),false,false);
  return max2f(__uint_as_float(rr[0]),__uint_as_float(rr[1]));
}
typedef int v8i_a __attribute__((ext_vector_type(8))); typedef int v4i_a __attribute__((ext_vector_type(4)));
#define MFMA8(ACC,A,B) asm volatile("s_nop 1\n\tv_mfma_scale_f32_32x32x64_f8f6f4 %0, %1, %2, %0, %3, %3 op_sel_hi:[0,0,0]":"+v"(ACC):"v"(A),"v"(B),"v"(sc8_))
#ifndef ATTN_STORE16
#define ATTN_STORE16(p,v) (*(u32x4*)(p)=(v))
#endif
template<int THRL,bool TRAIL> __device__ __forceinline__ void attn_unit(int b,int h,int qb,const unsigned char*Q,const unsigned char*__restrict__ K,const unsigned char*__restrict__ VT,bf16*O,char*shm){
  int tid_=threadIdx.x; asm volatile("":"+v"(tid_)); const int tid=tid_,lane=tid&63,r32=lane&31,hi=lane>>5; const int wid=__builtin_amdgcn_readfirstlane(tid>>6);
  const long rowbase=(long)b*SEQ; const int q0=qb*QB;
  const unsigned char*Qw=Q+(rowbase+q0+wid*QBLK)*DM+h*D;
  const unsigned char*Kh=K+rowbase*DM+h*D;
  const unsigned lds0=(unsigned)(uintptr_t)shm;
  float*wsf=(float*)(shm+LDS_WS)+wid*64;
  const int krow_=8*wid+((lane&31)>>2); const unsigned koff=(unsigned)(krow_*DM+(((lane&3)^((krow_>>2)&3))*16));
  const int vrow_=16*wid+(lane>>2); const unsigned voff=(unsigned)(vrow_*SEQ+(((lane&3)^((vrow_>>2)&3))*16));
  const unsigned kdst=lds0+LDS_K+wid*512, vdst=lds0+LDS_V+wid*1024;
  #define DMA_K(t,slot) do{ if(lane<32) glds16s(Kh+(long)(t)*KVBLK*DM,koff,(unsigned)__builtin_amdgcn_readfirstlane(kdst+(slot))); }while(0)
  #define DMA_V(t,slot) glds16s(VT+(long)(t)*KVBLK,voff,(unsigned)__builtin_amdgcn_readfirstlane(vdst+(slot)))
  int sc8_=0x7F7F7F7F; asm volatile("":"+v"(sc8_));
  v8i_a kf0,kf1;
  const lds_cptr shm3=(lds_cptr)shm; const lds_cptr kpa=shm3+LDS_K+r32*64+(((2*hi)^((r32>>2)&3))*16), kpb=shm3+LDS_K+r32*64+(((2*hi+1)^((r32>>2)&3))*16); const lds_cptr vpa=shm3+LDS_V+r32*64+(((2*hi)^((r32>>2)&3))*16), vpb=shm3+LDS_V+r32*64+(((2*hi+1)^((r32>>2)&3))*16);
  const int NT=(q0+QB)/KVBLK;
  DMA_K(0,0);DMA_V(0,0);DMA_K(1,SLOTB);
  v8i_a qf; { const v4i_a a_=*reinterpret_cast<const v4i_a*>(Qw+(long)r32*DM+32*hi), b_=*reinterpret_cast<const v4i_a*>(Qw+(long)r32*DM+32*hi+16); qf=__builtin_shufflevector(a_,b_,0,1,2,3,4,5,6,7); }
  #define KLD(KF,n,SL) do{ const v4i_a a_=*(const __attribute__((address_space(3))) v4i_a*)(kpa+(SL)+(n)*2048), b_=*(const __attribute__((address_space(3))) v4i_a*)(kpb+(SL)+(n)*2048); KF=__builtin_shufflevector(a_,b_,0,1,2,3,4,5,6,7); }while(0)
  #define QK8(DD,KF) asm volatile("s_nop 1\n\tv_mfma_scale_f32_32x32x64_f8f6f4 %0, %1, %2, %3, %4, %4 op_sel_hi:[0,0,0]":"=&v"(DD):"v"(KF),"v"(qf),"v"(negm),"v"(sc8_))
  float mhat=0.f; float z_=0.f; asm volatile("":"+v"(z_)); const f32x16 zv_={z_,z_,z_,z_,z_,z_,z_,z_,z_,z_,z_,z_,z_,z_,z_,z_};     f32x16 o[4];o[0]=zv_;o[1]=zv_;o[2]=zv_;o[3]=zv_;f32x16 negm=zv_;asm volatile("":"+v"(negm)); f32x16 osum=zv_;
  int one8_=0x38383838; asm volatile("":"+v"(one8_)); const v8i_a onesv={one8_,one8_,one8_,one8_,one8_,one8_,one8_,one8_};
  const int qrel=wid*QBLK+r32;
  #define CMASK(P0,P1,t) do{int jb_=(t)-(NT-4); if(jb_>=0)cmask(P0,P1,jb_,qrel,hi);}while(0)
  bool resc=false;
  #define START(P0,P1) do{ const float rm=rowmax(P0,P1); resc=false; \
    { const float dl=rm; mhat=fadd_s(mhat,dl); \
      _Pragma("unroll") for(int r=0;r<16;++r){P0[r]=fsub_s(P0[r],dl);P1[r]=fsub_s(P1[r],dl);} \
      _Pragma("unroll") for(int r=0;r<16;++r)negm[r]=-mhat; asm volatile("":"+v"(negm)); } \
    _Pragma("unroll") for(int r=0;r<16;++r)P0[r]=__builtin_amdgcn_exp2f(P0[r]); }while(0)
  #define RESC() do{ if(resc){ asm volatile("s_waitcnt lgkmcnt(0)\n\ts_nop 15\n\ts_nop 15":::"memory"); \
      _Pragma("unroll") for(int r=0;r<16;++r){const float f_=wsf[crow(r,hi)]; o[0][r]*=f_;o[1][r]*=f_;o[2][r]*=f_;o[3][r]*=f_;osum[r]*=f_;} } }while(0)
  f32x16 pA0,pA1,pB0,pB1;
  int sl_prev=0,sl_cur=0,sl_next=SLOTB;
  #define ROT() do{sl_prev=sl_cur;sl_cur=sl_next;sl_next=(sl_next==(NSLOT-1)*SLOTB)?0:sl_next+SLOTB;}while(0)
  DMA_K(2,2*SLOTB);
  WAIT_BAR(4);
  KLD(kf0,0,0); KLD(kf1,1,0); QK8(pA0,kf0); QK8(pA1,kf1); asm volatile("s_nop 15\n\ts_nop 15":"+v"(pA0),"+v"(pA1));CMASK(pA0,pA1,0);
  START(pA0,pA1);
  _Pragma("unroll") for(int r=0;r<8;++r)pA1[r]=__builtin_amdgcn_exp2f(pA1[r]);
  WAIT_BAR(0);
  DMA_K(3,0);DMA_V(1,SLOTB);
  ROT();
  KLD(kf0,0,sl_cur); KLD(kf1,1,sl_cur);
  WAIT_BAR(2);
  v8i_a pfv=onesv, vf0, vf1, vf2, vf3;
  #define KEEP(x) asm volatile(""::"v"(x))
  #define PKF(i,P,B) do{ int w_=__builtin_amdgcn_cvt_pk_fp8_f32(P[B],P[B+1],pfv[i],false); pfv[i]=__builtin_amdgcn_cvt_pk_fp8_f32(P[B+2],P[B+3],w_,true); }while(0)
  #define PIN(x) asm volatile("":"+v"(x))
  #define MX3(a,b,c) __builtin_fmaxf(__builtin_fmaxf((a),(b)),(c))
  #define GAPA(MF,A0,A1,A2,A3,PK) do{ MF; PK; SBAR(); }while(0)
  #define EX(v) __builtin_amdgcn_exp2f(v)
  #define EX8(X,B) do{ X[B]=EX(X[B]); X[B+1]=EX(X[B+1]); X[B+2]=EX(X[B+2]); X[B+3]=EX(X[B+3]); X[B+4]=EX(X[B+4]); X[B+5]=EX(X[B+5]); X[B+6]=EX(X[B+6]); X[B+7]=EX(X[B+7]); PIN(X); }while(0)
  #define VLD(VF,db) do{ const v4i_a a_=*(const __attribute__((address_space(3))) v4i_a*)(vp_a_+(db)*2048), b_=*(const __attribute__((address_space(3))) v4i_a*)(vp_b_+(db)*2048); VF=__builtin_shufflevector(a_,b_,0,1,2,3,4,5,6,7); }while(0)
  #define KRDP(G,KF,n) do{ if(G){ KLD(KF,n,sl_next); } }while(0)
  #define SEC_A(C0,C1,P0,P1,VL) do{ \
    PKF(0,P0,0); PKF(1,P0,4); PKF(2,P0,8); PKF(3,P0,12); PKF(4,P1,0); PKF(5,P1,4); \
    QK8(C0,kf0); SBAR(); \
    if(VL){ VLD(vf0,0); KEEP(kf0); SBAR(); } \
    QK8(C1,kf1); EX8(P1,8); PKF(6,P1,8); PKF(7,P1,12); SBAR(); \
    PIN(pfv); asm volatile("s_nop 7":"+v"(C0),"+v"(C1)); }while(0)
  #define SEC_DMA(t,GK,GV) do{ if(GK){DMA_K((t)+3,sl_cur);} if(GV){DMA_V((t)+1,sl_next);} }while(0)
  #define SEC_MAX(C0,C1) do{ float a=MX3(C0[0],C0[1],C1[0]),b=MX3(C0[2],C0[3],C1[1]); a=MX3(a,C1[2],C1[3]); \
      _Pragma("unroll") for(int r=4;r<16;r+=4){a=MX3(a,C0[r],C0[r+1]);b=MX3(b,C0[r+2],C0[r+3]);a=MX3(a,C1[r],C1[r+1]);b=MX3(b,C1[r+2],C1[r+3]);} \
      float rm=__builtin_fmaxf(a,b); { auto rr=__builtin_amdgcn_permlane32_swap(__float_as_uint(rm),__float_as_uint(rm),false,false); rm=__builtin_fmaxf(__uint_as_float(rr[0]),__uint_as_float(rr[1])); } \
      resc=false; \
      if(__builtin_expect(__any(rm>(float)THRL),0)){ const float dl=__builtin_fmaxf(rm,0.f); mhat+=dl; \
        _Pragma("unroll") for(int r=0;r<16;++r){C0[r]-=dl;C1[r]-=dl;} \
        _Pragma("unroll") for(int r=0;r<16;++r)negm[r]=-mhat; asm volatile("":"+v"(negm)); \
        const float f=__builtin_amdgcn_exp2f(-dl); if(hi==0)wsf[r32]=f; resc=true; } }while(0)
  #define SEC_B(C0,C1,GL) do{ \
    VLD(vf1,1); SBAR(); MFMA8(o[0],pfv,vf0); KRDP(GL,kf0,0); KEEP(vf0); EX8(C0,0); SBAR(); \
    VLD(vf2,2); KEEP(vf0); SBAR(); MFMA8(o[1],pfv,vf1); KRDP(GL,kf1,1); KEEP(vf1); EX8(C0,8); SBAR(); \
    VLD(vf3,3); KEEP(vf1); SBAR(); MFMA8(o[2],pfv,vf2); EX8(C1,0); SBAR(); \
    MFMA8(o[3],pfv,vf3); SBAR(); \
    MFMA8(osum,pfv,onesv); SBAR(); }while(0)
  #define STEP(C0,C1,P0,P1,t,GK,GV,GL) do{ SBAR(); \
    const lds_cptr vp_a_=vpa+sl_prev, vp_b_=vpb+sl_prev; \
    SEC_A(C0,C1,P0,P1,true); \
    SEC_DMA(t,GK,GV); \
    CMASK(C0,C1,t); \
    SEC_MAX(C0,C1); \
    SBAR(); \
    SEC_B(C0,C1,GL); \
    }while(0)
  #define STEP_T(C0,C1,N0,N1,t,GK,GV,GL,GA) do{ SBAR(); \
    const lds_cptr vp_a_=vpa+sl_prev, vp_b_=vpb+sl_prev; \
    SEC_DMA(t,GK,GV); \
    VLD(vf0,0); SBAR(); \
    SEC_MAX(C0,C1); \
    SBAR(); \
    SEC_B(C0,C1,GL); \
    if(GA){ SEC_A(N0,N1,C0,C1,false); CMASK(N0,N1,(t)+1); } \
    }while(0)
  int t=1;
  constexpr bool trail_=TRAIL;
  if constexpr(trail_){ const lds_cptr vp_a_=vpa, vp_b_=vpb; SEC_A(pB0,pB1,pA0,pA1,false); CMASK(pB0,pB1,1); }
  #undef CMASK
  #define CMASK(P0,P1,t) do{}while(0)
  if constexpr(!trail_){
    for(;t+5<NT;t+=2){
      STEP(pB0,pB1,pA0,pA1,t,true,true,true);     WAIT_BAR(2); RESC(); ROT();
      STEP(pA0,pA1,pB0,pB1,t+1,true,true,true);   WAIT_BAR(2); RESC(); ROT();
    }
  } else {
    for(;t+5<NT;t+=2){
      STEP_T(pB0,pB1,pA0,pA1,t,true,true,true,true);     WAIT_BAR(2); RESC(); ROT();
      STEP_T(pA0,pA1,pB0,pB1,t+1,true,true,true,true);   WAIT_BAR(2); RESC(); ROT();
    }
  }
  #undef CMASK
  #define CMASK(P0,P1,t) do{int jb_=(t)-(NT-4); if(jb_>=0)cmask(P0,P1,jb_,qrel,hi);}while(0)
  #define ENDW(tt) do{ if((tt)+3<NT){WAIT_BAR(2);} else if((tt)+2<NT){WAIT_BAR(1);} else {WAIT_BAR(0);} }while(0)
  if constexpr(!trail_){
    for(;t+1<NT;t+=2){
      STEP(pB0,pB1,pA0,pA1,t,(t+3<NT),(t+1<NT),(t+1<NT));       ENDW(t);   RESC(); ROT();
      STEP(pA0,pA1,pB0,pB1,t+1,(t+4<NT),(t+2<NT),(t+2<NT));     ENDW(t+1); RESC(); ROT();
    }
    STEP(pB0,pB1,pA0,pA1,NT-1,false,false,false); RESC();
  } else {
    for(;t+1<NT;t+=2){
      STEP_T(pB0,pB1,pA0,pA1,t,(t+3<NT),(t+1<NT),(t+1<NT),true);       ENDW(t);   RESC(); ROT();
      STEP_T(pA0,pA1,pB0,pB1,t+1,(t+4<NT),(t+2<NT),(t+2<NT),true);     ENDW(t+1); RESC(); ROT();
    }
    STEP_T(pB0,pB1,pA0,pA1,NT-1,false,false,false,false); RESC();
  }
  {
    EX8(pB1,8); PKF(0,pB0,0);PKF(1,pB0,4);PKF(2,pB0,8);PKF(3,pB0,12);PKF(4,pB1,0);PKF(5,pB1,4);PKF(6,pB1,8);PKF(7,pB1,12); PIN(pfv);
    const lds_cptr vp_a_=vpa+sl_cur, vp_b_=vpb+sl_cur;
    VLD(vf0,0); VLD(vf1,1); VLD(vf2,2); VLD(vf3,3); SBAR(); MFMA8(o[0],pfv,vf0); MFMA8(o[1],pfv,vf1); MFMA8(o[2],pfv,vf2); MFMA8(o[3],pfv,vf3); MFMA8(osum,pfv,onesv); SBAR();
    asm volatile("s_nop 15\n\ts_nop 15\n\ts_nop 15\n\ts_nop 15\n\ts_nop 7":"+v"(o[0]),"+v"(o[1]),"+v"(o[2]),"+v"(o[3]),"+v"(osum)); }
  #undef PKF
  #undef EX8
  #undef VLD
  #undef PAF
  #undef VFR
  #undef PIN
  #undef MX3
  #undef GAPA
  #undef GAPB
  #undef EX
  #undef KRDP
  #undef KLD
  #undef QK8
  #undef KRD
  #undef STEP
  #undef STEP_T
  #undef SEC_A
  #undef KEEP
  #undef SEC_B
  #undef SEC_MAX
  #undef SEC_DMA
  #undef ENDW
  float rli[16];
  #pragma unroll
  for(int r=0;r<16;++r)rli[r]=__builtin_amdgcn_rcpf(osum[r]);
  bf16*Ow=O+(rowbase+q0+wid*QBLK)*DM+h*D;
  { bf16*stg=(bf16*)(shm+LDS_OST)+wid*2048;
    #pragma unroll
    for(int hh=0;hh<2;++hh){
    #pragma unroll
    for(int r=0;r<16;++r){const int orow=crow(r,hi);
      #pragma unroll
      for(int d0=0;d0<2;++d0)stg[orow*64+d0*32+r32]=__float2bfloat16(o[2*hh+d0][r]*rli[r]);}
    asm volatile("s_waitcnt lgkmcnt(0)":::"memory");
    #pragma unroll
    for(int i=0;i<4;++i){const int row=i*8+(lane>>3),ch=lane&7; const u32x4 v=*(const u32x4*)(stg+row*64+ch*8); ATTN_STORE16(Ow+(long)row*DM+hh*64+ch*8,v);}
    asm volatile("s_waitcnt lgkmcnt(0)":::"memory"); } }
  asm volatile("s_waitcnt lgkmcnt(0)\n\ts_barrier":::"memory");
  #undef DMA_K
  #undef DMA_V
  #undef CMASK
  #undef START
  #undef RESC
  #undef ROT
}
constexpr int ATTN_LDS_BYTES=LDS_BYTES;
struct AttnUnit { int b, h, c, qb; };
struct DiffOrder {
  int vcu;
  __device__ __forceinline__ explicit DiffOrder(int v):vcu(v){}
  __device__ __forceinline__ bool next(int i,AttnUnit&u)const{ if(i>=16)return false; const int r=i>>2,k=i&3,x=vcu>>5,loc=vcu&31,j=loc&15; const int bh=r*8+x;
    u.b=bh>>4; u.h=bh&15; u.c=loc>>4; const int pair=j+16*(k>>1); u.qb=(k&1)?63-pair:pair; return true; }
};
#undef SBAR
#undef WAIT_BAR
}
#define GAS __attribute__((address_space(1)))
#define LAS __attribute__((address_space(3)))
typedef unsigned short bf16;
typedef unsigned v4u __attribute__((ext_vector_type(4)));
typedef float f32x4 __attribute__((ext_vector_type(4)));
typedef short bf16x8 __attribute__((ext_vector_type(8)));
typedef GAS unsigned gu32;
typedef GAS unsigned long long gu64;
#define RLX_AGENT __ATOMIC_RELAXED, __HIP_MEMORY_SCOPE_AGENT
#define LDS_WAIT() asm volatile("s_waitcnt lgkmcnt(0)" ::: "memory")
#define VM_WAIT() asm volatile("s_waitcnt vmcnt(0)" ::: "memory")
__device__ __forceinline__ unsigned long long rt() { return __builtin_amdgcn_s_memrealtime(); }
__device__ __forceinline__ unsigned f2bf(float f) { unsigned u = __builtin_bit_cast(unsigned, f); return (u + 0x7fffu + ((u >> 16) & 1u)) >> 16; }
__device__ __forceinline__ unsigned pk2(float lo, float hi) { return f2bf(lo) | (f2bf(hi) << 16); }

#define XB_TMO      128
#define XB_XCNT(j)  (256  + 64 * (j))
#define XB_XSUB(j)  (1280 + 64 * (j))
#define XB_XGEN(j)  (2304 + 64 * (j))
#define XB_TOP      3328
#define XB_TOPGEN   3392
#define XCD_BAR_WORDS 3456
#define XB_SPIN_CAP (1u << 18)

__device__ __forceinline__ unsigned xb_ld(unsigned* p)              { return __hip_atomic_load(p, __ATOMIC_RELAXED, __HIP_MEMORY_SCOPE_AGENT); }
__device__ __forceinline__ unsigned xb_add(unsigned* p, unsigned v) { return __hip_atomic_fetch_add(p, v, __ATOMIC_RELAXED, __HIP_MEMORY_SCOPE_AGENT); }
__device__ __forceinline__ unsigned xb_xcc_id() { return (unsigned)__builtin_amdgcn_s_getreg((3 << 11) | 20) & 0xFu; }
#define XB_SPIN(cond, bar) do { unsigned _sp = 0; while (cond) { __builtin_amdgcn_s_sleep(1); \
    if ((++_sp & 255u) == 0u) { if (xb_ld(&(bar)[XB_TMO])) break; if (_sp > XB_SPIN_CAP) { atomicAdd(&(bar)[XB_TMO], 1u); break; } } } } while (0)

struct XcdBarrier {
    unsigned* bar; unsigned x;
    volatile LAS unsigned* st;
};

__device__ __forceinline__ XcdBarrier xcd_barrier_post(unsigned* bar, volatile LAS unsigned* st) {
    XcdBarrier b; b.bar = bar; b.x = xb_xcc_id(); b.st = st;
    if (threadIdx.x == 0) (void)xb_add(&bar[XB_XCNT(b.x)], 1u);
    return b;
}
__device__ __forceinline__ void xcd_barrier_complete(unsigned* bar, unsigned x, unsigned& nloc, unsigned& nx) {
    const unsigned G = gridDim.x * gridDim.y * gridDim.z;
    unsigned sum, cnt, mine, sp = 0u;
    for (;;) {
        sum = 0u; cnt = 0u; mine = 0u;
#pragma unroll
        for (unsigned j = 0; j < 16; ++j) { const unsigned c = xb_ld(&bar[XB_XCNT(j)]); sum += c; cnt += (c > 0u) ? 1u : 0u; mine = (j == x) ? c : mine; }
        if (sum == G) break;
        __builtin_amdgcn_s_sleep(1);
        if ((++sp & 255u) == 0u) { if (xb_ld(&bar[XB_TMO])) break; if (sp > XB_SPIN_CAP) { atomicAdd(&bar[XB_TMO], 1u); break; } }
    }
    nloc = mine > 0u ? mine : 1u; nx = cnt > 0u ? cnt : 1u;
}

__device__ __forceinline__ void xcd_barrier(const XcdBarrier& b) {
    asm volatile("s_waitcnt vmcnt(0)" ::: "memory");
    __syncthreads();
    if (threadIdx.x == 0) {
        unsigned* bar = b.bar;
        __builtin_amdgcn_s_waitcnt(0);
        unsigned nloc = b.st[0], nx = b.st[1];
        if (nloc == 0u) { xcd_barrier_complete(bar, b.x, nloc, nx); b.st[0] = nloc; b.st[1] = nx; }
        const unsigned old = xb_add(&bar[XB_XSUB(b.x)], 1u);
        const unsigned gen = old / nloc;
        if (old + 1u == (gen + 1u) * nloc) {
            __builtin_amdgcn_fence(__ATOMIC_RELEASE, "agent");
            asm volatile("s_waitcnt vmcnt(0)" ::: "memory");
            const unsigned og = xb_add(&bar[XB_TOP], 1u);
            const unsigned tg = og / nx;
            if (og + 1u == (tg + 1u) * nx) xb_add(&bar[XB_TOPGEN], 1u);
            else XB_SPIN(xb_ld(&bar[XB_TOPGEN]) == tg, bar);
            __builtin_amdgcn_fence(__ATOMIC_ACQUIRE, "agent");
            xb_add(&bar[XB_XGEN(b.x)], 1u);
            asm volatile("s_waitcnt vmcnt(0)" ::: "memory");
        } else {
            XB_SPIN(xb_ld(&bar[XB_XGEN(b.x)]) == gen, bar);
            __builtin_amdgcn_fence(__ATOMIC_ACQUIRE, "agent");
            asm volatile("s_waitcnt vmcnt(0)" ::: "memory");
        }
    }
    __syncthreads();
}
constexpr int NWAVES = 8;
constexpr int BATCH = 2, SEQ = 16384, D = 2048, M = BATCH * SEQ;
constexpr int ZW = 3072, PW = 1024, GW = 1024, FF = 5632, NE = 8, NQKV = 3 * D;
constexpr int CHUNK_TILES = 64, MAX_TILES = 264;
constexpr float EPS = 1e-5f;
constexpr float LAMBDA_INIT = 0.35550906759096927f;
constexpr size_t MiB = 1u << 20;
constexpr size_t WS_CTL = 0, CTL_ZERO_BYTES = 1 * MiB;
constexpr size_t WS_ROPE = 2 * MiB;
constexpr size_t WS_TOK = 10 * MiB;
constexpr size_t WS_WSP = 12 * MiB, WS_WPOOL = 12 * MiB + 512 * 1024;
constexpr size_t WS_WIN = 16 * MiB, WS_WOUT = 28 * MiB, WS_WGU = 36 * MiB, WS_WD = 80 * MiB, WS_WQKV = 102 * MiB, WS_WO = 126 * MiB, WS_WEGU = 134 * MiB, WS_WED = 486 * MiB;
constexpr size_t WS_XR = 320 * MiB;
constexpr size_t WS_A = 662 * MiB;
constexpr size_t WS_B = 790 * MiB;
constexpr size_t WS_Z = WS_B, WS_Y1 = WS_B + 192 * MiB, WS_ACT = WS_B;
constexpr size_t WS_Q = WS_B, WS_K = WS_B + 128 * MiB, WS_V = WS_B + 256 * MiB, WS_O0 = WS_B + 384 * MiB, WS_O1 = WS_B + 512 * MiB;
constexpr size_t WS_XP = WS_A, WS_YM = 794 * MiB, WS_ACTC = 1058 * MiB;
constexpr size_t WS_END = 1430 * MiB;
constexpr float W8_SCALE = 32.0f;
static_assert(WS_XP + (size_t)MAX_TILES * 256 * D <= WS_YM && WS_YM + (size_t)MAX_TILES * 256 * D * 2 <= WS_ACTC && WS_ACTC + (size_t)MAX_TILES * 256 * FF <= WS_END, "moe map");
static_assert(WS_ACT + (size_t)M * FF * 2 <= WS_END && WS_Y1 + (size_t)M * D * 2 <= WS_END && WS_WED + (size_t)NE * D * FF <= WS_A && WS_WEGU + (size_t)NE * 2 * FF * D <= WS_XR && WS_XR + (size_t)M * D * 2 <= WS_WED, "map");
constexpr int CW_TMO = 0, CW_CODE = 1, CW_BAR = 4096, CW_GCNT = 16384;
constexpr int RING_OFF = 0, RING_BYTES = 131072;
constexpr int LDSCTL_OFF = RING_BYTES, MISC_OFF = LDSCTL_OFF + 320;
constexpr int LDS_BYTES = 147456;
constexpr int LW_TS = 0, LW_SEG = 16, LW_TEXP = 128;
constexpr int LW_WSC = 48;
constexpr size_t WS_HSCALE = WS_TOK + 896 * 1024;

struct Frame {
    LAS unsigned char* lds;
    volatile LAS unsigned* MISC;
    gu32* ctl;
    int tid, lane, wave;
    int vcu, G;
};

__device__ __forceinline__ float wave_sum(float v) {
#pragma unroll
    for (int o = 1; o < 64; o <<= 1) v += __shfl_xor(v, o);
    return v;
}
__device__ __forceinline__ float bf2f(unsigned short b) { return __uint_as_float((unsigned)b << 16); }
__device__ __forceinline__ float bflo(unsigned w) { return __uint_as_float(w << 16); }
__device__ __forceinline__ float bfhi(unsigned w) { return __uint_as_float(w & 0xffff0000u); }

__device__ __forceinline__ int map_gate(int n) { return 256 * (n >> 7) + (n & 127); }
__device__ __forceinline__ int map_up(int n) { return 256 * (n >> 7) + 128 + (n & 127); }
__device__ __forceinline__ int map_qkv(int n) {
    if (n >= 2 * D) return n;
    const int sec = n / D, cs = n % D, tile = cs >> 8, hh = (cs & 255) >> 6, d = cs & 63;
    return sec * D + tile * 256 + (d >> 5) * 128 + hh * 32 + (d & 31);
}
template <int MODE, bool FP8> __device__ __forceinline__ void p0_matrix(const float* W, int K, int N, void* WTv, float scale, LAS float* scr, int lane, int it) {
    const int nblk = N / 64, kb = it / nblk, nb = it % nblk, k0 = 64 * kb, n0 = 64 * nb;
    f32x4 v[16];
#pragma unroll
    for (int i = 0; i < 16; ++i) v[i] = *(const GAS f32x4*)(W + (size_t)(k0 + 4 * i + (lane >> 4)) * N + n0 + 4 * (lane & 15));
#pragma unroll
    for (int i = 0; i < 16; ++i) { const int k = 4 * i + (lane >> 4); *(LAS f32x4*)(scr + k * 64 + ((4 * (lane & 15) + 4 * k) & 63)) = v[i]; }
    LDS_WAIT(); asm volatile("" ::: "memory");
    const int ns = n0 + (lane & 32); const int dr = (MODE == 0 ? ns : MODE == 1 ? map_gate(ns) : MODE == 2 ? map_up(ns) : map_qkv(ns)) + (lane & 31);
#define P0_EL(k) scr[(k) * 64 + ((lane + 4 * (k)) & 63)]
    if constexpr (FP8) { GAS v4u* dst = (GAS v4u*)((unsigned char*)WTv + (size_t)dr * K + k0);
#pragma unroll
        for (int c = 0; c < 4; ++c) { v4u o;
            o.x = pg8::pk_fp8x4(P0_EL(16 * c + 0) * scale, P0_EL(16 * c + 1) * scale, P0_EL(16 * c + 2) * scale, P0_EL(16 * c + 3) * scale);
            o.y = pg8::pk_fp8x4(P0_EL(16 * c + 4) * scale, P0_EL(16 * c + 5) * scale, P0_EL(16 * c + 6) * scale, P0_EL(16 * c + 7) * scale);
            o.z = pg8::pk_fp8x4(P0_EL(16 * c + 8) * scale, P0_EL(16 * c + 9) * scale, P0_EL(16 * c + 10) * scale, P0_EL(16 * c + 11) * scale);
            o.w = pg8::pk_fp8x4(P0_EL(16 * c + 12) * scale, P0_EL(16 * c + 13) * scale, P0_EL(16 * c + 14) * scale, P0_EL(16 * c + 15) * scale);
            dst[c] = o; }
    } else { GAS v4u* dst = (GAS v4u*)((bf16*)WTv + (size_t)dr * K + k0);
#pragma unroll
        for (int c = 0; c < 8; ++c) { v4u o; o.x = pk2(P0_EL(8 * c + 0), P0_EL(8 * c + 1)); o.y = pk2(P0_EL(8 * c + 2), P0_EL(8 * c + 3)); o.z = pk2(P0_EL(8 * c + 4), P0_EL(8 * c + 5)); o.w = pk2(P0_EL(8 * c + 6), P0_EL(8 * c + 7));
            dst[c] = o; }
    }
#undef P0_EL
    LDS_WAIT(); asm volatile("" ::: "memory");
}
template <int MODE> __device__ __forceinline__ void p0_matrix8w(const float* W, int K, int N, unsigned char* WT, float scale, LAS float* scr, int lane, int it) {
    const int nblk = N / 32, kb = it / nblk, nb = it % nblk, k0 = 128 * kb, n0 = 32 * nb;
    f32x4 v[16];
#pragma unroll
    for (int i = 0; i < 16; ++i) v[i] = *(const GAS f32x4*)(W + (size_t)(k0 + 8 * i + (lane >> 3)) * N + n0 + 4 * (lane & 7));
#pragma unroll
    for (int i = 0; i < 16; ++i) { const int k = 8 * i + (lane >> 3); *(LAS f32x4*)(scr + k * 32 + ((4 * (lane & 7) + 4 * k) & 31)) = v[i]; }
    LDS_WAIT(); asm volatile("" ::: "memory");
    const int n = lane & 31, kh = lane >> 5; const int dr = (MODE == 0 ? n0 : MODE == 1 ? map_gate(n0) : map_up(n0)) + n;
    GAS v4u* dst = (GAS v4u*)(WT + (size_t)dr * K + k0 + 64 * kh);
#define P0_EL(k) (scr[(64 * kh + (k)) * 32 + ((n + 4 * (64 * kh + (k))) & 31)] * scale)
#pragma unroll
    for (int c = 0; c < 4; ++c) { v4u o;
        o.x = pg8::pk_fp8x4(P0_EL(16 * c + 0), P0_EL(16 * c + 1), P0_EL(16 * c + 2), P0_EL(16 * c + 3)); o.y = pg8::pk_fp8x4(P0_EL(16 * c + 4), P0_EL(16 * c + 5), P0_EL(16 * c + 6), P0_EL(16 * c + 7));
        o.z = pg8::pk_fp8x4(P0_EL(16 * c + 8), P0_EL(16 * c + 9), P0_EL(16 * c + 10), P0_EL(16 * c + 11)); o.w = pg8::pk_fp8x4(P0_EL(16 * c + 12), P0_EL(16 * c + 13), P0_EL(16 * c + 14), P0_EL(16 * c + 15));
        dst[c] = o; }
#undef P0_EL
    LDS_WAIT(); asm volatile("" ::: "memory");
}
__device__ __forceinline__ unsigned pk_i8x4(float a, float b, float c, float d) {
    const int i0 = __float2int_rn(fminf(fmaxf(a, -127.f), 127.f)), i1 = __float2int_rn(fminf(fmaxf(b, -127.f), 127.f)), i2 = __float2int_rn(fminf(fmaxf(c, -127.f), 127.f)), i3 = __float2int_rn(fminf(fmaxf(d, -127.f), 127.f));
    return (unsigned)(i0 & 255) | ((unsigned)(i1 & 255) << 8) | ((unsigned)(i2 & 255) << 16) | ((unsigned)i3 << 24);
}
template <int MODE> __device__ __forceinline__ void p0_matrix_i8w(const float* W, int K, int N, unsigned char* WT, float inv, LAS float* scr, int lane, int it) {
    const int nblk = N / 32, kb = it / nblk, nb = it % nblk, k0 = 128 * kb, n0 = 32 * nb;
    f32x4 v[16];
#pragma unroll
    for (int i = 0; i < 16; ++i) v[i] = *(const GAS f32x4*)(W + (size_t)(k0 + 8 * i + (lane >> 3)) * N + n0 + 4 * (lane & 7));
#pragma unroll
    for (int i = 0; i < 16; ++i) { const int k = 8 * i + (lane >> 3); *(LAS f32x4*)(scr + k * 32 + ((4 * (lane & 7) + 4 * k) & 31)) = v[i]; }
    LDS_WAIT(); asm volatile("" ::: "memory");
    const int n = lane & 31, kh = lane >> 5; const int dr = (MODE == 0 ? n0 : MODE == 1 ? map_gate(n0) : MODE == 2 ? map_up(n0) : map_qkv(n0)) + n;
    GAS v4u* dst = (GAS v4u*)(WT + (size_t)dr * K + k0 + 64 * kh);
#define P0_EL(k) (scr[(64 * kh + (k)) * 32 + ((n + 4 * (64 * kh + (k))) & 31)] * inv)
#pragma unroll
    for (int c = 0; c < 4; ++c) { v4u o;
        o.x = pk_i8x4(P0_EL(16 * c + 0), P0_EL(16 * c + 1), P0_EL(16 * c + 2), P0_EL(16 * c + 3)); o.y = pk_i8x4(P0_EL(16 * c + 4), P0_EL(16 * c + 5), P0_EL(16 * c + 6), P0_EL(16 * c + 7));
        o.z = pk_i8x4(P0_EL(16 * c + 8), P0_EL(16 * c + 9), P0_EL(16 * c + 10), P0_EL(16 * c + 11)); o.w = pk_i8x4(P0_EL(16 * c + 12), P0_EL(16 * c + 13), P0_EL(16 * c + 14), P0_EL(16 * c + 15));
        dst[c] = o; }
#undef P0_EL
    LDS_WAIT(); asm volatile("" ::: "memory");
}
__device__ __forceinline__ float rms_row_to_bf16(const float* xrow, const float* gain, bf16* orow, int lane) {
    const GAS f32x4* xr = (const GAS f32x4*)xrow + lane; const GAS f32x4* gr = (const GAS f32x4*)gain + lane;
    f32x4 v[8]; float s = 0.f;
#pragma unroll
    for (int j = 0; j < 8; ++j) { v[j] = xr[64 * j]; s += (v[j].x * v[j].x + v[j].y * v[j].y) + (v[j].z * v[j].z + v[j].w * v[j].w); }
    const float rstd = 1.f / sqrtf(wave_sum(s) * (1.f / D) + EPS);
    GAS unsigned long long* o8 = (GAS unsigned long long*)orow + lane;
#pragma unroll
    for (int j = 0; j < 8; ++j) { const f32x4 g = gr[64 * j];
        o8[64 * j] = (unsigned long long)pk2(v[j].x * rstd * g.x, v[j].y * rstd * g.y) | ((unsigned long long)pk2(v[j].z * rstd * g.z, v[j].w * rstd * g.w) << 32); }
    return rstd;
}
__device__ __forceinline__ void norm_phase(Frame& F, const float* x, const float* gain, bf16* out) {
    const int gw = F.vcu * NWAVES + F.wave, NGW = F.G * NWAVES, lane = F.lane;
    const GAS f32x4* gr = (const GAS f32x4*)gain + lane;
    f32x4 v[8], nx[8];
    if (gw < M) { const GAS f32x4* xr = (const GAS f32x4*)(x + (size_t)gw * D) + lane;
#pragma unroll
        for (int j = 0; j < 8; ++j) v[j] = xr[64 * j]; }
    for (int m = gw; m < M; m += NGW) {
        const int mn = (m + NGW < M) ? m + NGW : m; const GAS f32x4* xn = (const GAS f32x4*)(x + (size_t)mn * D) + lane;
#pragma unroll
        for (int j = 0; j < 8; ++j) nx[j] = xn[64 * j];
        float s = 0.f;
#pragma unroll
        for (int j = 0; j < 8; ++j) s += (v[j].x * v[j].x + v[j].y * v[j].y) + (v[j].z * v[j].z + v[j].w * v[j].w);
        const float rstd = 1.f / sqrtf(wave_sum(s) * (1.f / D) + EPS);
        GAS unsigned long long* o8 = (GAS unsigned long long*)(out + (size_t)m * D) + lane;
#pragma unroll
        for (int j = 0; j < 8; ++j) { const f32x4 g = gr[64 * j];
            o8[64 * j] = (unsigned long long)pk2(v[j].x * rstd * g.x, v[j].y * rstd * g.y) | ((unsigned long long)pk2(v[j].z * rstd * g.z, v[j].w * rstd * g.w) << 32); }
#pragma unroll
        for (int j = 0; j < 8; ++j) v[j] = nx[j];
    }
}
__device__ __forceinline__ void norm_phase_b(Frame& F, const bf16* x, const float* gain, bf16* out) {
    const int gw = F.vcu * NWAVES + F.wave, NGW = F.G * NWAVES, lane = F.lane;
    const GAS f32x4* gr = (const GAS f32x4*)gain + 2 * lane;
    v4u v[4], nx[4];
    if (gw < M) { const GAS v4u* xr = (const GAS v4u*)(x + (size_t)gw * D) + lane;
#pragma unroll
        for (int j = 0; j < 4; ++j) v[j] = xr[64 * j]; }
    for (int m = gw; m < M; m += NGW) {
        const int mn = (m + NGW < M) ? m + NGW : m; const GAS v4u* xn = (const GAS v4u*)(x + (size_t)mn * D) + lane;
#pragma unroll
        for (int j = 0; j < 4; ++j) nx[j] = xn[64 * j];
        float s = 0.f; f32x4 a[4][2];
#pragma unroll
        for (int j = 0; j < 4; ++j) { a[j][0] = pg8::bf4lo(v[j].x, v[j].y); a[j][1] = pg8::bf4lo(v[j].z, v[j].w);
            s += (a[j][0].x * a[j][0].x + a[j][0].y * a[j][0].y) + (a[j][0].z * a[j][0].z + a[j][0].w * a[j][0].w) + (a[j][1].x * a[j][1].x + a[j][1].y * a[j][1].y) + (a[j][1].z * a[j][1].z + a[j][1].w * a[j][1].w); }
        const float rstd = 1.f / sqrtf(wave_sum(s) * (1.f / D) + EPS);
        GAS v4u* o = (GAS v4u*)(out + (size_t)m * D) + lane;
#pragma unroll
        for (int j = 0; j < 4; ++j) { const f32x4 g0 = gr[128 * j], g1 = gr[128 * j + 1]; v4u w;
            w.x = pk2(a[j][0].x * rstd * g0.x, a[j][0].y * rstd * g0.y); w.y = pk2(a[j][0].z * rstd * g0.z, a[j][0].w * rstd * g0.w);
            w.z = pk2(a[j][1].x * rstd * g1.x, a[j][1].y * rstd * g1.y); w.w = pk2(a[j][1].z * rstd * g1.z, a[j][1].w * rstd * g1.w); o[64 * j] = w; }
#pragma unroll
        for (int j = 0; j < 4; ++j) v[j] = nx[j];
    }
}
typedef unsigned v2u_f __attribute__((ext_vector_type(2)));
__device__ __forceinline__ void norm_phase_q(Frame& F, const bf16* x, const float* gain, unsigned char* out, float* rowscale) {
    const int gw = F.vcu * NWAVES + F.wave, NGW = F.G * NWAVES, lane = F.lane;
    const GAS f32x4* gr = (const GAS f32x4*)gain + 2 * lane;
    v4u v[4], nx[4];
    if (gw < M) { const GAS v4u* xr = (const GAS v4u*)(x + (size_t)gw * D) + lane;
#pragma unroll
        for (int j = 0; j < 4; ++j) v[j] = xr[64 * j]; }
    for (int m = gw; m < M; m += NGW) {
        const int mn = (m + NGW < M) ? m + NGW : m; const GAS v4u* xn = (const GAS v4u*)(x + (size_t)mn * D) + lane;
#pragma unroll
        for (int j = 0; j < 4; ++j) nx[j] = xn[64 * j];
        float s = 0.f; f32x4 a[4][2];
#pragma unroll
        for (int j = 0; j < 4; ++j) { a[j][0] = pg8::bf4lo(v[j].x, v[j].y); a[j][1] = pg8::bf4lo(v[j].z, v[j].w);
            s += (a[j][0].x * a[j][0].x + a[j][0].y * a[j][0].y) + (a[j][0].z * a[j][0].z + a[j][0].w * a[j][0].w) + (a[j][1].x * a[j][1].x + a[j][1].y * a[j][1].y) + (a[j][1].z * a[j][1].z + a[j][1].w * a[j][1].w); }
        const float rstd = 1.f / sqrtf(wave_sum(s) * (1.f / D) + EPS);
        float amax = 0.f;
#pragma unroll
        for (int j = 0; j < 4; ++j)
#pragma unroll
            for (int q = 0; q < 2; ++q) { const f32x4 g = gr[128 * j + q]; a[j][q] = (f32x4){a[j][q].x * rstd * g.x, a[j][q].y * rstd * g.y, a[j][q].z * rstd * g.z, a[j][q].w * rstd * g.w};
                amax = fmaxf(amax, fmaxf(fmaxf(fabsf(a[j][q].x), fabsf(a[j][q].y)), fmaxf(fabsf(a[j][q].z), fabsf(a[j][q].w)))); }
#pragma unroll
        for (int o = 1; o < 64; o <<= 1) amax = fmaxf(amax, __shfl_xor(amax, o));
        amax = fmaxf(amax, 1e-20f); const float inv = 127.0f / amax;
        GAS v2u_f* o8 = (GAS v2u_f*)(out + (size_t)m * D) + lane;
#pragma unroll
        for (int j = 0; j < 4; ++j) { v2u_f w; w.x = pk_i8x4(a[j][0].x * inv, a[j][0].y * inv, a[j][0].z * inv, a[j][0].w * inv); w.y = pk_i8x4(a[j][1].x * inv, a[j][1].y * inv, a[j][1].z * inv, a[j][1].w * inv); o8[64 * j] = w; }
        if (lane == 0) rowscale[m] = amax * (1.0f / 127.0f);
#pragma unroll
        for (int j = 0; j < 4; ++j) v[j] = nx[j];
    }
}
struct P0Args { const float *w_in, *w_out, *w_gate, *w_up, *w_down, *w_qkv, *w_o, *w_pool, *we_gate, *we_up, *we_down, *w_spatial; const int* positions; const float* x; const float* norm_mix; };
__device__ __forceinline__ void p0_prologue(Frame& F, const P0Args& a, unsigned char* ws) {
    LAS float* scr = (LAS float*)(F.lds + RING_OFF + F.wave * 16384);
    const int gw = F.vcu * NWAVES + F.wave, NGW = F.G * NWAVES, lane = F.lane;
    norm_phase(F, a.x, a.norm_mix, (bf16*)(ws + WS_A));
    constexpr int I_IN = (D / 64) * (ZW / 64), I_DD = (D / 64) * (D / 64), I_FF = (D / 64) * (FF / 64), I_QKV = (D / 64) * (NQKV / 64), I_POOL = 4 * 4;
    constexpr int N_DENSE = I_IN + I_DD + 3 * I_FF + I_QKV + I_DD + 4 * I_POOL, N_ALL = N_DENSE + NE * 3 * I_FF;
    { LAS float* red = (LAS float*)(F.lds + RING_OFF + 131072 - 128);     volatile LAS float* LWf = (volatile LAS float*)(F.lds + LDSCTL_OFF);
      float sg_ = 0.f, su_ = 0.f, sq_ = 0.f, so_ = 0.f;
      for (int i = F.tid; i < 16384; i += 512) { const float g_ = a.w_gate[i], u_ = a.w_up[i], q_ = a.w_qkv[i], o_ = a.w_o[i]; sg_ += g_ * g_; su_ += u_ * u_; sq_ += q_ * q_; so_ += o_ * o_; }
      sg_ = wave_sum(sg_); su_ = wave_sum(su_); sq_ = wave_sum(sq_); so_ = wave_sum(so_);
      if (lane == 0) { red[4 * F.wave] = sg_; red[4 * F.wave + 1] = su_; red[4 * F.wave + 2] = sq_; red[4 * F.wave + 3] = so_; }
      __syncthreads();
      if (F.tid == 0) { float tg = 0.f, tu = 0.f, tq = 0.f, to = 0.f; for (int w_ = 0; w_ < NWAVES; ++w_) { tg += red[4 * w_]; tu += red[4 * w_ + 1]; tq += red[4 * w_ + 2]; to += red[4 * w_ + 3]; }
          LWf[LW_WSC + 3] = 4.0f * sqrtf(to * (1.0f / 16384.0f)) * (1.0f / 127.0f);
          LWf[LW_WSC] = 4.0f * sqrtf(tg * (1.0f / 16384.0f)) * (1.0f / 127.0f); LWf[LW_WSC + 1] = 4.0f * sqrtf(tu * (1.0f / 16384.0f)) * (1.0f / 127.0f); LWf[LW_WSC + 2] = 4.0f * sqrtf(tq * (1.0f / 16384.0f)) * (1.0f / 127.0f); }
      __syncthreads(); }
    const float inv_g = 1.0f / ((volatile LAS float*)(F.lds + LDSCTL_OFF))[LW_WSC], inv_u = 1.0f / ((volatile LAS float*)(F.lds + LDSCTL_OFF))[LW_WSC + 1];
    const float inv_q = 1.0f / ((volatile LAS float*)(F.lds + LDSCTL_OFF))[LW_WSC + 2];
    const float inv_o = 1.0f / ((volatile LAS float*)(F.lds + LDSCTL_OFF))[LW_WSC + 3];
    for (int it = gw; it < N_ALL; it += NGW) {
        int r = it;
        if (r < I_IN) { p0_matrix<0, false>(a.w_in, D, ZW, ws + WS_WIN, 1.f, scr, lane, r); continue; } r -= I_IN;
        if (r < I_DD) { p0_matrix<0, false>(a.w_out, D, D, ws + WS_WOUT, 1.f, scr, lane, r); continue; } r -= I_DD;
        if (r < I_FF) { p0_matrix_i8w<1>(a.w_gate, D, FF, ws + WS_WGU, inv_g, scr, lane, r); continue; } r -= I_FF;
        if (r < I_FF) { p0_matrix_i8w<2>(a.w_up, D, FF, ws + WS_WGU, inv_u, scr, lane, r); continue; } r -= I_FF;
        if (r < I_FF) { p0_matrix8w<0>(a.w_down, FF, D, ws + WS_WD, W8_SCALE, scr, lane, r); continue; } r -= I_FF;
        if (r < I_QKV) { p0_matrix_i8w<3>(a.w_qkv, D, NQKV, ws + WS_WQKV, inv_q, scr, lane, r); continue; } r -= I_QKV;
        if (r < I_DD) { p0_matrix_i8w<0>(a.w_o, D, D, ws + WS_WO, inv_o, scr, lane, r); continue; } r -= I_DD;
        if (r < 4 * I_POOL) { const int g = r / I_POOL; p0_matrix<0, false>(a.w_pool + (size_t)g * 65536, 256, 256, ws + WS_WPOOL + (size_t)g * 65536 * 2, 1.f, scr, lane, r % I_POOL); continue; } r -= 4 * I_POOL;
        { constexpr int I8 = (D / 128) * (FF / 32); static_assert(I8 == I_FF && (FF / 128) * (D / 32) == I_FF, "same item count in both item shapes");
          const int e = r / (3 * I_FF), q = r % (3 * I_FF), which = q / I_FF, ii = q % I_FF;
          if (which == 0) p0_matrix8w<1>(a.we_gate + (size_t)e * D * FF, D, FF, ws + WS_WEGU + (size_t)e * 2 * FF * D, W8_SCALE, scr, lane, ii);
          else if (which == 1) p0_matrix8w<2>(a.we_up + (size_t)e * D * FF, D, FF, ws + WS_WEGU + (size_t)e * 2 * FF * D, W8_SCALE, scr, lane, ii);
          else p0_matrix8w<0>(a.we_down + (size_t)e * FF * D, FF, D, ws + WS_WED + (size_t)e * D * FF, W8_SCALE, scr, lane, ii); }
    }
    { bf16* wsp = (bf16*)(ws + WS_WSP); const int gt = F.vcu * NWAVES * 64 + F.tid, NT = F.G * NWAVES * 64;
      for (int i = gt; i < 8 * 128 * 128; i += NT) { const int t = (i >> 7) & 127, s = i & 127; wsp[i] = (bf16)(s <= t ? f2bf(a.w_spatial[i]) : 0u); }
      float* rope = (float*)(ws + WS_ROPE);
      for (int i = gt; i < M * 32; i += NT) { const int r = i >> 5, k = i & 31;
          const float inv = exp2f(-(float)k * (13.287712379549449f / 32.0f)); const float ang = (float)a.positions[r] * inv;
          const double rev = (double)ang * 0.15915494309189535; const float fr = (float)(rev - rint(rev));
          rope[(size_t)r * 64 + k] = __builtin_amdgcn_cosf(fr); rope[(size_t)r * 64 + 32 + k] = __builtin_amdgcn_sinf(fr); } }
}

typedef unsigned v2u __attribute__((ext_vector_type(2)));
__device__ __forceinline__ void p2_mixer(Frame& F, const bf16* Z, bf16* Y, const bf16* WpT, const float* pscale, const bf16* Wsp, const float* bsp, const float* lng, const float* lnb) {
    constexpr int ZP = 136;
    LAS bf16* ZS = (LAS bf16*)(F.lds);
    LAS bf16* PL = (LAS bf16*)(F.lds + 144 * ZP * 2);
    LAS bf16* VT = (LAS bf16*)(F.lds);
    LAS float* ST = (LAS float*)(F.lds + 81920);
    const int tid = F.tid, lane = F.lane, w = F.wave, fr = lane & 15, fq = lane >> 4;
    for (int unit = F.vcu; unit < M / 128; unit += F.G) {
        const int r0 = unit * 128, tpos0 = r0 % SEQ; const bool first = tpos0 == 0;
        for (int g = 0; g < 4; ++g) {
            const int win = 2 << g;
            f32x4 acc[2][8];
#pragma unroll
            for (int a = 0; a < 2; ++a)
#pragma unroll
                for (int b = 0; b < 8; ++b) acc[a][b] = (f32x4){0.f, 0.f, 0.f, 0.f};
            for (int kh = 0; kh < 2; ++kh) {
                __syncthreads();
                for (int i = tid; i < 144 * 16; i += 512) { const int row = i >> 4, ch = i & 15; v4u v = (v4u){0u, 0u, 0u, 0u};
                    if (!(first && row < 16)) v = *(const GAS v4u*)(Z + (size_t)(r0 - 16 + row) * ZW + g * 256 + kh * 128 + ch * 8);
                    *(LAS v4u*)(ZS + row * ZP + ch * 8) = v; }
                __syncthreads();
                { const int ch = tid & 15, tq = tid >> 4;
#pragma unroll 1
                  for (int k = 0; k < 4; ++k) { const int t = tq + 32 * k; float s[8];
#pragma unroll
                      for (int j = 0; j < 8; ++j) s[j] = 0.f;
                      for (int j = 0; j < win; ++j) { const v4u v = *(const LAS v4u*)(ZS + (t + 16 - j) * ZP + ch * 8);
                          s[0] += bflo(v.x); s[1] += bfhi(v.x); s[2] += bflo(v.y); s[3] += bfhi(v.y); s[4] += bflo(v.z); s[5] += bfhi(v.z); s[6] += bflo(v.w); s[7] += bfhi(v.w); }
                      const v4u zc = *(const LAS v4u*)(ZS + (t + 16) * ZP + ch * 8); const int tp = tpos0 + t; const float inv = 1.0f / (float)(tp + 1 < win ? tp + 1 : win);
                      v4u o; o.x = pk2(s[0] * inv - bflo(zc.x), s[1] * inv - bfhi(zc.x)); o.y = pk2(s[2] * inv - bflo(zc.y), s[3] * inv - bfhi(zc.y));
                      o.z = pk2(s[4] * inv - bflo(zc.z), s[5] * inv - bfhi(zc.z)); o.w = pk2(s[6] * inv - bflo(zc.w), s[7] * inv - bfhi(zc.w));
                      *(LAS v4u*)(PL + t * ZP + ch * 8) = o; } }
                __syncthreads();
#pragma unroll 1
                for (int ks = 0; ks < 4; ++ks) { bf16x8 af[2];
#pragma unroll
                    for (int db = 0; db < 2; ++db) af[db] = *(const GAS bf16x8*)(WpT + ((size_t)g * 256 + 32 * w + 16 * db + fr) * 256 + kh * 128 + 32 * ks + 8 * fq);
#pragma unroll
                    for (int tb = 0; tb < 8; ++tb) { const bf16x8 bv = *(const LAS bf16x8*)(PL + (16 * tb + fr) * ZP + 32 * ks + 8 * fq);
#pragma unroll
                        for (int db = 0; db < 2; ++db) acc[db][tb] = __builtin_amdgcn_mfma_f32_16x16x32_bf16(af[db], bv, acc[db][tb], 0, 0, 0); } }
            }
#pragma unroll
            for (int db = 0; db < 2; ++db) { const int col = g * 256 + 32 * w + 16 * db + 4 * fq; const f32x4 sc = *(const GAS f32x4*)(pscale + col);
#pragma unroll
                for (int tb = 0; tb < 8; ++tb) { const f32x4 v = acc[db][tb] * sc; v2u o; o.x = pk2(v[0], v[1]); o.y = pk2(v[2], v[3]);
                    *(GAS v2u*)(Y + (size_t)(r0 + 16 * tb + fr) * D + col) = o; } }
        }
        __syncthreads();
        for (int k = 0; k < 16; ++k) { const int t = 16 * w + k; const GAS v4u* vr = (const GAS v4u*)(Z + (size_t)(r0 + t) * ZW + PW + GW) + lane; const v4u a = vr[0], b = vr[64];
            float x[16] = {bflo(a.x), bfhi(a.x), bflo(a.y), bfhi(a.y), bflo(a.z), bfhi(a.z), bflo(a.w), bfhi(a.w), bflo(b.x), bfhi(b.x), bflo(b.y), bfhi(b.y), bflo(b.z), bfhi(b.z), bflo(b.w), bfhi(b.w)};
            float s = 0.f;
#pragma unroll
            for (int j = 0; j < 16; ++j) s += x[j];
            const float mean = wave_sum(s) * (1.0f / GW); float q = 0.f;
#pragma unroll
            for (int j = 0; j < 16; ++j) { const float d = x[j] - mean; q += d * d; }
            const float rstd = 1.0f / sqrtf(wave_sum(q) * (1.0f / GW) + EPS);
            if (lane == 0) { ST[2 * t] = mean; ST[2 * t + 1] = rstd; } }
        __syncthreads();
        for (int g = 0; g < 8; ++g) {
#pragma unroll 1
            for (int k = 0; k < 4; ++k) { const int i = tid + 512 * k, s = i >> 4, ch = i & 15;
                const v4u v = *(const GAS v4u*)(Z + (size_t)(r0 + s) * ZW + PW + GW + g * 128 + ch * 8); const float mean = ST[2 * s], rstd = ST[2 * s + 1];
                const f32x4 g0 = *(const GAS f32x4*)(lng + g * 128 + ch * 8), g1 = *(const GAS f32x4*)(lng + g * 128 + ch * 8 + 4), b0 = *(const GAS f32x4*)(lnb + g * 128 + ch * 8), b1 = *(const GAS f32x4*)(lnb + g * 128 + ch * 8 + 4);
                LAS bf16* vt = VT + (ch * 8) * ZP + s;
                vt[0 * ZP] = (bf16)f2bf((bflo(v.x) - mean) * rstd * g0[0] + b0[0]); vt[1 * ZP] = (bf16)f2bf((bfhi(v.x) - mean) * rstd * g0[1] + b0[1]);
                vt[2 * ZP] = (bf16)f2bf((bflo(v.y) - mean) * rstd * g0[2] + b0[2]); vt[3 * ZP] = (bf16)f2bf((bfhi(v.y) - mean) * rstd * g0[3] + b0[3]);
                vt[4 * ZP] = (bf16)f2bf((bflo(v.z) - mean) * rstd * g1[0] + b1[0]); vt[5 * ZP] = (bf16)f2bf((bfhi(v.z) - mean) * rstd * g1[1] + b1[1]);
                vt[6 * ZP] = (bf16)f2bf((bflo(v.w) - mean) * rstd * g1[2] + b1[2]); vt[7 * ZP] = (bf16)f2bf((bfhi(v.w) - mean) * rstd * g1[3] + b1[3]); }
            __syncthreads();
            f32x4 acc[8];
#pragma unroll
            for (int b = 0; b < 8; ++b) acc[b] = (f32x4){0.f, 0.f, 0.f, 0.f};
            const int nks = (w >> 1) + 1;
#pragma unroll 1
            for (int ks = 0; ks < nks; ++ks) { const bf16x8 bw = *(const GAS bf16x8*)(Wsp + ((size_t)g * 128 + 16 * w + fr) * 128 + 32 * ks + 8 * fq);
#pragma unroll
                for (int cb = 0; cb < 8; ++cb) { const bf16x8 av = *(const LAS bf16x8*)(VT + (16 * cb + fr) * ZP + 32 * ks + 8 * fq);
                    acc[cb] = __builtin_amdgcn_mfma_f32_16x16x32_bf16(av, bw, acc[cb], 0, 0, 0); } }
            { const int t = 16 * w + fr; const float bias = bsp[g * 128 + t];
#pragma unroll
              for (int cb = 0; cb < 8; ++cb) { const int c = g * 128 + 16 * cb + 4 * fq; const v2u uu = *(const GAS v2u*)(Z + (size_t)(r0 + t) * ZW + PW + c);
                  v2u o; o.x = pk2(bflo(uu.x) * (acc[cb][0] + bias), bfhi(uu.x) * (acc[cb][1] + bias)); o.y = pk2(bflo(uu.y) * (acc[cb][2] + bias), bfhi(uu.y) * (acc[cb][3] + bias));
                  *(GAS v2u*)(Y + (size_t)(r0 + t) * D + PW + c) = o; } }
            __syncthreads();
        }
    }
}

__device__ __forceinline__ void p10_combine(Frame& F, const bf16* O0, const bf16* O1, unsigned char* O, float* rowscale, const float* lq1, const float* lk1, const float* lq2, const float* lk2, const float* subg) {
    const int gw = F.vcu * NWAVES + F.wave, NGW = F.G * NWAVES, lane = F.lane;
    const float s1 = wave_sum(lq1[lane] * lk1[lane]), s2 = wave_sum(lq2[lane] * lk2[lane]);
    const float lam = expf(s1) - expf(s2) + LAMBDA_INIT;
    const int e0 = (lane & 15) * 8;
    const f32x4 g0 = *(const GAS f32x4*)(subg + e0), g1 = *(const GAS f32x4*)(subg + e0 + 4);
    const float post = 1.0f - LAMBDA_INIT;
    for (int m = gw; m < M; m += NGW) {
        const GAS v4u* a = (const GAS v4u*)(O0 + (size_t)m * D) + lane; const GAS v4u* b = (const GAS v4u*)(O1 + (size_t)m * D) + lane; GAS v2u* o = (GAS v2u*)(O + (size_t)m * D) + lane;
        float val[4][8]; float amax = 0.f;
#pragma unroll
        for (int j = 0; j < 4; ++j) { const v4u x = a[64 * j], y = b[64 * j]; float d[8];
            d[0] = bflo(x.x) - lam * bflo(y.x); d[1] = bfhi(x.x) - lam * bfhi(y.x); d[2] = bflo(x.y) - lam * bflo(y.y); d[3] = bfhi(x.y) - lam * bfhi(y.y);
            d[4] = bflo(x.z) - lam * bflo(y.z); d[5] = bfhi(x.z) - lam * bfhi(y.z); d[6] = bflo(x.w) - lam * bflo(y.w); d[7] = bfhi(x.w) - lam * bfhi(y.w);
            float q = 0.f;
#pragma unroll
            for (int i = 0; i < 8; ++i) q += d[i] * d[i];
            q += __shfl_xor(q, 1); q += __shfl_xor(q, 2); q += __shfl_xor(q, 4); q += __shfl_xor(q, 8);
            const float r = post / sqrtf(q * (1.0f / 128.0f) + EPS);
            val[j][0] = d[0] * r * g0[0]; val[j][1] = d[1] * r * g0[1]; val[j][2] = d[2] * r * g0[2]; val[j][3] = d[3] * r * g0[3];
            val[j][4] = d[4] * r * g1[0]; val[j][5] = d[5] * r * g1[1]; val[j][6] = d[6] * r * g1[2]; val[j][7] = d[7] * r * g1[3];
#pragma unroll
            for (int i = 0; i < 8; ++i) amax = fmaxf(amax, fabsf(val[j][i])); }
#pragma unroll
        for (int sft = 1; sft < 64; sft <<= 1) amax = fmaxf(amax, __shfl_xor(amax, sft));
        amax = fmaxf(amax, 1e-20f); const float inv = 127.0f / amax;
#pragma unroll
        for (int j = 0; j < 4; ++j) { v2u w; w.x = pk_i8x4(val[j][0] * inv, val[j][1] * inv, val[j][2] * inv, val[j][3] * inv); w.y = pk_i8x4(val[j][4] * inv, val[j][5] * inv, val[j][6] * inv, val[j][7] * inv); o[64 * j] = w; }
        if (lane == 0) rowscale[m] = amax * (1.0f / 127.0f);
    }
}

__device__ __forceinline__ void p12a_route(Frame& F, const bf16* X, const float* gain, const float* wrt, unsigned char* ws) {
    LAS float* WR = (LAS float*)(F.lds);
    LAS int* SEL = (LAS int*)(F.lds + 65536);
    LAS int* RNK = (LAS int*)(F.lds + 65536 + 1024);
    LAS int* LCNT = (LAS int*)(F.lds + 65536 + 2048);
    int* tok_e = (int*)(ws + WS_TOK); int* tok_p = tok_e + 2 * M; float* tok_w = (float*)(tok_p + 2 * M); float* tok_rstd = tok_w + 2 * M;
    const int tid = F.tid, lane = F.lane, w = F.wave;
    for (int i = tid; i < D * NE; i += 512) WR[(i & 7) * D + (i >> 3)] = wrt[i];
    if (tid < 16) LCNT[tid] = 0;
    __syncthreads();
    const int rows_per_blk = M / F.G;
    const int rbase = F.vcu * rows_per_blk;
    const GAS f32x4* gr = (const GAS f32x4*)gain + 2 * lane;
    for (int li = w; li < rows_per_blk; li += NWAVES) { const int m = rbase + li;
        const GAS v4u* xr = (const GAS v4u*)(X + (size_t)m * D) + lane;
        f32x4 v[4][2]; float s = 0.f;
#pragma unroll
        for (int j = 0; j < 4; ++j) { const v4u t = xr[64 * j]; v[j][0] = pg8::bf4lo(t.x, t.y); v[j][1] = pg8::bf4lo(t.z, t.w);
#pragma unroll
            for (int q = 0; q < 2; ++q) s += (v[j][q].x * v[j][q].x + v[j][q].y * v[j][q].y) + (v[j][q].z * v[j][q].z + v[j][q].w * v[j][q].w); }
        const float rstd = 1.f / sqrtf(wave_sum(s) * (1.f / D) + EPS);
        float lg[8];
#pragma unroll
        for (int e = 0; e < 8; ++e) lg[e] = 0.f;
#pragma unroll
        for (int j = 0; j < 4; ++j)
#pragma unroll
            for (int q = 0; q < 2; ++q) { const f32x4 g = gr[128 * j + q]; const f32x4 h = (f32x4){v[j][q].x * rstd * g.x, v[j][q].y * rstd * g.y, v[j][q].z * rstd * g.z, v[j][q].w * rstd * g.w};
#pragma unroll
                for (int e = 0; e < 8; ++e) { const f32x4 wv = *(const LAS f32x4*)(WR + e * D + 8 * (64 * j + lane) + 4 * q); lg[e] += (h.x * wv.x + h.y * wv.y) + (h.z * wv.z + h.w * wv.w); } }
#pragma unroll
        for (int e = 0; e < 8; ++e) lg[e] = wave_sum(lg[e]);
        if (lane == 0) {
            int e0 = 0; float v0 = lg[0];
#pragma unroll
            for (int e = 1; e < 8; ++e) if (lg[e] > v0) { v0 = lg[e]; e0 = e; }
            int e1 = -1; float v1 = -INFINITY;
#pragma unroll
            for (int e = 0; e < 8; ++e) if (e != e0 && (e1 < 0 || lg[e] > v1)) { v1 = lg[e]; e1 = e; }
            const float w1 = 1.0f / (1.0f + expf(v0 - v1)), w0 = 1.0f - w1;
            SEL[2 * li] = e0; SEL[2 * li + 1] = e1; tok_w[2 * m] = w0; tok_w[2 * m + 1] = w1; tok_rstd[m] = rstd; }
    }
    __syncthreads();
    if (tid < 2 * rows_per_blk) RNK[tid] = __hip_atomic_fetch_add(LCNT + SEL[tid], 1, __ATOMIC_RELAXED, __HIP_MEMORY_SCOPE_WORKGROUP);
    __syncthreads();
    if (tid < 8) LCNT[8 + tid] = (int)__hip_atomic_fetch_add(F.ctl + CW_GCNT + 64 * tid, (unsigned)LCNT[tid], RLX_AGENT);
    __syncthreads();
    if (tid < 2 * rows_per_blk) { const int e = SEL[tid]; tok_e[2 * rbase + tid] = e; tok_p[2 * rbase + tid] = LCNT[8 + e] + RNK[tid]; }
    __syncthreads();
}
__device__ __forceinline__ void p12b_gather(Frame& F, const bf16* X, const float* gain, unsigned char* ws) {
    volatile LAS int* LW = (volatile LAS int*)(F.lds + LDSCTL_OFF);
    if (F.tid == 0) { int ts = 0; LW[LW_TS] = 0; LW[LW_SEG] = 0;
        for (int e = 0; e < 8; ++e) { const unsigned c = __hip_atomic_load(F.ctl + CW_GCNT + 64 * e, RLX_AGENT); const int t0 = ts; ts += (int)((c + 255u) >> 8); LW[LW_TS + e + 1] = ts; LW[LW_SEG + e + 1] = ts * 256;
            for (int t = t0; t < ts && t < MAX_TILES; ++t) LW[LW_TEXP + t] = e; } }
    __syncthreads();
    int* tok_e = (int*)(ws + WS_TOK); int* tok_p = tok_e + 2 * M; float* tok_w = (float*)(tok_p + 2 * M); float* tok_rstd = tok_w + 2 * M;
    unsigned char* Xp = ws + WS_XP;
    const int gw = F.vcu * NWAVES + F.wave, NGW = F.G * NWAVES, lane = F.lane;
    const GAS f32x4* gr = (const GAS f32x4*)gain + 2 * lane;
    for (int m = gw; m < M; m += NGW) {
        const int e0 = tok_e[2 * m], e1 = tok_e[2 * m + 1]; const int p0 = LW[LW_SEG + e0] + tok_p[2 * m], p1 = LW[LW_SEG + e1] + tok_p[2 * m + 1]; const float rstd = tok_rstd[m];
        const GAS v4u* xr = (const GAS v4u*)(X + (size_t)m * D) + lane;
        GAS v2u* d0 = (GAS v2u*)(Xp + (size_t)p0 * D) + lane; GAS v2u* d1 = (GAS v2u*)(Xp + (size_t)p1 * D) + lane;
#pragma unroll
        for (int j = 0; j < 4; ++j) { const v4u t = xr[64 * j]; const f32x4 a = pg8::bf4lo(t.x, t.y), b = pg8::bf4lo(t.z, t.w), g0 = gr[128 * j], g1 = gr[128 * j + 1];
            v2u o; o.x = pg8::pk_fp8x4(a.x * rstd * g0.x, a.y * rstd * g0.y, a.z * rstd * g0.z, a.w * rstd * g0.w); o.y = pg8::pk_fp8x4(b.x * rstd * g1.x, b.y * rstd * g1.y, b.z * rstd * g1.z, b.w * rstd * g1.w);
            d0[64 * j] = o; d1[64 * j] = o; }
        asm volatile("" ::: "memory");
        if (lane == 0) { tok_p[2 * m] = p0; tok_p[2 * m + 1] = p1; }
    }
}
__device__ __forceinline__ void p15_final(Frame& F, const bf16* X, float* out, const float* gain, unsigned char* ws, bool poison) {
    const int* tok_e = (const int*)(ws + WS_TOK); const int* tok_p = tok_e + 2 * M; const float* tok_w = (const float*)(tok_p + 2 * M);
    const bf16* Ym = (const bf16*)(ws + WS_YM);
    const int gw = F.vcu * NWAVES + F.wave, NGW = F.G * NWAVES, lane = F.lane;
    const GAS f32x4* gr = (const GAS f32x4*)gain + 2 * lane;
    v4u x[4], xn[4], a[4], an[4], b[4], bn[4]; float w0 = 0.f, w1 = 0.f, w0n, w1n;
#define P15_LOAD(m_, X_, A_, B_, W0_, W1_) do { const int p0_ = tok_p[2 * (m_)], p1_ = tok_p[2 * (m_) + 1]; W0_ = tok_w[2 * (m_)]; W1_ = tok_w[2 * (m_) + 1]; \
        const GAS v4u* xr_ = (const GAS v4u*)(X + (size_t)(m_) * D) + lane; const GAS v4u* y0_ = (const GAS v4u*)(Ym + (size_t)p0_ * D) + lane; const GAS v4u* y1_ = (const GAS v4u*)(Ym + (size_t)p1_ * D) + lane; \
        _Pragma("unroll") for (int j = 0; j < 4; ++j) { X_[j] = xr_[64 * j]; A_[j] = y0_[64 * j]; B_[j] = y1_[64 * j]; } } while (0)
    if (gw < M) P15_LOAD(gw, x, a, b, w0, w1);
    for (int m = gw; m < M; m += NGW) {
        const int mn = (m + NGW < M) ? m + NGW : m;
        P15_LOAD(mn, xn, an, bn, w0n, w1n);
        f32x4 v[4][2]; float s = 0.f;
#pragma unroll
        for (int j = 0; j < 4; ++j) {
            v[j][0] = pg8::bf4lo(x[j].x, x[j].y) + pg8::bf4lo(a[j].x, a[j].y) * w0 + pg8::bf4lo(b[j].x, b[j].y) * w1;
            v[j][1] = pg8::bf4lo(x[j].z, x[j].w) + pg8::bf4lo(a[j].z, a[j].w) * w0 + pg8::bf4lo(b[j].z, b[j].w) * w1;
#pragma unroll
            for (int q = 0; q < 2; ++q) s += (v[j][q].x * v[j][q].x + v[j][q].y * v[j][q].y) + (v[j][q].z * v[j][q].z + v[j][q].w * v[j][q].w); }
        float rstd = 1.f / sqrtf(wave_sum(s) * (1.f / D) + EPS);
        if (poison) rstd = __builtin_nanf("");
        GAS f32x4* xo = (GAS f32x4*)(out + (size_t)m * D) + 2 * lane;
#pragma unroll
        for (int j = 0; j < 4; ++j)
#pragma unroll
            for (int q = 0; q < 2; ++q) { const f32x4 g = gr[128 * j + q]; xo[128 * j + q] = (f32x4){v[j][q].x * rstd * g.x, v[j][q].y * rstd * g.y, v[j][q].z * rstd * g.z, v[j][q].w * rstd * g.w}; }
#pragma unroll
        for (int j = 0; j < 4; ++j) { x[j] = xn[j]; a[j] = an[j]; b[j] = bn[j]; }
        w0 = w0n; w1 = w1n;
    }
#undef P15_LOAD
}
struct Args { const void* in[29]; float* out; unsigned char* ws; };
__global__ void __launch_bounds__(NWAVES * 64, 2) hybrid_fwd(Args args) {
    extern __shared__ __attribute__((aligned(16))) unsigned char lds[];
    Frame F;
    F.lds = (LAS unsigned char*)lds;
    F.MISC = (volatile LAS unsigned*)(F.lds + MISC_OFF);
    F.tid = threadIdx.x; F.lane = F.tid & 63; F.wave = __builtin_amdgcn_readfirstlane(F.tid >> 6);
    F.G = gridDim.x; { const int bx = blockIdx.x; F.vcu = (F.G % 8 == 0) ? (bx % 8) * (F.G / 8) + bx / 8 : bx; }
    unsigned char* ws = args.ws;
    F.ctl = (gu32*)(ws + WS_CTL);
    for (int u = F.tid; u < (LDS_BYTES - LDSCTL_OFF) / 4; u += NWAVES * 64) ((LAS unsigned*)(F.lds + LDSCTL_OFF))[u] = 0u;
    __syncthreads();
    XcdBarrier bar = xcd_barrier_post((unsigned*)(F.ctl + CW_BAR), F.MISC + 8);
#define GRID_BAR() do { xcd_barrier(bar); int t_ = threadIdx.x; asm volatile("" : "+v"(t_)); F.tid = t_; F.lane = t_ & 63; } while (0)
    const float* x = (const float*)args.in[0]; float* out = args.out;
    bf16* const A = (bf16*)(ws + WS_A); bf16* const XR = (bf16*)(ws + WS_XR);
    typedef pg8::bf16_t pb;

    { P0Args a; a.w_in = (const float*)args.in[3]; a.w_out = (const float*)args.in[10]; a.w_gate = (const float*)args.in[12]; a.w_up = (const float*)args.in[13]; a.w_down = (const float*)args.in[14];
      a.w_qkv = (const float*)args.in[16]; a.w_o = (const float*)args.in[22]; a.w_pool = (const float*)args.in[4]; a.we_gate = (const float*)args.in[25]; a.we_up = (const float*)args.in[26]; a.we_down = (const float*)args.in[27];
      a.w_spatial = (const float*)args.in[8]; a.positions = (const int*)args.in[1]; a.x = x; a.norm_mix = (const float*)args.in[2];
      p0_prologue(F, a, ws); }
    GRID_BAR();
    { pg8::Gemm g{(const pb*)A, (const pb*)(ws + WS_WIN), D, 0}; pg8::StaticOrder S; S.init(M, ZW, F.G, (int)blockIdx.x);
      pg8::EpiZ E{(pb*)(ws + WS_Z), ZW, PW / 256};
      pg8::gemm_phase<pg8::EpiZ, pg8::StaticOrder, true, true>(F.lds + RING_OFF, g, S, E); }
    GRID_BAR();
    p2_mixer(F, (const bf16*)(ws + WS_Z), (bf16*)(ws + WS_Y1), (const bf16*)(ws + WS_WPOOL), (const float*)args.in[5], (const bf16*)(ws + WS_WSP), (const float*)args.in[9], (const float*)args.in[6], (const float*)args.in[7]);
    GRID_BAR();
    { pg8::Gemm g{(const pb*)(ws + WS_Y1), (const pb*)(ws + WS_WOUT), D, 0}; pg8::StaticOrder S; S.init(M, D, F.G, (int)blockIdx.x);
      pg8::EpiResB<true> E{x, (pb*)XR, D, 1.0f};
      pg8::gemm_phase<pg8::EpiResB<true>, pg8::StaticOrder, true, true>(F.lds + RING_OFF, g, S, E); }
    GRID_BAR();
    norm_phase_q(F, XR, (const float*)args.in[11], (unsigned char*)A, (float*)(ws + WS_HSCALE));
    GRID_BAR();
    { pg8::Gemm g{(const pb*)A, (const pb*)(ws + WS_WGU), D / 2, 0}; pg8::StaticOrder S; S.init(M, 2 * FF, F.G, (int)blockIdx.x);
      volatile LAS float* LWf = (volatile LAS float*)(F.lds + LDSCTL_OFF);
      pg8::EpiSwiGLUq E{ws + WS_ACT, FF, (const float*)(ws + WS_HSCALE), LWf[LW_WSC], LWf[LW_WSC + 1]};
      pg8::gemm_phase<pg8::EpiSwiGLUq, pg8::StaticOrder, true, true, false, true>(F.lds + RING_OFF, g, S, E); }
    GRID_BAR();
    { pg8::Gemm g{(const pb*)(ws + WS_ACT), (const pb*)(ws + WS_WD), FF / 2, 0}; pg8::StaticOrder S; S.init(M, D, F.G, (int)blockIdx.x);
      pg8::EpiResB<false> E{(const pb*)XR, (pb*)XR, D, 1.0f / W8_SCALE};
      pg8::gemm_phase<pg8::EpiResB<false>, pg8::StaticOrder, true, true, true>(F.lds + RING_OFF, g, S, E); }
    GRID_BAR();
    norm_phase_q(F, XR, (const float*)args.in[15], (unsigned char*)A, (float*)(ws + WS_HSCALE));
    GRID_BAR();
    { pg8::Gemm g{(const pb*)A, (const pb*)(ws + WS_WQKV), D / 2, 0}; pg8::StaticOrder S; S.init(M, 2 * D, F.G, (int)blockIdx.x);
      pg8::EpiQKVq8 E{ws + WS_Q, ws + WS_K, D, (const float*)(ws + WS_ROPE), attn_body::C2, (const float*)(ws + WS_HSCALE), ((volatile LAS float*)(F.lds + LDSCTL_OFF))[LW_WSC + 2]};
      pg8::gemm_phase<pg8::EpiQKVq8, pg8::StaticOrder, true, true, false, true>(F.lds + RING_OFF, g, S, E); }
    { pg8::Gemm g{(const pb*)(ws + WS_WQKV + (size_t)2 * D * D), (const pb*)A, D / 2, 0}; pg8::StaticOrder S; S.init(D, M, F.G, (int)blockIdx.x);
      pg8::EpiVT E{ws + WS_V, (const float*)(ws + WS_HSCALE), ((volatile LAS float*)(F.lds + LDSCTL_OFF))[LW_WSC + 2], SEQ};
      pg8::gemm_phase<pg8::EpiVT, pg8::StaticOrder, true, true, false, true>(F.lds + RING_OFF, g, S, E); }
    GRID_BAR();
    { const attn_body::DiffOrder S(F.vcu); attn_body::AttnUnit u;
      const unsigned char* Qb = ws + WS_Q; const unsigned char* Kb = ws + WS_K;     const unsigned char* VTb = ws + WS_V;
#define ATTN_UNITS(TRAIL) for (int i = 0; S.next(i, u); ++i) { const int qc = (u.h * 2 + u.c) * 64, vc = u.h * 128; \
          attn_body::bf16* Ob = (attn_body::bf16*)(ws + (u.c ? WS_O1 : WS_O0)); \
          attn_body::attn_unit<8, TRAIL>(u.b, 0, u.qb, Qb + qc, Kb + qc, VTb + (size_t)(u.b * 16 + u.h) * 128 * SEQ, Ob + vc, (char*)lds + RING_OFF); }
      if (F.wave < 4) { ATTN_UNITS(false) } else { ATTN_UNITS(true) }
#undef ATTN_UNITS
    }
    GRID_BAR();
    p10_combine(F, (const bf16*)(ws + WS_O0), (const bf16*)(ws + WS_O1), (unsigned char*)A, (float*)(ws + WS_HSCALE), (const float*)args.in[17], (const float*)args.in[18], (const float*)args.in[19], (const float*)args.in[20], (const float*)args.in[21]);
    GRID_BAR();
    { pg8::Gemm g{(const pb*)A, (const pb*)(ws + WS_WO), D / 2, 0}; pg8::StaticOrder S; S.init(M, D, F.G, (int)blockIdx.x);
      pg8::EpiResBq E{(pb*)XR, D, (const float*)(ws + WS_HSCALE), ((volatile LAS float*)(F.lds + LDSCTL_OFF))[LW_WSC + 3]};
      pg8::gemm_phase<pg8::EpiResBq, pg8::StaticOrder, true, true, false, true>(F.lds + RING_OFF, g, S, E); }
    GRID_BAR();
    p12a_route(F, XR, (const float*)args.in[23], (const float*)args.in[24], ws);
    GRID_BAR();
    p12b_gather(F, XR, (const float*)args.in[23], ws);
    GRID_BAR();
    { volatile LAS int* LW = (volatile LAS int*)(F.lds + LDSCTL_OFF); const int n_tiles = __builtin_amdgcn_readfirstlane(LW[LW_TS + 8]);
      { pg8::Gemm g{(const pb*)(ws + WS_XP), (const pb*)(ws + WS_WEGU), D / 2, (size_t)2 * FF * D}; pg8::MoeOrder S; S.init(n_tiles * 256, 2 * FF, F.G, (int)blockIdx.x); S.tile0 = 0;
        S.texp = (const volatile LAS int*)(F.lds + LDSCTL_OFF) + LW_TEXP;
        pg8::EpiSwiGLU8 E{ws + WS_ACTC, FF, 1.0f / W8_SCALE};
        pg8::gemm_phase<pg8::EpiSwiGLU8, pg8::MoeOrder, true, true, true>(F.lds + RING_OFF, g, S, E); }
      GRID_BAR();
      { pg8::Gemm g{(const pb*)(ws + WS_ACTC), (const pb*)(ws + WS_WED), FF / 2, (size_t)D * FF}; pg8::MoeOrder S; S.init(n_tiles * 256, D, F.G, (int)blockIdx.x); S.tile0 = 0;
        S.texp = (const volatile LAS int*)(F.lds + LDSCTL_OFF) + LW_TEXP;
        pg8::EpiPlainS E{(pb*)(ws + WS_YM), D, 1.0f / W8_SCALE};
        pg8::gemm_phase<pg8::EpiPlainS, pg8::MoeOrder, true, true, true>(F.lds + RING_OFF, g, S, E); }
      GRID_BAR();
    }
    { const bool poison = __hip_atomic_load(F.ctl + CW_BAR + XB_TMO, RLX_AGENT) != 0u;
      p15_final(F, XR, out, (const float*)args.in[28], ws, poison); }
}

extern "C" void kernel_launch(void* const* d_in, const int* in_sizes, int n_in, void* d_out, int out_size, void* d_ws, size_t ws_size, hipStream_t stream) {
    static int grid = 0;
    if (grid == 0) {
        if (n_in != 29 || in_sizes[0] != M * D || out_size != M * D || ws_size < WS_END) { fprintf(stderr, "kernel_launch: unexpected shapes (n_in %d, in0 %d, out %d, ws %zu < %zu); nothing launched\n", n_in, n_in > 0 ? in_sizes[0] : -1, out_size, ws_size, (size_t)WS_END); grid = -1; return; }
        int dev = 0, cus = 0, per_cu = 0;
        if (hipGetDevice(&dev) != hipSuccess || hipDeviceGetAttribute(&cus, hipDeviceAttributeMultiprocessorCount, dev) != hipSuccess) { grid = -1; return; }
        if (hipFuncSetAttribute((const void*)hybrid_fwd, hipFuncAttributeMaxDynamicSharedMemorySize, LDS_BYTES) != hipSuccess) { fprintf(stderr, "kernel_launch: hipFuncSetAttribute failed\n"); grid = -1; return; }
        if (hipOccupancyMaxActiveBlocksPerMultiprocessor(&per_cu, (const void*)hybrid_fwd, NWAVES * 64, LDS_BYTES) != hipSuccess || per_cu < 1) fprintf(stderr, "kernel_launch: occupancy query says %d\n", per_cu);
        (void)hipGetLastError();
        if (cus < 256) { fprintf(stderr, "kernel_launch: needs 256 CUs, device has %d\n", cus); grid = -1; return; }
        grid = 256;
    }
    if (grid < 0) return;
    if (hipMemsetAsync((char*)d_ws + WS_CTL, 0, CTL_ZERO_BYTES, stream) != hipSuccess) return;
    Args a{};
    for (int i = 0; i < 29; ++i) a.in[i] = d_in[i];
    a.out = (float*)d_out; a.ws = (unsigned char*)d_ws;
    hipLaunchKernelGGL(hybrid_fwd, dim3(grid), dim3(NWAVES * 64), LDS_BYTES, stream, a);
    const hipError_t le = hipPeekAtLastError();
    if (le != hipSuccess) fprintf(stderr, "kernel_launch: launch failed: %s\n", hipGetErrorName(le));
}
```

```cpp
#include <hip/hip_runtime.h>
#include <hip/hip_bf16.h>
#include <cstdio>
#include <cstdint>
#include <cmath>
namespace pg8 {
#define PG8_LAS __attribute__((address_space(3)))
typedef unsigned short bf16_t;
typedef short bf16x8 __attribute__((ext_vector_type(8)));
typedef float f32x4 __attribute__((ext_vector_type(4)));
typedef unsigned u32x4 __attribute__((ext_vector_type(4)));
constexpr int BM = 256, BK = 64, HALF = 128, HTB = HALF * BK * 2  , STAGE_BYTES = 8 * HTB, NXCD = 8, WGM = 8;

__host__ __device__ __forceinline__ int lds_byte(int r, int c) { const int st = (r >> 4) * 2 + (c >> 5), rr = r & 15, cc = c & 31, ob = rr * 64 + cc * 2; return st * 1024 + (ob ^ (((ob >> 9) & 1) << 5)); }
__host__ __device__ __forceinline__ void stage_rc(int b, int& R, int& C) { const int st = b / 1024, sb = b % 1024, swz = sb ^ (((sb >> 9) & 1) << 5); R = (st >> 1) * 16 + swz / 64; C = (st & 1) * 32 + (swz % 64) / 2; }
__host__ __device__ __forceinline__ int perm32(int rho) { const int n = rho >> 4, i = rho & 15; return 8 * (i >> 2) + 4 * n + (i & 3); }

struct Unit { int pm, pn, be; };
struct Gemm { const bf16_t* A; const bf16_t* Bt; int K; size_t bstride; };

struct StaticOrder {
    int nM, nN, nwg, G, c;
    __host__ __device__ void init(int M, int N, int G_, int c_) { nM = M / BM; nN = N / BM; nwg = nM * nN; G = G_; c = c_; }
    __host__ __device__ bool next(int i, Unit& u) const {
        const long L = (long)i * G + c; if (L >= nwg) return false;
        int wgid = (int)L; { const int q = nwg / NXCD, r = nwg % NXCD, xcd = wgid % NXCD, off = wgid / NXCD; wgid = (xcd < r ? xcd * (q + 1) : r * (q + 1) + (xcd - r) * q) + off; }
        const int nig = WGM * nN, gid = wgid / nig, fm = gid * WGM, gsz = (nM - fm) < WGM ? (nM - fm) : WGM;
        u.pm = fm + ((wgid % nig) % gsz); u.pn = (wgid % nig) / gsz; u.be = 0; return true;
    }
    __device__ __forceinline__ void a_ready(const Unit&) const {}
    __device__ __forceinline__ void done(const Unit&) const {}
};

__device__ __forceinline__ unsigned cvt_pk_bf16(float lo, float hi) { unsigned r; asm volatile("v_cvt_pk_bf16_f32 %0, %1, %2" : "=v"(r) : "v"(lo), "v"(hi)); return r; }
typedef float f32x2 __attribute__((ext_vector_type(2)));
__device__ __forceinline__ f32x2 gelu_pk(f32x2 v) {
    const f32x2 av = __builtin_elementwise_abs(v), d = av * 0.2316418882f + 1.0f;
    f32x2 t; t.x = __builtin_amdgcn_rcpf(d.x); t.y = __builtin_amdgcn_rcpf(d.y);
    f32x2 q = t * 0.5307027145f + (-0.7265760135f); q = q * t + 0.7107068705f; q = q * t + (-0.142248368f); q = q * t + 0.127414796f; q = q * t;
    const f32x2 s = (v * v) * (-0.72134752044f);
    f32x2 e; e.x = __builtin_amdgcn_exp2f(s.x); e.y = __builtin_amdgcn_exp2f(s.y);
    const f32x2 m = v * (q * e), r = v - m;
    f32x2 o; o.x = v.x < 0.f ? m.x : r.x; o.y = v.y < 0.f ? m.y : r.y; return o;
}

typedef int v4i_t __attribute__((ext_vector_type(4)));
__device__ __forceinline__ u32x4 pack8(f32x4 v0, f32x4 v1) { u32x4 w; w.x = cvt_pk_bf16(v0[0], v0[1]); w.y = cvt_pk_bf16(v0[2], v0[3]); w.z = cvt_pk_bf16(v1[0], v1[1]); w.w = cvt_pk_bf16(v1[2], v1[3]); return w; }
__device__ __forceinline__ f32x4 gelu4(f32x4 v) { const f32x2 a = gelu_pk((f32x2){v[0], v[1]}), b = gelu_pk((f32x2){v[2], v[3]}); return (f32x4){a.x, a.y, b.x, b.y}; }
__device__ __forceinline__ float silu1(float x) { return x * __builtin_amdgcn_rcpf(1.0f + __builtin_amdgcn_exp2f(x * -1.4426950408889634f)); }
__device__ __forceinline__ f32x4 swiglu4(f32x4 g, f32x4 u) { return (f32x4){silu1(g[0]) * u[0], silu1(g[1]) * u[1], silu1(g[2]) * u[2], silu1(g[3]) * u[3]}; }

struct EpiZ {
    static constexpr bool PERM = true, AFTER_DRAIN = false;
    bf16_t* O; int ldc; int gelu_from;
    __device__ __forceinline__ void operator()(const f32x4 (&acc)[2][2][4][2], const Unit& u, int wr, int wc, int fr, int fq) const {
        const int row0 = u.pm * BM + wr * 64 + fr, col0 = u.pn * BM + wc * 32 + 8 * fq; const bool gel = u.pn >= gelu_from;
#pragma unroll
        for (int ai = 0; ai < 2; ++ai)
#pragma unroll
            for (int m = 0; m < 4; ++m) { bf16_t* rowp = O + (size_t)(row0 + ai * HALF + m * 16) * ldc + col0;
#pragma unroll
                for (int bj = 0; bj < 2; ++bj) { f32x4 v0 = acc[ai][bj][m][0], v1 = acc[ai][bj][m][1];
                    if (gel) { v0 = gelu4(v0); v1 = gelu4(v1); }
                    *(u32x4*)(rowp + bj * HALF) = pack8(v0, v1); } }
    }
};
struct EpiPlain {
    static constexpr bool PERM = true, AFTER_DRAIN = false;
    bf16_t* O; int ldc;
    __device__ __forceinline__ void operator()(const f32x4 (&acc)[2][2][4][2], const Unit& u, int wr, int wc, int fr, int fq) const {
        const int row0 = u.pm * BM + wr * 64 + fr, col0 = u.pn * BM + wc * 32 + 8 * fq;
#pragma unroll
        for (int ai = 0; ai < 2; ++ai)
#pragma unroll
            for (int m = 0; m < 4; ++m) { bf16_t* rowp = O + (size_t)(row0 + ai * HALF + m * 16) * ldc + col0;
#pragma unroll
                for (int bj = 0; bj < 2; ++bj) *(u32x4*)(rowp + bj * HALF) = pack8(acc[ai][bj][m][0], acc[ai][bj][m][1]); }
    }
};
__device__ __forceinline__ f32x4 bf4lo(unsigned a, unsigned b) { return (f32x4){__uint_as_float(a << 16), __uint_as_float(a & 0xffff0000u), __uint_as_float(b << 16), __uint_as_float(b & 0xffff0000u)}; }
template <bool RES32> struct EpiResB {
    static constexpr bool PERM = true, AFTER_DRAIN = false;
    const void* res; bf16_t* out; int ldc; float s;
    __device__ __forceinline__ void operator()(const f32x4 (&acc)[2][2][4][2], const Unit& u, int wr, int wc, int fr, int fq) const {
        const int row0 = u.pm * BM + wr * 64 + fr, col0 = u.pn * BM + wc * 32 + 8 * fq;
#pragma unroll
        for (int ai = 0; ai < 2; ++ai) { f32x4 r[4][2][2];
#pragma unroll
            for (int m = 0; m < 4; ++m) { const size_t off = (size_t)(row0 + ai * HALF + m * 16) * ldc + col0;
#pragma unroll
                for (int bj = 0; bj < 2; ++bj) {
                    if constexpr (RES32) { r[m][bj][0] = *(const f32x4*)((const float*)res + off + bj * HALF); r[m][bj][1] = *(const f32x4*)((const float*)res + off + bj * HALF + 4); }
                    else { const u32x4 w = *(const u32x4*)((const bf16_t*)res + off + bj * HALF); r[m][bj][0] = bf4lo(w.x, w.y); r[m][bj][1] = bf4lo(w.z, w.w); } } }
#pragma unroll
            for (int m = 0; m < 4; ++m) { const size_t off = (size_t)(row0 + ai * HALF + m * 16) * ldc + col0;
#pragma unroll
                for (int bj = 0; bj < 2; ++bj) *(u32x4*)(out + off + bj * HALF) = pack8(r[m][bj][0] + acc[ai][bj][m][0] * s, r[m][bj][1] + acc[ai][bj][m][1] * s); }
            asm volatile("" ::: "memory"); }
    }
};
struct EpiSwiGLU {
    static constexpr bool PERM = true, AFTER_DRAIN = false;
    bf16_t* O; int ldc;
    __device__ __forceinline__ void operator()(const f32x4 (&acc)[2][2][4][2], const Unit& u, int wr, int wc, int fr, int fq) const {
        const int row0 = u.pm * BM + wr * 64 + fr, col0 = u.pn * HALF + wc * 32 + 8 * fq;
#pragma unroll
        for (int ai = 0; ai < 2; ++ai)
#pragma unroll
            for (int m = 0; m < 4; ++m) { bf16_t* rowp = O + (size_t)(row0 + ai * HALF + m * 16) * ldc + col0;
                const f32x4 a0 = swiglu4(acc[ai][0][m][0], acc[ai][1][m][0]), a1 = swiglu4(acc[ai][0][m][1], acc[ai][1][m][1]);
                *(u32x4*)rowp = pack8(a0, a1); }
    }
};
struct EpiQKV {
    static constexpr bool PERM = true, AFTER_DRAIN = false;
    bf16_t* Q; bf16_t* Kk; bf16_t* V; int ldc; const float* rope; float qscale;
    __device__ __forceinline__ void operator()(const f32x4 (&acc)[2][2][4][2], const Unit& u, int wr, int wc, int fr, int fq) const {
        const int row0 = u.pm * BM + wr * 64 + fr;
        if (u.pn < 16) {
            bf16_t* base = (u.pn < 8) ? Q : Kk; const float sc = (u.pn < 8) ? qscale : 1.0f; const int col0 = (u.pn & 7) * BM + wc * 64 + 8 * fq;
#pragma unroll
            for (int ai = 0; ai < 2; ++ai)
#pragma unroll
                for (int m = 0; m < 4; ++m) { const int r = row0 + ai * HALF + m * 16; const float* cs = rope + (size_t)r * 64 + 8 * fq;
                    const f32x4 c0 = *(const f32x4*)(cs), c1 = *(const f32x4*)(cs + 4), s0 = *(const f32x4*)(cs + 32), s1 = *(const f32x4*)(cs + 36);
                    const f32x4 x10 = acc[ai][0][m][0], x11 = acc[ai][0][m][1], x20 = acc[ai][1][m][0], x21 = acc[ai][1][m][1];
                    const f32x4 o10 = (x10 * c0 - x20 * s0) * sc, o11 = (x11 * c1 - x21 * s1) * sc, o20 = (x20 * c0 + x10 * s0) * sc, o21 = (x21 * c1 + x11 * s1) * sc;
                    bf16_t* rowp = base + (size_t)r * ldc + col0;
                    *(u32x4*)rowp = pack8(o10, o11); *(u32x4*)(rowp + 32) = pack8(o20, o21); }
        } else {
            const int col0 = (u.pn - 16) * BM + wc * 32 + 8 * fq;
#pragma unroll
            for (int ai = 0; ai < 2; ++ai)
#pragma unroll
                for (int m = 0; m < 4; ++m) { bf16_t* rowp = V + (size_t)(row0 + ai * HALF + m * 16) * ldc + col0;
#pragma unroll
                    for (int bj = 0; bj < 2; ++bj) *(u32x4*)(rowp + bj * HALF) = pack8(acc[ai][bj][m][0], acc[ai][bj][m][1]); }
        }
    }
};
__device__ __forceinline__ f32x4 cvti4(f32x4 a, float f) { return __builtin_convertvector(__builtin_bit_cast(v4i_t, a), f32x4) * f; }
struct EpiQKVq {
    static constexpr bool PERM = true, AFTER_DRAIN = false;
    bf16_t* Q; bf16_t* Kk; bf16_t* V; int ldc; const float* rope; float qscale; const float* rowscale; float sw;
    __device__ __forceinline__ void operator()(const f32x4 (&acc)[2][2][4][2], const Unit& u, int wr, int wc, int fr, int fq) const {
        const int row0 = u.pm * BM + wr * 64 + fr;
        if (u.pn < 16) {
            bf16_t* base = (u.pn < 8) ? Q : Kk; const float sc = (u.pn < 8) ? qscale : 1.0f; const int col0 = (u.pn & 7) * BM + wc * 64 + 8 * fq;
#pragma unroll
            for (int ai = 0; ai < 2; ++ai)
#pragma unroll
                for (int m = 0; m < 4; ++m) { const int r = row0 + ai * HALF + m * 16; const float* cs = rope + (size_t)r * 64 + 8 * fq; const float f = rowscale[r] * sw;
                    const f32x4 c0 = *(const f32x4*)(cs), c1 = *(const f32x4*)(cs + 4), s0 = *(const f32x4*)(cs + 32), s1 = *(const f32x4*)(cs + 36);
                    const f32x4 x10 = cvti4(acc[ai][0][m][0], f), x11 = cvti4(acc[ai][0][m][1], f), x20 = cvti4(acc[ai][1][m][0], f), x21 = cvti4(acc[ai][1][m][1], f);
                    const f32x4 o10 = (x10 * c0 - x20 * s0) * sc, o11 = (x11 * c1 - x21 * s1) * sc, o20 = (x20 * c0 + x10 * s0) * sc, o21 = (x21 * c1 + x11 * s1) * sc;
                    bf16_t* rowp = base + (size_t)r * ldc + col0;
                    *(u32x4*)rowp = pack8(o10, o11); *(u32x4*)(rowp + 32) = pack8(o20, o21); }
        } else {
            const int col0 = (u.pn - 16) * BM + wc * 32 + 8 * fq;
#pragma unroll
            for (int ai = 0; ai < 2; ++ai)
#pragma unroll
                for (int m = 0; m < 4; ++m) { const int r = row0 + ai * HALF + m * 16; bf16_t* rowp = V + (size_t)r * ldc + col0; const float f = rowscale[r] * sw;
#pragma unroll
                    for (int bj = 0; bj < 2; ++bj) *(u32x4*)(rowp + bj * HALF) = pack8(cvti4(acc[ai][bj][m][0], f), cvti4(acc[ai][bj][m][1], f)); }
        }
    }
};
struct EpiResBq {
    static constexpr bool PERM = true, AFTER_DRAIN = false;
    bf16_t* xr; int ldc; const float* rowscale; float sw;
    __device__ __forceinline__ void operator()(const f32x4 (&acc)[2][2][4][2], const Unit& u, int wr, int wc, int fr, int fq) const {
        const int row0 = u.pm * BM + wr * 64 + fr, col0 = u.pn * BM + wc * 32 + 8 * fq;
#pragma unroll
        for (int ai = 0; ai < 2; ++ai) { u32x4 r[4][2]; float f[4];
#pragma unroll
            for (int m = 0; m < 4; ++m) { const int rr = row0 + ai * HALF + m * 16; const size_t off = (size_t)rr * ldc + col0; f[m] = rowscale[rr] * sw;
#pragma unroll
                for (int bj = 0; bj < 2; ++bj) r[m][bj] = *(const u32x4*)(xr + off + bj * HALF); }
#pragma unroll
            for (int m = 0; m < 4; ++m) { const size_t off = (size_t)(row0 + ai * HALF + m * 16) * ldc + col0;
#pragma unroll
                for (int bj = 0; bj < 2; ++bj) *(u32x4*)(xr + off + bj * HALF) = pack8(bf4lo(r[m][bj].x, r[m][bj].y) + cvti4(acc[ai][bj][m][0], f[m]), bf4lo(r[m][bj].z, r[m][bj].w) + cvti4(acc[ai][bj][m][1], f[m])); }
            asm volatile("" ::: "memory"); }
    }
};
__device__ __forceinline__ unsigned pk_fp8x4(float a, float b, float c, float d) { unsigned w = 0u; w = (unsigned)__builtin_amdgcn_cvt_pk_fp8_f32(a, b, (int)w, false); w = (unsigned)__builtin_amdgcn_cvt_pk_fp8_f32(c, d, (int)w, true); return w; }
typedef unsigned u32x2 __attribute__((ext_vector_type(2)));
struct EpiSwiGLU8 {
    static constexpr bool PERM = true, AFTER_DRAIN = false;
    unsigned char* O; int ldc; float s;
    __device__ __forceinline__ void operator()(const f32x4 (&acc)[2][2][4][2], const Unit& u, int wr, int wc, int fr, int fq) const {
        const int row0 = u.pm * BM + wr * 64 + fr, col0 = u.pn * HALF + wc * 32 + 8 * fq;
#pragma unroll
        for (int ai = 0; ai < 2; ++ai)
#pragma unroll
            for (int m = 0; m < 4; ++m) { unsigned char* rowp = O + (size_t)(row0 + ai * HALF + m * 16) * ldc + col0;
                const f32x4 a0 = swiglu4(acc[ai][0][m][0] * s, acc[ai][1][m][0] * s), a1 = swiglu4(acc[ai][0][m][1] * s, acc[ai][1][m][1] * s);
                u32x2 w; w.x = pk_fp8x4(a0[0], a0[1], a0[2], a0[3]); w.y = pk_fp8x4(a1[0], a1[1], a1[2], a1[3]);
                *(u32x2*)rowp = w; }
    }
};
struct EpiSwiGLUq {
    static constexpr bool PERM = true, AFTER_DRAIN = false;
    unsigned char* O; int ldc; const float* rowscale; float sg, su;
    __device__ __forceinline__ void operator()(const f32x4 (&acc)[2][2][4][2], const Unit& u, int wr, int wc, int fr, int fq) const {
        const int row0 = u.pm * BM + wr * 64 + fr, col0 = u.pn * HALF + wc * 32 + 8 * fq;
#pragma unroll
        for (int ai = 0; ai < 2; ++ai)
#pragma unroll
            for (int m = 0; m < 4; ++m) { const int r = row0 + ai * HALF + m * 16; unsigned char* rowp = O + (size_t)r * ldc + col0; const float rs = rowscale[r]; const float fg = rs * sg, fu = rs * su;
                const f32x4 g0 = __builtin_convertvector(__builtin_bit_cast(v4i_t, acc[ai][0][m][0]), f32x4) * fg, g1 = __builtin_convertvector(__builtin_bit_cast(v4i_t, acc[ai][0][m][1]), f32x4) * fg;
                const f32x4 u0 = __builtin_convertvector(__builtin_bit_cast(v4i_t, acc[ai][1][m][0]), f32x4) * fu, u1 = __builtin_convertvector(__builtin_bit_cast(v4i_t, acc[ai][1][m][1]), f32x4) * fu;
                const f32x4 a0 = swiglu4(g0, u0), a1 = swiglu4(g1, u1);
                u32x2 w; w.x = pk_fp8x4(a0[0], a0[1], a0[2], a0[3]); w.y = pk_fp8x4(a1[0], a1[1], a1[2], a1[3]);
                *(u32x2*)rowp = w; }
    }
};
struct EpiQKVq8 {
    static constexpr bool PERM = true, AFTER_DRAIN = false;
    unsigned char* Q; unsigned char* Kk; int ldc; const float* rope; float qscale; const float* rowscale; float sw;
    __device__ __forceinline__ void operator()(const f32x4 (&acc)[2][2][4][2], const Unit& u, int wr, int wc, int fr, int fq) const {
        const int row0 = u.pm * BM + wr * 64 + fr;
        unsigned char* base = (u.pn < 8) ? Q : Kk; const float sc = (u.pn < 8) ? qscale : 1.0f; const int col0 = (u.pn & 7) * BM + wc * 64 + 8 * fq;
#pragma unroll
        for (int ai = 0; ai < 2; ++ai)
#pragma unroll
            for (int m = 0; m < 4; ++m) { const int r = row0 + ai * HALF + m * 16; const float* cs = rope + (size_t)r * 64 + 8 * fq; const float f = rowscale[r] * sw;
                const f32x4 c0 = *(const f32x4*)(cs), c1 = *(const f32x4*)(cs + 4), s0 = *(const f32x4*)(cs + 32), s1 = *(const f32x4*)(cs + 36);
                const f32x4 x10 = cvti4(acc[ai][0][m][0], f), x11 = cvti4(acc[ai][0][m][1], f), x20 = cvti4(acc[ai][1][m][0], f), x21 = cvti4(acc[ai][1][m][1], f);
                const f32x4 o10 = (x10 * c0 - x20 * s0) * sc, o11 = (x11 * c1 - x21 * s1) * sc, o20 = (x20 * c0 + x10 * s0) * sc, o21 = (x21 * c1 + x11 * s1) * sc;
                unsigned char* rowp = base + (size_t)r * ldc + col0;
                u32x2 w1, w2; w1.x = pk_fp8x4(o10[0], o10[1], o10[2], o10[3]); w1.y = pk_fp8x4(o11[0], o11[1], o11[2], o11[3]); w2.x = pk_fp8x4(o20[0], o20[1], o20[2], o20[3]); w2.y = pk_fp8x4(o21[0], o21[1], o21[2], o21[3]);
                *(u32x2*)rowp = w1; *(u32x2*)(rowp + 32) = w2; }
    }
};
struct EpiVT {
    static constexpr bool PERM = true, AFTER_DRAIN = false;
    unsigned char* VT; const float* rowscale; float sw; int seq;
    __device__ __forceinline__ void operator()(const f32x4 (&acc)[2][2][4][2], const Unit& u, int wr, int wc, int fr, int fq) const {
        const int row0 = u.pm * BM + wr * 64 + fr;
#pragma unroll
        for (int bj = 0; bj < 2; ++bj) { const int c0 = u.pn * BM + bj * HALF + wc * 32 + 8 * fq;
            const f32x4 s0 = *(const f32x4*)(rowscale + c0) * sw, s1 = *(const f32x4*)(rowscale + c0 + 4) * sw;
            const int b = c0 / seq, pos = c0 % seq, k0 = pos & 63; const int basep = (pos & ~63) + 16 * ((k0 >> 5) & 1) + 4 * ((k0 & 31) >> 3);
#pragma unroll
            for (int ai = 0; ai < 2; ++ai)
#pragma unroll
                for (int m = 0; m < 4; ++m) { const int r = row0 + ai * HALF + m * 16;
                    const f32x4 v0 = __builtin_convertvector(__builtin_bit_cast(v4i_t, acc[ai][bj][m][0]), f32x4) * s0, v1 = __builtin_convertvector(__builtin_bit_cast(v4i_t, acc[ai][bj][m][1]), f32x4) * s1;
                    unsigned char* p = VT + ((size_t)(b * 16 + (r >> 7)) * 128 + (r & 127)) * seq + basep;
                    *(unsigned*)p = pk_fp8x4(v0[0], v0[1], v0[2], v0[3]); *(unsigned*)(p + 32) = pk_fp8x4(v1[0], v1[1], v1[2], v1[3]); } }
    }
};
struct EpiSwiGLUqs {
    static constexpr bool PERM = true, AFTER_DRAIN = false;
    unsigned char* O; int ldc; float sa; const volatile PG8_LAS float* wsc;
    __device__ __forceinline__ void operator()(const f32x4 (&acc)[2][2][4][2], const Unit& u, int wr, int wc, int fr, int fq) const {
        const int row0 = u.pm * BM + wr * 64 + fr, col0 = u.pn * HALF + wc * 32 + 8 * fq; const float fg = sa * wsc[2 * u.be], fu = sa * wsc[2 * u.be + 1];
#pragma unroll
        for (int ai = 0; ai < 2; ++ai)
#pragma unroll
            for (int m = 0; m < 4; ++m) { unsigned char* rowp = O + (size_t)(row0 + ai * HALF + m * 16) * ldc + col0;
                const f32x4 a0 = swiglu4(cvti4(acc[ai][0][m][0], fg), cvti4(acc[ai][1][m][0], fu)), a1 = swiglu4(cvti4(acc[ai][0][m][1], fg), cvti4(acc[ai][1][m][1], fu));
                u32x2 w; w.x = pk_fp8x4(a0[0], a0[1], a0[2], a0[3]); w.y = pk_fp8x4(a1[0], a1[1], a1[2], a1[3]);
                *(u32x2*)rowp = w; }
    }
};
struct EpiZq {
    static constexpr bool PERM = true, AFTER_DRAIN = false;
    bf16_t* O; int ldc; int gelu_from; const float* rowscale; float sw;
    __device__ __forceinline__ void operator()(const f32x4 (&acc)[2][2][4][2], const Unit& u, int wr, int wc, int fr, int fq) const {
        const int row0 = u.pm * BM + wr * 64 + fr, col0 = u.pn * BM + wc * 32 + 8 * fq; const bool gel = u.pn >= gelu_from;
#pragma unroll
        for (int ai = 0; ai < 2; ++ai)
#pragma unroll
            for (int m = 0; m < 4; ++m) { const int r = row0 + ai * HALF + m * 16; bf16_t* rowp = O + (size_t)r * ldc + col0; const float f = rowscale[r] * sw;
#pragma unroll
                for (int bj = 0; bj < 2; ++bj) { f32x4 v0 = cvti4(acc[ai][bj][m][0], f), v1 = cvti4(acc[ai][bj][m][1], f);
                    if (gel) { v0 = gelu4(v0); v1 = gelu4(v1); }
                    *(u32x4*)(rowp + bj * HALF) = pack8(v0, v1); } }
    }
};
struct EpiPlainS {
    static constexpr bool PERM = true, AFTER_DRAIN = false;
    bf16_t* O; int ldc; float s;
    __device__ __forceinline__ void operator()(const f32x4 (&acc)[2][2][4][2], const Unit& u, int wr, int wc, int fr, int fq) const {
        const int row0 = u.pm * BM + wr * 64 + fr, col0 = u.pn * BM + wc * 32 + 8 * fq;
#pragma unroll
        for (int ai = 0; ai < 2; ++ai)
#pragma unroll
            for (int m = 0; m < 4; ++m) { bf16_t* rowp = O + (size_t)(row0 + ai * HALF + m * 16) * ldc + col0;
#pragma unroll
                for (int bj = 0; bj < 2; ++bj) *(u32x4*)(rowp + bj * HALF) = pack8(acc[ai][bj][m][0] * s, acc[ai][bj][m][1] * s); }
    }
};
struct MoeOrder : StaticOrder {
    int tile0; const volatile PG8_LAS int* texp;
    __device__ __forceinline__ bool next(int i, Unit& u) const {
        if (!StaticOrder::next(i, u)) return false;
        u.be = __builtin_amdgcn_readfirstlane(texp[tile0 + u.pm]); return true;
    }
};
typedef int v4i_t __attribute__((ext_vector_type(4))); typedef int v8i_t __attribute__((ext_vector_type(8)));
__device__ __forceinline__ void mma8(f32x4& c, bf16x8 b0, bf16x8 b1, bf16x8 a0, bf16x8 a1, int sc) {
    const v4i_t x0 = __builtin_bit_cast(v4i_t, b0), x1 = __builtin_bit_cast(v4i_t, b1), y0 = __builtin_bit_cast(v4i_t, a0), y1 = __builtin_bit_cast(v4i_t, a1);
    const v8i_t X = __builtin_shufflevector(x0, x1, 0, 1, 2, 3, 4, 5, 6, 7), Y = __builtin_shufflevector(y0, y1, 0, 1, 2, 3, 4, 5, 6, 7);
    asm volatile("v_mfma_scale_f32_16x16x128_f8f6f4 %0, %1, %2, %0, %3, %3 op_sel_hi:[0,0,0]" : "+v"(c) : "v"(X), "v"(Y), "v"(sc));
}
__device__ __forceinline__ f32x4 mma_i8(bf16x8 b, bf16x8 a, f32x4 c) {
    return __builtin_bit_cast(f32x4, __builtin_amdgcn_mfma_i32_16x16x64_i8(__builtin_bit_cast(v4i_t, b), __builtin_bit_cast(v4i_t, a), __builtin_bit_cast(v4i_t, c), 0, 0, 0));
}
template <class Epi, class Sched, bool ALIGN_EPI = false, bool SP2 = false, bool FP8 = false, bool I8 = false>
__device__ __forceinline__ void gemm_phase(PG8_LAS unsigned char* lds, const Gemm g, const Sched& S, const Epi& E) {
    int tid_ = threadIdx.x; asm volatile("" : "+v"(tid_));
    const int tid = tid_, wid = __builtin_amdgcn_readfirstlane(tid >> 6), lane = tid & 63, wr = wid >> 2, wc = wid & 3, fr = lane & 15, fq = lane >> 4;
    const int K = g.K, nt = K / BK;
    unsigned voffA[2], voffB[2];
#pragma unroll
    for (int i = 0; i < 2; ++i) { int R, C; stage_rc(tid * 16 + i * 8192, R, C); const int Rb = Epi::PERM ? ((R & ~31) + perm32(R & 31)) : R;
        voffA[i] = (unsigned)(R * K + C) * 2u; voffB[i] = (unsigned)(Rb * K + C) * 2u; }
    const size_t kstep = (size_t)(BK * 2);
    const size_t hstep = (size_t)HALF * K * 2;
    const size_t tstep = 2 * hstep;
    const unsigned ldsw = (unsigned)wid * 1024u;
    const int aoff = lds_byte(wr * 64 + fr, fq * 8), boff = lds_byte(wc * 32 + fr, fq * 8);
#define PG8_SA(b, h) (((b) * 2 + (h)) * HTB)
#define PG8_SB(b, h) ((4 + (b) * 2 + (h)) * HTB)
#define PG8_STAGE(bufoff, gbase, voff) do { _Pragma("unroll") for (int _i = 0; _i < 2; ++_i) \
        __builtin_amdgcn_global_load_lds((const unsigned*)((const char*)(gbase) + (voff)[_i]), (PG8_LAS unsigned*)(lds + (bufoff) + ldsw + _i * 8192), 16, 0, 0); } while (0)
#define PG8_LDA(dst, b, h) do { _Pragma("unroll") for (int m = 0; m < 4; ++m) _Pragma("unroll") for (int k = 0; k < 2; ++k) dst[m][k] = *(const PG8_LAS bf16x8*)(lds + PG8_SA(b, h) + aoff + m * 2048 + k * 1024); } while (0)
#define PG8_LDB(dst, b, h) do { _Pragma("unroll") for (int n = 0; n < 2; ++n) _Pragma("unroll") for (int k = 0; k < 2; ++k) dst[n][k] = *(const PG8_LAS bf16x8*)(lds + PG8_SB(b, h) + boff + n * 2048 + k * 1024); } while (0)
#define PG8_MMA(ai, bj, At, Bt) do { __builtin_amdgcn_s_setprio(1); _Pragma("unroll") for (int m = 0; m < 4; ++m) _Pragma("unroll") for (int n = 0; n < 2; ++n) { \
        if constexpr (FP8) mma8(acc[ai][bj][m][n], Bt[n][0], Bt[n][1], At[m][0], At[m][1], sc8); \
        else if constexpr (I8) { _Pragma("unroll") for (int k = 0; k < 2; ++k) acc[ai][bj][m][n] = mma_i8(Bt[n][k], At[m][k], acc[ai][bj][m][n]); } \
        else { _Pragma("unroll") for (int k = 0; k < 2; ++k) acc[ai][bj][m][n] = __builtin_amdgcn_mfma_f32_16x16x32_bf16(Bt[n][k], At[m][k], acc[ai][bj][m][n], 0, 0, 0); } } __builtin_amdgcn_s_setprio(0); } while (0)
#define PG8_WAIT_V(n) asm volatile("s_waitcnt vmcnt(" #n ")" ::: "memory")
#define PG8_WAIT_L(n) asm volatile("s_waitcnt lgkmcnt(" #n ")" ::: "memory")
#define PG8_BAR __builtin_amdgcn_s_barrier()
#define PG8_SCHED __builtin_amdgcn_sched_barrier(0)
    int sc8 = 0x7F7F7F7F; asm volatile("" : "+v"(sc8));
    Unit cur, nxt; int ui = 0;
    if (!S.next(0, cur)) return;
    f32x4 acc[2][2][4][2];
#pragma unroll
    for (int a = 0; a < 2; ++a)
#pragma unroll
        for (int b = 0; b < 2; ++b)
#pragma unroll
            for (int m = 0; m < 4; ++m)
#pragma unroll
                for (int n = 0; n < 2; ++n) acc[a][b][m][n] = (f32x4){0.f, 0.f, 0.f, 0.f};
    bf16x8 At[4][2], B0[2][2], B1[2][2];
    const char* cA = (const char*)g.A + (size_t)cur.pm * tstep; const char* cB = (const char*)g.Bt + (size_t)cur.be * g.bstride + (size_t)cur.pn * tstep;
    S.a_ready(cur);
    if constexpr (SP2) {
        PG8_STAGE(PG8_SB(0, 0), cB, voffB); PG8_STAGE(PG8_SB(0, 1), cB + hstep, voffB); PG8_STAGE(PG8_SA(0, 0), cA, voffA); PG8_STAGE(PG8_SA(0, 1), cA + hstep, voffA);
        if (wr == 1) PG8_BAR;
        PG8_WAIT_V(2); PG8_BAR;
        PG8_STAGE(PG8_SB(1, 0), cB + kstep, voffB); PG8_STAGE(PG8_SA(1, 0), cA + kstep, voffA); PG8_STAGE(PG8_SB(1, 1), cB + hstep + kstep, voffB);
        PG8_WAIT_V(6); PG8_BAR;
    } else {
        PG8_STAGE(PG8_SB(0, 0), cB, voffB); PG8_STAGE(PG8_SA(0, 0), cA, voffA); PG8_STAGE(PG8_SB(0, 1), cB + hstep, voffB); PG8_STAGE(PG8_SA(0, 1), cA + hstep, voffA);
        if (wr == 1) PG8_BAR;
        PG8_WAIT_V(4); PG8_BAR;
        PG8_STAGE(PG8_SB(1, 0), cB + kstep, voffB); PG8_STAGE(PG8_SA(1, 0), cA + kstep, voffA); PG8_STAGE(PG8_SB(1, 1), cB + hstep + kstep, voffB);
        PG8_WAIT_V(6); PG8_BAR;
    }
    for (;;) {
        const bool has_next = S.next(ui + 1, nxt);
        const char* nA = has_next ? (const char*)g.A + (size_t)nxt.pm * tstep : cA; const char* nB = has_next ? (const char*)g.Bt + (size_t)nxt.be * g.bstride + (size_t)nxt.pn * tstep : cB;
        for (int t = 0; t < nt; t += 2) {
            const bool last = (t == nt - 2);
            const char* a1 = cA + (size_t)(t + 1) * kstep;
            const char* a2 = last ? nA : cA + (size_t)(t + 2) * kstep; const char* b2 = last ? nB : cB + (size_t)(t + 2) * kstep;
            const char* a3 = a2 + kstep; const char* b3 = b2 + kstep;
            if (last && has_next) S.a_ready(nxt);
            if constexpr (SP2) {
            PG8_LDB(B0, 0, 0); PG8_LDB(B1, 0, 1); PG8_SCHED; PG8_LDA(At, 0, 0); PG8_STAGE(PG8_SA(1, 1), a1 + hstep, voffA);
            PG8_WAIT_V(8); PG8_WAIT_L(0); PG8_BAR; PG8_MMA(0, 0, At, B0); PG8_MMA(0, 1, At, B1); PG8_BAR; PG8_SCHED;
            PG8_LDA(At, 0, 1); PG8_STAGE(PG8_SB(0, 0), b2, voffB); PG8_STAGE(PG8_SB(0, 1), b2 + hstep, voffB); PG8_STAGE(PG8_SA(0, 0), a2, voffA);
            PG8_WAIT_V(8); PG8_WAIT_L(0); PG8_BAR; PG8_MMA(1, 0, At, B0); PG8_MMA(1, 1, At, B1); PG8_BAR; PG8_SCHED;
            PG8_LDB(B0, 1, 0); PG8_LDB(B1, 1, 1); PG8_SCHED; PG8_LDA(At, 1, 0); PG8_STAGE(PG8_SA(0, 1), a2 + hstep, voffA);
            PG8_WAIT_V(8); PG8_WAIT_L(0); PG8_BAR; PG8_MMA(0, 0, At, B0); PG8_MMA(0, 1, At, B1); PG8_BAR; PG8_SCHED;
            PG8_LDA(At, 1, 1); PG8_STAGE(PG8_SB(1, 0), b3, voffB); PG8_STAGE(PG8_SB(1, 1), b3 + hstep, voffB); PG8_STAGE(PG8_SA(1, 0), a3, voffA);
            PG8_WAIT_V(8); PG8_WAIT_L(0); PG8_BAR; PG8_MMA(1, 0, At, B0); PG8_MMA(1, 1, At, B1); PG8_BAR; PG8_SCHED;
            } else {
            PG8_LDB(B0, 0, 0); PG8_SCHED; PG8_LDA(At, 0, 0); PG8_STAGE(PG8_SA(1, 1), a1 + hstep, voffA);
            PG8_WAIT_L(8); PG8_BAR; PG8_WAIT_L(0); PG8_MMA(0, 0, At, B0); PG8_BAR; PG8_SCHED;
            PG8_LDB(B1, 0, 1); PG8_STAGE(PG8_SB(0, 0), b2, voffB);
            PG8_BAR; PG8_WAIT_L(0); PG8_MMA(0, 1, At, B1); PG8_BAR;
            PG8_LDA(At, 0, 1); PG8_STAGE(PG8_SA(0, 0), a2, voffA);
            PG8_BAR; PG8_WAIT_L(0); PG8_MMA(1, 0, At, B0); PG8_BAR; PG8_SCHED;
            PG8_STAGE(PG8_SB(0, 1), b2 + hstep, voffB);
            PG8_WAIT_V(6); PG8_BAR; PG8_MMA(1, 1, At, B1); PG8_BAR;
            PG8_LDB(B0, 1, 0); PG8_SCHED; PG8_LDA(At, 1, 0); PG8_STAGE(PG8_SA(0, 1), a2 + hstep, voffA);
            PG8_WAIT_L(8); PG8_BAR; PG8_WAIT_L(0); PG8_MMA(0, 0, At, B0); PG8_BAR; PG8_SCHED;
            PG8_LDB(B1, 1, 1); PG8_STAGE(PG8_SB(1, 0), b3, voffB);
            PG8_BAR; PG8_WAIT_L(0); PG8_MMA(0, 1, At, B1); PG8_BAR;
            PG8_LDA(At, 1, 1); PG8_STAGE(PG8_SA(1, 0), a3, voffA);
            PG8_BAR; PG8_WAIT_L(0); PG8_MMA(1, 0, At, B0); PG8_BAR; PG8_SCHED;
            PG8_STAGE(PG8_SB(1, 1), b3 + hstep, voffB);
            PG8_WAIT_V(6); PG8_BAR; PG8_MMA(1, 1, At, B1); PG8_BAR;
            }
        }
        if constexpr (ALIGN_EPI) { if (wr == 0) PG8_BAR; }
        if constexpr (FP8) asm volatile("s_nop 15\n\ts_nop 15" ::: "memory");
        if constexpr (!Epi::AFTER_DRAIN) { E(acc, cur, wr, wc, fr, fq); S.done(cur); }
        if (!has_next) break;
#pragma unroll
        for (int a = 0; a < 2; ++a)
#pragma unroll
            for (int b = 0; b < 2; ++b)
#pragma unroll
                for (int m = 0; m < 4; ++m)
#pragma unroll
                    for (int n = 0; n < 2; ++n) acc[a][b][m][n] = (f32x4){0.f, 0.f, 0.f, 0.f};
        cur = nxt; cA = nA; cB = nB; ++ui;
        if constexpr (ALIGN_EPI) { if (wr == 1) PG8_BAR; }
    }
    PG8_WAIT_V(0);
    if constexpr (!ALIGN_EPI) { if (wr == 0) PG8_BAR; }
    PG8_BAR;
    if constexpr (Epi::AFTER_DRAIN) { E.fused(acc, cur, wr, wc, fr, fq, lds, wid, lane); S.done(cur); }
#undef PG8_SA
#undef PG8_SB
#undef PG8_STAGE
#undef PG8_LDA
#undef PG8_LDB
#undef PG8_MMA
#undef PG8_WAIT_V
#undef PG8_WAIT_L
#undef PG8_BAR
#undef PG8_SCHED
}
}

#ifndef PG8_SP2
#define PG8_SP2 true
#endif
#include <hip/hip_bf16.h>
#include <cmath>
namespace attn_body {
using bf16=__hip_bfloat16;
using bf16x8=__attribute__((ext_vector_type(8)))short;
using s16x4=__attribute__((ext_vector_type(4)))short;
using f32x16=__attribute__((ext_vector_type(16)))float;
using u32x4=__attribute__((ext_vector_type(4)))unsigned;
constexpr int BATCH=2,NHEAD=16,SEQ=16384,D=64,DM=2048;
constexpr int NW=8,QBLK=32,QB=QBLK*NW,KVBLK=64,NQB=SEQ/QB;
constexpr int ATTN_PITCH=DM, ATTN_UNIT_ROWS=QB;
__device__ __forceinline__ int crow(int r,int hi){return (r&3)+8*(r>>2)+4*hi;}
#define SBAR() __builtin_amdgcn_sched_barrier(0)
__device__ __forceinline__ void cmask(f32x16&p0,f32x16&p1,int jb,int qrel,int hi){
  const float NEG=-INFINITY; int kb=64*jb+4*hi;
  #pragma unroll
  for(int r=0;r<16;++r){int kv=kb+(r&3)+8*(r>>2); if(kv>qrel)p0[r]=NEG; if(kv+32>qrel)p1[r]=NEG;}
}

constexpr int NSLOT=3, SLOTB=8192;
constexpr int LDS_K=0, LDS_V=NSLOT*SLOTB, LDS_WS=2*NSLOT*SLOTB, LDS_OST=LDS_WS+NW*64*4, LDS_BYTES=LDS_OST+NW*4096;
constexpr int ATTN_PARAM_OFF=131072+2048;
constexpr float C2=0.125f*1.4426950408889634f;
__device__ __forceinline__ void glds16(const void*gsrc,unsigned lds_dst){unsigned keep;
  asm volatile("s_mov_b32 %0, m0\n\ts_mov_b32 m0, %2\n\ts_nop 0\n\tglobal_load_lds_dwordx4 %1, off\n\ts_mov_b32 m0, %0":"=&s"(keep):"v"(gsrc),"s"(lds_dst):"memory");}
__device__ __forceinline__ float max3f(float a,float b,float c){float r;asm("v_max3_f32 %0, %1, %2, %3":"=v"(r):"v"(a),"v"(b),"v"(c));return r;}
__device__ __forceinline__ float max2f(float a,float b){float r;asm("v_max_f32_e32 %0, %1, %2":"=v"(r):"v"(a),"v"(b));return r;}
__device__ __forceinline__ float fadd_s(float a,float b){float r;asm("v_add_f32_e32 %0, %1, %2":"=v"(r):"v"(a),"v"(b));return r;}
__device__ __forceinline__ float fsub_s(float a,float b){float r;asm("v_sub_f32_e32 %0, %1, %2":"=v"(r):"v"(a),"v"(b));return r;}
typedef float f32x2_t __attribute__((ext_vector_type(2))); typedef __bf16 bf16x2_t __attribute__((ext_vector_type(2)));
__device__ __forceinline__ unsigned cvtpk_s(float lo,float hi){f32x2_t v={lo,hi};bf16x2_t b=__builtin_convertvector(v,bf16x2_t);return __builtin_bit_cast(unsigned,b);}
__device__ __forceinline__ void glds16s(const void*sbase,unsigned voff,unsigned lds_dst){unsigned keep;
  asm volatile("s_mov_b32 %0, m0\n\ts_mov_b32 m0, %2\n\ts_nop 0\n\tglobal_load_lds_dwordx4 %1, %3\n\ts_mov_b32 m0, %0":"=&s"(keep):"v"(voff),"s"(lds_dst),"s"(sbase):"memory");}
#define WAIT_BAR(N) asm volatile("s_waitcnt vmcnt(" #N ") lgkmcnt(0)\n\ts_barrier":::"memory")

__device__ __forceinline__ void qkt(f32x16&p0,f32x16&p1,const char*Kslot,const bf16x8*qr,const f32x16&negm,int r32,int hi){
  const char*kb=Kslot+hi*1024+r32*16;
  #pragma unroll
  for(int d0=0;d0<4;++d0){
    const bf16x8 b0=*reinterpret_cast<const bf16x8*>(kb+d0*2048);
    const bf16x8 b1=*reinterpret_cast<const bf16x8*>(kb+d0*2048+512);
    if(d0==0){p0=__builtin_amdgcn_mfma_f32_32x32x16_bf16(b0,qr[0],negm,0,0,0);p1=__builtin_amdgcn_mfma_f32_32x32x16_bf16(b1,qr[0],negm,0,0,0);}
    else{p0=__builtin_amdgcn_mfma_f32_32x32x16_bf16(b0,qr[d0],p0,0,0,0);p1=__builtin_amdgcn_mfma_f32_32x32x16_bf16(b1,qr[d0],p1,0,0,0);}}
}
typedef __attribute__((address_space(3))) const char* lds_cptr;
typedef short v4i16_t __attribute__((ext_vector_type(4)));
__device__ __forceinline__ void kload8(bf16x8*kf,lds_cptr kp){
  kf[0]=*(const __attribute__((address_space(3))) bf16x8*)(kp);      kf[1]=*(const __attribute__((address_space(3))) bf16x8*)(kp+512);
  kf[2]=*(const __attribute__((address_space(3))) bf16x8*)(kp+2048); kf[3]=*(const __attribute__((address_space(3))) bf16x8*)(kp+2560);
  kf[4]=*(const __attribute__((address_space(3))) bf16x8*)(kp+4096); kf[5]=*(const __attribute__((address_space(3))) bf16x8*)(kp+4608);
  kf[6]=*(const __attribute__((address_space(3))) bf16x8*)(kp+6144); kf[7]=*(const __attribute__((address_space(3))) bf16x8*)(kp+6656);
}
__device__ __forceinline__ void kload2(bf16x8*kf,lds_cptr kp,int j){ kf[2*j]=*(const __attribute__((address_space(3))) bf16x8*)(kp+j*2048); kf[2*j+1]=*(const __attribute__((address_space(3))) bf16x8*)(kp+j*2048+512); }
__device__ __forceinline__ s16x4 vtr(lds_cptr p){ return __builtin_bit_cast(s16x4,__builtin_amdgcn_ds_read_tr16_b64_v4i16((__attribute__((address_space(3))) v4i16_t*)p)); }
__device__ __forceinline__ float rowmax(const f32x16&p0,const f32x16&p1){
  float a=max3f(p0[0],p0[1],p1[0]),b=max3f(p0[2],p0[3],p1[1]);a=max3f(a,p1[2],p1[3]);
  #pragma unroll
  for(int r=4;r<16;r+=4){a=max3f(a,p0[r],p0[r+1]);b=max3f(b,p0[r+2],p0[r+3]);a=max3f(a,p1[r],p1[r+1]);b=max3f(b,p1[r+2],p1[r+3]);}
  const float m=max2f(a,b);
  auto rr=__builtin_amdgcn_permlane32_swap(__float_as_uint(m),__float_as_uint(m),false,false);
  return max2f(__uint_as_float(rr[0]),__uint_as_float(rr[1]));
}
typedef int v8i_a __attribute__((ext_vector_type(8))); typedef int v4i_a __attribute__((ext_vector_type(4)));
#define MFMA8(ACC,A,B) asm volatile("s_nop 1\n\tv_mfma_scale_f32_32x32x64_f8f6f4 %0, %1, %2, %0, %3, %3 op_sel_hi:[0,0,0]":"+v"(ACC):"v"(A),"v"(B),"v"(sc8_))
#ifndef ATTN_STORE16
#define ATTN_STORE16(p,v) (*(u32x4*)(p)=(v))
#endif
template<int THRL,bool TRAIL> __device__ __forceinline__ void attn_unit(int b,int h,int qb,const unsigned char*Q,const unsigned char*__restrict__ K,const unsigned char*__restrict__ VT,bf16*O,char*shm){
  int tid_=threadIdx.x; asm volatile("":"+v"(tid_)); const int tid=tid_,lane=tid&63,r32=lane&31,hi=lane>>5; const int wid=__builtin_amdgcn_readfirstlane(tid>>6);
  const long rowbase=(long)b*SEQ; const int q0=qb*QB;
  const unsigned char*Qw=Q+(rowbase+q0+wid*QBLK)*DM+h*D;
  const unsigned char*Kh=K+rowbase*DM+h*D;
  const unsigned lds0=(unsigned)(uintptr_t)shm;
  float*wsf=(float*)(shm+LDS_WS)+wid*64;
  const int krow_=8*wid+((lane&31)>>2); const unsigned koff=(unsigned)(krow_*DM+(((lane&3)^((krow_>>2)&3))*16));
  const int vrow_=16*wid+(lane>>2); const unsigned voff=(unsigned)(vrow_*SEQ+(((lane&3)^((vrow_>>2)&3))*16));
  const unsigned kdst=lds0+LDS_K+wid*512, vdst=lds0+LDS_V+wid*1024;
  #define DMA_K(t,slot) do{ if(lane<32) glds16s(Kh+(long)(t)*KVBLK*DM,koff,(unsigned)__builtin_amdgcn_readfirstlane(kdst+(slot))); }while(0)
  #define DMA_V(t,slot) glds16s(VT+(long)(t)*KVBLK,voff,(unsigned)__builtin_amdgcn_readfirstlane(vdst+(slot)))
  int sc8_=0x7F7F7F7F; asm volatile("":"+v"(sc8_));
  v8i_a kf0,kf1;
  const lds_cptr shm3=(lds_cptr)shm; const lds_cptr kpa=shm3+LDS_K+r32*64+(((2*hi)^((r32>>2)&3))*16), kpb=shm3+LDS_K+r32*64+(((2*hi+1)^((r32>>2)&3))*16); const lds_cptr vpa=shm3+LDS_V+r32*64+(((2*hi)^((r32>>2)&3))*16), vpb=shm3+LDS_V+r32*64+(((2*hi+1)^((r32>>2)&3))*16);
  const int NT=(q0+QB)/KVBLK;
  DMA_K(0,0);DMA_V(0,0);DMA_K(1,SLOTB);
  v8i_a qf; { const v4i_a a_=*reinterpret_cast<const v4i_a*>(Qw+(long)r32*DM+32*hi), b_=*reinterpret_cast<const v4i_a*>(Qw+(long)r32*DM+32*hi+16); qf=__builtin_shufflevector(a_,b_,0,1,2,3,4,5,6,7); }
  #define KLD(KF,n,SL) do{ const v4i_a a_=*(const __attribute__((address_space(3))) v4i_a*)(kpa+(SL)+(n)*2048), b_=*(const __attribute__((address_space(3))) v4i_a*)(kpb+(SL)+(n)*2048); KF=__builtin_shufflevector(a_,b_,0,1,2,3,4,5,6,7); }while(0)
  #define QK8(DD,KF) asm volatile("s_nop 1\n\tv_mfma_scale_f32_32x32x64_f8f6f4 %0, %1, %2, %3, %4, %4 op_sel_hi:[0,0,0]":"=&v"(DD):"v"(KF),"v"(qf),"v"(negm),"v"(sc8_))
  float mhat=0.f; float z_=0.f; asm volatile("":"+v"(z_)); const f32x16 zv_={z_,z_,z_,z_,z_,z_,z_,z_,z_,z_,z_,z_,z_,z_,z_,z_};     f32x16 o[4];o[0]=zv_;o[1]=zv_;o[2]=zv_;o[3]=zv_;f32x16 negm=zv_;asm volatile("":"+v"(negm)); f32x16 osum=zv_;
  int one8_=0x38383838; asm volatile("":"+v"(one8_)); const v8i_a onesv={one8_,one8_,one8_,one8_,one8_,one8_,one8_,one8_};
  const int qrel=wid*QBLK+r32;
  #define CMASK(P0,P1,t) do{int jb_=(t)-(NT-4); if(jb_>=0)cmask(P0,P1,jb_,qrel,hi);}while(0)
  bool resc=false;
  #define START(P0,P1) do{ const float rm=rowmax(P0,P1); resc=false; \
    { const float dl=rm; mhat=fadd_s(mhat,dl); \
      _Pragma("unroll") for(int r=0;r<16;++r){P0[r]=fsub_s(P0[r],dl);P1[r]=fsub_s(P1[r],dl);} \
      _Pragma("unroll") for(int r=0;r<16;++r)negm[r]=-mhat; asm volatile("":"+v"(negm)); } \
    _Pragma("unroll") for(int r=0;r<16;++r)P0[r]=__builtin_amdgcn_exp2f(P0[r]); }while(0)
  #define RESC() do{ if(resc){ asm volatile("s_waitcnt lgkmcnt(0)\n\ts_nop 15\n\ts_nop 15":::"memory"); \
      _Pragma("unroll") for(int r=0;r<16;++r){const float f_=wsf[crow(r,hi)]; o[0][r]*=f_;o[1][r]*=f_;o[2][r]*=f_;o[3][r]*=f_;osum[r]*=f_;} } }while(0)
  f32x16 pA0,pA1,pB0,pB1;
  int sl_prev=0,sl_cur=0,sl_next=SLOTB;
  #define ROT() do{sl_prev=sl_cur;sl_cur=sl_next;sl_next=(sl_next==(NSLOT-1)*SLOTB)?0:sl_next+SLOTB;}while(0)
  DMA_K(2,2*SLOTB);
  WAIT_BAR(4);
  KLD(kf0,0,0); KLD(kf1,1,0); QK8(pA0,kf0); QK8(pA1,kf1); asm volatile("s_nop 15\n\ts_nop 15":"+v"(pA0),"+v"(pA1));CMASK(pA0,pA1,0);
  START(pA0,pA1);
  _Pragma("unroll") for(int r=0;r<8;++r)pA1[r]=__builtin_amdgcn_exp2f(pA1[r]);
  WAIT_BAR(0);
  DMA_K(3,0);DMA_V(1,SLOTB);
  ROT();
  KLD(kf0,0,sl_cur); KLD(kf1,1,sl_cur);
  WAIT_BAR(2);
  v8i_a pfv=onesv, vf0, vf1, vf2, vf3;
  #define KEEP(x) asm volatile(""::"v"(x))
  #define PKF(i,P,B) do{ int w_=__builtin_amdgcn_cvt_pk_fp8_f32(P[B],P[B+1],pfv[i],false); pfv[i]=__builtin_amdgcn_cvt_pk_fp8_f32(P[B+2],P[B+3],w_,true); }while(0)
  #define PIN(x) asm volatile("":"+v"(x))
  #define MX3(a,b,c) __builtin_fmaxf(__builtin_fmaxf((a),(b)),(c))
  #define GAPA(MF,A0,A1,A2,A3,PK) do{ MF; PK; SBAR(); }while(0)
  #define EX(v) __builtin_amdgcn_exp2f(v)
  #define EX8(X,B) do{ X[B]=EX(X[B]); X[B+1]=EX(X[B+1]); X[B+2]=EX(X[B+2]); X[B+3]=EX(X[B+3]); X[B+4]=EX(X[B+4]); X[B+5]=EX(X[B+5]); X[B+6]=EX(X[B+6]); X[B+7]=EX(X[B+7]); PIN(X); }while(0)
  #define VLD(VF,db) do{ const v4i_a a_=*(const __attribute__((address_space(3))) v4i_a*)(vp_a_+(db)*2048), b_=*(const __attribute__((address_space(3))) v4i_a*)(vp_b_+(db)*2048); VF=__builtin_shufflevector(a_,b_,0,1,2,3,4,5,6,7); }while(0)
  #define KRDP(G,KF,n) do{ if(G){ KLD(KF,n,sl_next); } }while(0)
  #define SEC_A(C0,C1,P0,P1,VL) do{ \
    PKF(0,P0,0); PKF(1,P0,4); PKF(2,P0,8); PKF(3,P0,12); PKF(4,P1,0); PKF(5,P1,4); \
    QK8(C0,kf0); SBAR(); \
    if(VL){ VLD(vf0,0); KEEP(kf0); SBAR(); } \
    QK8(C1,kf1); EX8(P1,8); PKF(6,P1,8); PKF(7,P1,12); SBAR(); \
    PIN(pfv); asm volatile("s_nop 7":"+v"(C0),"+v"(C1)); }while(0)
  #define SEC_DMA(t,GK,GV) do{ if(GK){DMA_K((t)+3,sl_cur);} if(GV){DMA_V((t)+1,sl_next);} }while(0)
  #define SEC_MAX(C0,C1) do{ float a=MX3(C0[0],C0[1],C1[0]),b=MX3(C0[2],C0[3],C1[1]); a=MX3(a,C1[2],C1[3]); \
      _Pragma("unroll") for(int r=4;r<16;r+=4){a=MX3(a,C0[r],C0[r+1]);b=MX3(b,C0[r+2],C0[r+3]);a=MX3(a,C1[r],C1[r+1]);b=MX3(b,C1[r+2],C1[r+3]);} \
      float rm=__builtin_fmaxf(a,b); { auto rr=__builtin_amdgcn_permlane32_swap(__float_as_uint(rm),__float_as_uint(rm),false,false); rm=__builtin_fmaxf(__uint_as_float(rr[0]),__uint_as_float(rr[1])); } \
      resc=false; \
      if(__builtin_expect(__any(rm>(float)THRL),0)){ const float dl=__builtin_fmaxf(rm,0.f); mhat+=dl; \
        _Pragma("unroll") for(int r=0;r<16;++r){C0[r]-=dl;C1[r]-=dl;} \
        _Pragma("unroll") for(int r=0;r<16;++r)negm[r]=-mhat; asm volatile("":"+v"(negm)); \
        const float f=__builtin_amdgcn_exp2f(-dl); if(hi==0)wsf[r32]=f; resc=true; } }while(0)
  #define SEC_B(C0,C1,GL) do{ \
    VLD(vf1,1); SBAR(); MFMA8(o[0],pfv,vf0); KRDP(GL,kf0,0); KEEP(vf0); EX8(C0,0); SBAR(); \
    VLD(vf2,2); KEEP(vf0); SBAR(); MFMA8(o[1],pfv,vf1); KRDP(GL,kf1,1); KEEP(vf1); EX8(C0,8); SBAR(); \
    VLD(vf3,3); KEEP(vf1); SBAR(); MFMA8(o[2],pfv,vf2); EX8(C1,0); SBAR(); \
    MFMA8(o[3],pfv,vf3); SBAR(); \
    MFMA8(osum,pfv,onesv); SBAR(); }while(0)
  #define STEP(C0,C1,P0,P1,t,GK,GV,GL) do{ SBAR(); \
    const lds_cptr vp_a_=vpa+sl_prev, vp_b_=vpb+sl_prev; \
    SEC_A(C0,C1,P0,P1,true); \
    SEC_DMA(t,GK,GV); \
    CMASK(C0,C1,t); \
    SEC_MAX(C0,C1); \
    SBAR(); \
    SEC_B(C0,C1,GL); \
    }while(0)
  #define STEP_T(C0,C1,N0,N1,t,GK,GV,GL,GA) do{ SBAR(); \
    const lds_cptr vp_a_=vpa+sl_prev, vp_b_=vpb+sl_prev; \
    SEC_DMA(t,GK,GV); \
    VLD(vf0,0); SBAR(); \
    SEC_MAX(C0,C1); \
    SBAR(); \
    SEC_B(C0,C1,GL); \
    if(GA){ SEC_A(N0,N1,C0,C1,false); CMASK(N0,N1,(t)+1); } \
    }while(0)
  int t=1;
  constexpr bool trail_=TRAIL;
  if constexpr(trail_){ const lds_cptr vp_a_=vpa, vp_b_=vpb; SEC_A(pB0,pB1,pA0,pA1,false); CMASK(pB0,pB1,1); }
  #undef CMASK
  #define CMASK(P0,P1,t) do{}while(0)
  if constexpr(!trail_){
    for(;t+5<NT;t+=2){
      STEP(pB0,pB1,pA0,pA1,t,true,true,true);     WAIT_BAR(2); RESC(); ROT();
      STEP(pA0,pA1,pB0,pB1,t+1,true,true,true);   WAIT_BAR(2); RESC(); ROT();
    }
  } else {
    for(;t+5<NT;t+=2){
      STEP_T(pB0,pB1,pA0,pA1,t,true,true,true,true);     WAIT_BAR(2); RESC(); ROT();
      STEP_T(pA0,pA1,pB0,pB1,t+1,true,true,true,true);   WAIT_BAR(2); RESC(); ROT();
    }
  }
  #undef CMASK
  #define CMASK(P0,P1,t) do{int jb_=(t)-(NT-4); if(jb_>=0)cmask(P0,P1,jb_,qrel,hi);}while(0)
  #define ENDW(tt) do{ if((tt)+3<NT){WAIT_BAR(2);} else if((tt)+2<NT){WAIT_BAR(1);} else {WAIT_BAR(0);} }while(0)
  if constexpr(!trail_){
    for(;t+1<NT;t+=2){
      STEP(pB0,pB1,pA0,pA1,t,(t+3<NT),(t+1<NT),(t+1<NT));       ENDW(t);   RESC(); ROT();
      STEP(pA0,pA1,pB0,pB1,t+1,(t+4<NT),(t+2<NT),(t+2<NT));     ENDW(t+1); RESC(); ROT();
    }
    STEP(pB0,pB1,pA0,pA1,NT-1,false,false,false); RESC();
  } else {
    for(;t+1<NT;t+=2){
      STEP_T(pB0,pB1,pA0,pA1,t,(t+3<NT),(t+1<NT),(t+1<NT),true);       ENDW(t);   RESC(); ROT();
      STEP_T(pA0,pA1,pB0,pB1,t+1,(t+4<NT),(t+2<NT),(t+2<NT),true);     ENDW(t+1); RESC(); ROT();
    }
    STEP_T(pB0,pB1,pA0,pA1,NT-1,false,false,false,false); RESC();
  }
  {
    EX8(pB1,8); PKF(0,pB0,0);PKF(1,pB0,4);PKF(2,pB0,8);PKF(3,pB0,12);PKF(4,pB1,0);PKF(5,pB1,4);PKF(6,pB1,8);PKF(7,pB1,12); PIN(pfv);
    const lds_cptr vp_a_=vpa+sl_cur, vp_b_=vpb+sl_cur;
    VLD(vf0,0); VLD(vf1,1); VLD(vf2,2); VLD(vf3,3); SBAR(); MFMA8(o[0],pfv,vf0); MFMA8(o[1],pfv,vf1); MFMA8(o[2],pfv,vf2); MFMA8(o[3],pfv,vf3); MFMA8(osum,pfv,onesv); SBAR();
    asm volatile("s_nop 15\n\ts_nop 15\n\ts_nop 15\n\ts_nop 15\n\ts_nop 7":"+v"(o[0]),"+v"(o[1]),"+v"(o[2]),"+v"(o[3]),"+v"(osum)); }
  #undef PKF
  #undef EX8
  #undef VLD
  #undef PAF
  #undef VFR
  #undef PIN
  #undef MX3
  #undef GAPA
  #undef GAPB
  #undef EX
  #undef KRDP
  #undef KLD
  #undef QK8
  #undef KRD
  #undef STEP
  #undef STEP_T
  #undef SEC_A
  #undef KEEP
  #undef SEC_B
  #undef SEC_MAX
  #undef SEC_DMA
  #undef ENDW
  float rli[16];
  #pragma unroll
  for(int r=0;r<16;++r)rli[r]=__builtin_amdgcn_rcpf(osum[r]);
  bf16*Ow=O+(rowbase+q0+wid*QBLK)*DM+h*D;
  { bf16*stg=(bf16*)(shm+LDS_OST)+wid*2048;
    #pragma unroll
    for(int hh=0;hh<2;++hh){
    #pragma unroll
    for(int r=0;r<16;++r){const int orow=crow(r,hi);
      #pragma unroll
      for(int d0=0;d0<2;++d0)stg[orow*64+d0*32+r32]=__float2bfloat16(o[2*hh+d0][r]*rli[r]);}
    asm volatile("s_waitcnt lgkmcnt(0)":::"memory");
    #pragma unroll
    for(int i=0;i<4;++i){const int row=i*8+(lane>>3),ch=lane&7; const u32x4 v=*(const u32x4*)(stg+row*64+ch*8); ATTN_STORE16(Ow+(long)row*DM+hh*64+ch*8,v);}
    asm volatile("s_waitcnt lgkmcnt(0)":::"memory"); } }
  asm volatile("s_waitcnt lgkmcnt(0)\n\ts_barrier":::"memory");
  #undef DMA_K
  #undef DMA_V
  #undef CMASK
  #undef START
  #undef RESC
  #undef ROT
}
constexpr int ATTN_LDS_BYTES=LDS_BYTES;
struct AttnUnit { int b, h, c, qb; };
struct DiffOrder {
  int vcu;
  __device__ __forceinline__ explicit DiffOrder(int v):vcu(v){}
  __device__ __forceinline__ bool next(int i,AttnUnit&u)const{ if(i>=16)return false; const int r=i>>2,k=i&3,x=vcu>>5,loc=vcu&31,j=loc&15; const int bh=r*8+x;
    u.b=bh>>4; u.h=bh&15; u.c=loc>>4; const int pair=j+16*(k>>1); u.qb=(k&1)?63-pair:pair; return true; }
};
#undef SBAR
#undef WAIT_BAR
}
#define GAS __attribute__((address_space(1)))
#define LAS __attribute__((address_space(3)))
typedef unsigned short bf16;
typedef unsigned v4u __attribute__((ext_vector_type(4)));
typedef float f32x4 __attribute__((ext_vector_type(4)));
typedef short bf16x8 __attribute__((ext_vector_type(8)));
typedef GAS unsigned gu32;
typedef GAS unsigned long long gu64;
#define RLX_AGENT __ATOMIC_RELAXED, __HIP_MEMORY_SCOPE_AGENT
#define LDS_WAIT() asm volatile("s_waitcnt lgkmcnt(0)" ::: "memory")
#define VM_WAIT() asm volatile("s_waitcnt vmcnt(0)" ::: "memory")
__device__ __forceinline__ unsigned long long rt() { return __builtin_amdgcn_s_memrealtime(); }
__device__ __forceinline__ unsigned f2bf(float f) { unsigned u = __builtin_bit_cast(unsigned, f); return (u + 0x7fffu + ((u >> 16) & 1u)) >> 16; }
__device__ __forceinline__ unsigned pk2(float lo, float hi) { return f2bf(lo) | (f2bf(hi) << 16); }

#define XB_TMO      128
#define XB_XCNT(j)  (256  + 64 * (j))
#define XB_XSUB(j)  (1280 + 64 * (j))
#define XB_XGEN(j)  (2304 + 64 * (j))
#define XB_TOP      3328
#define XB_TOPGEN   3392
#define XCD_BAR_WORDS 3456
#define XB_SPIN_CAP (1u << 18)

__device__ __forceinline__ unsigned xb_ld(unsigned* p)              { return __hip_atomic_load(p, __ATOMIC_RELAXED, __HIP_MEMORY_SCOPE_AGENT); }
__device__ __forceinline__ unsigned xb_add(unsigned* p, unsigned v) { return __hip_atomic_fetch_add(p, v, __ATOMIC_RELAXED, __HIP_MEMORY_SCOPE_AGENT); }
__device__ __forceinline__ unsigned xb_xcc_id() { return (unsigned)__builtin_amdgcn_s_getreg((3 << 11) | 20) & 0xFu; }
#define XB_SPIN(cond, bar) do { unsigned _sp = 0; while (cond) { __builtin_amdgcn_s_sleep(1); \
    if ((++_sp & 255u) == 0u) { if (xb_ld(&(bar)[XB_TMO])) break; if (_sp > XB_SPIN_CAP) { atomicAdd(&(bar)[XB_TMO], 1u); break; } } } } while (0)

struct XcdBarrier {
    unsigned* bar; unsigned x;
    volatile LAS unsigned* st;
};

__device__ __forceinline__ XcdBarrier xcd_barrier_post(unsigned* bar, volatile LAS unsigned* st) {
    XcdBarrier b; b.bar = bar; b.x = xb_xcc_id(); b.st = st;
    if (threadIdx.x == 0) (void)xb_add(&bar[XB_XCNT(b.x)], 1u);
    return b;
}
__device__ __forceinline__ void xcd_barrier_complete(unsigned* bar, unsigned x, unsigned& nloc, unsigned& nx) {
    const unsigned G = gridDim.x * gridDim.y * gridDim.z;
    unsigned sum, cnt, mine, sp = 0u;
    for (;;) {
        sum = 0u; cnt = 0u; mine = 0u;
#pragma unroll
        for (unsigned j = 0; j < 16; ++j) { const unsigned c = xb_ld(&bar[XB_XCNT(j)]); sum += c; cnt += (c > 0u) ? 1u : 0u; mine = (j == x) ? c : mine; }
        if (sum == G) break;
        __builtin_amdgcn_s_sleep(1);
        if ((++sp & 255u) == 0u) { if (xb_ld(&bar[XB_TMO])) break; if (sp > XB_SPIN_CAP) { atomicAdd(&bar[XB_TMO], 1u); break; } }
    }
    nloc = mine > 0u ? mine : 1u; nx = cnt > 0u ? cnt : 1u;
}

__device__ __forceinline__ void xcd_barrier(const XcdBarrier& b) {
    asm volatile("s_waitcnt vmcnt(0)" ::: "memory");
    __syncthreads();
    if (threadIdx.x == 0) {
        unsigned* bar = b.bar;
        __builtin_amdgcn_s_waitcnt(0);
        unsigned nloc = b.st[0], nx = b.st[1];
        if (nloc == 0u) { xcd_barrier_complete(bar, b.x, nloc, nx); b.st[0] = nloc; b.st[1] = nx; }
        const unsigned old = xb_add(&bar[XB_XSUB(b.x)], 1u);
        const unsigned gen = old / nloc;
        if (old + 1u == (gen + 1u) * nloc) {
            __builtin_amdgcn_fence(__ATOMIC_RELEASE, "agent");
            asm volatile("s_waitcnt vmcnt(0)" ::: "memory");
            const unsigned og = xb_add(&bar[XB_TOP], 1u);
            const unsigned tg = og / nx;
            if (og + 1u == (tg + 1u) * nx) xb_add(&bar[XB_TOPGEN], 1u);
            else XB_SPIN(xb_ld(&bar[XB_TOPGEN]) == tg, bar);
            __builtin_amdgcn_fence(__ATOMIC_ACQUIRE, "agent");
            xb_add(&bar[XB_XGEN(b.x)], 1u);
            asm volatile("s_waitcnt vmcnt(0)" ::: "memory");
        } else {
            XB_SPIN(xb_ld(&bar[XB_XGEN(b.x)]) == gen, bar);
            __builtin_amdgcn_fence(__ATOMIC_ACQUIRE, "agent");
            asm volatile("s_waitcnt vmcnt(0)" ::: "memory");
        }
    }
    __syncthreads();
}
constexpr int NWAVES = 8;
constexpr int BATCH = 2, SEQ = 16384, D = 2048, M = BATCH * SEQ;
constexpr int ZW = 3072, PW = 1024, GW = 1024, FF = 5632, NE = 8, NQKV = 3 * D;
constexpr int CHUNK_TILES = 64, MAX_TILES = 264;
constexpr float EPS = 1e-5f;
constexpr float LAMBDA_INIT = 0.35550906759096927f;
constexpr size_t MiB = 1u << 20;
constexpr size_t WS_CTL = 0, CTL_ZERO_BYTES = 1 * MiB;
constexpr size_t WS_ROPE = 2 * MiB;
constexpr size_t WS_TOK = 10 * MiB;
constexpr size_t WS_WSP = 12 * MiB, WS_WPOOL = 12 * MiB + 512 * 1024;
constexpr size_t WS_WIN = 16 * MiB, WS_WOUT = 28 * MiB, WS_WGU = 36 * MiB, WS_WD = 80 * MiB, WS_WQKV = 102 * MiB, WS_WO = 126 * MiB, WS_WEGU = 134 * MiB, WS_WED = 486 * MiB;
constexpr size_t WS_XR = 320 * MiB;
constexpr size_t WS_A = 662 * MiB;
constexpr size_t WS_B = 790 * MiB;
constexpr size_t WS_Z = WS_B, WS_Y1 = WS_B + 192 * MiB, WS_ACT = WS_B;
constexpr size_t WS_Q = WS_B, WS_K = WS_B + 128 * MiB, WS_V = WS_B + 256 * MiB, WS_O0 = WS_B + 384 * MiB, WS_O1 = WS_B + 512 * MiB;
constexpr size_t WS_XP = WS_A, WS_YM = 794 * MiB, WS_ACTC = 1058 * MiB;
constexpr size_t WS_END = 1430 * MiB;
constexpr float W8_SCALE = 32.0f;
static_assert(WS_XP + (size_t)MAX_TILES * 256 * D <= WS_YM && WS_YM + (size_t)MAX_TILES * 256 * D * 2 <= WS_ACTC && WS_ACTC + (size_t)MAX_TILES * 256 * FF <= WS_END, "moe map");
static_assert(WS_ACT + (size_t)M * FF * 2 <= WS_END && WS_Y1 + (size_t)M * D * 2 <= WS_END && WS_WED + (size_t)NE * D * FF <= WS_A && WS_WEGU + (size_t)NE * 2 * FF * D <= WS_XR && WS_XR + (size_t)M * D * 2 <= WS_WED, "map");
constexpr int CW_TMO = 0, CW_CODE = 1, CW_BAR = 4096, CW_GCNT = 16384;
constexpr int RING_OFF = 0, RING_BYTES = 131072;
constexpr int LDSCTL_OFF = RING_BYTES, MISC_OFF = LDSCTL_OFF + 320;
constexpr int LDS_BYTES = 147456;
constexpr int LW_TS = 0, LW_SEG = 16, LW_TEXP = 128;
constexpr int LW_WSC = 48;
constexpr float XP_CLIP = 5.0f;
constexpr size_t WS_HSCALE = WS_TOK + 896 * 1024;

struct Frame {
    LAS unsigned char* lds;
    volatile LAS unsigned* MISC;
    gu32* ctl;
    int tid, lane, wave;
    int vcu, G;
};

__device__ __forceinline__ float wave_sum(float v) {
#pragma unroll
    for (int o = 1; o < 64; o <<= 1) v += __shfl_xor(v, o);
    return v;
}
__device__ __forceinline__ float bf2f(unsigned short b) { return __uint_as_float((unsigned)b << 16); }
__device__ __forceinline__ float bflo(unsigned w) { return __uint_as_float(w << 16); }
__device__ __forceinline__ float bfhi(unsigned w) { return __uint_as_float(w & 0xffff0000u); }

__device__ __forceinline__ int map_gate(int n) { return 256 * (n >> 7) + (n & 127); }
__device__ __forceinline__ int map_up(int n) { return 256 * (n >> 7) + 128 + (n & 127); }
__device__ __forceinline__ int map_qkv(int n) {
    if (n >= 2 * D) return n;
    const int sec = n / D, cs = n % D, tile = cs >> 8, hh = (cs & 255) >> 6, d = cs & 63;
    return sec * D + tile * 256 + (d >> 5) * 128 + hh * 32 + (d & 31);
}
template <int MODE, bool FP8> __device__ __forceinline__ void p0_matrix(const float* W, int K, int N, void* WTv, float scale, LAS float* scr, int lane, int it) {
    const int nblk = N / 64, kb = it / nblk, nb = it % nblk, k0 = 64 * kb, n0 = 64 * nb;
    f32x4 v[16];
#pragma unroll
    for (int i = 0; i < 16; ++i) v[i] = *(const GAS f32x4*)(W + (size_t)(k0 + 4 * i + (lane >> 4)) * N + n0 + 4 * (lane & 15));
#pragma unroll
    for (int i = 0; i < 16; ++i) { const int k = 4 * i + (lane >> 4); *(LAS f32x4*)(scr + k * 64 + ((4 * (lane & 15) + 4 * k) & 63)) = v[i]; }
    LDS_WAIT(); asm volatile("" ::: "memory");
    const int ns = n0 + (lane & 32); const int dr = (MODE == 0 ? ns : MODE == 1 ? map_gate(ns) : MODE == 2 ? map_up(ns) : map_qkv(ns)) + (lane & 31);
#define P0_EL(k) scr[(k) * 64 + ((lane + 4 * (k)) & 63)]
    if constexpr (FP8) { GAS v4u* dst = (GAS v4u*)((unsigned char*)WTv + (size_t)dr * K + k0);
#pragma unroll
        for (int c = 0; c < 4; ++c) { v4u o;
            o.x = pg8::pk_fp8x4(P0_EL(16 * c + 0) * scale, P0_EL(16 * c + 1) * scale, P0_EL(16 * c + 2) * scale, P0_EL(16 * c + 3) * scale);
            o.y = pg8::pk_fp8x4(P0_EL(16 * c + 4) * scale, P0_EL(16 * c + 5) * scale, P0_EL(16 * c + 6) * scale, P0_EL(16 * c + 7) * scale);
            o.z = pg8::pk_fp8x4(P0_EL(16 * c + 8) * scale, P0_EL(16 * c + 9) * scale, P0_EL(16 * c + 10) * scale, P0_EL(16 * c + 11) * scale);
            o.w = pg8::pk_fp8x4(P0_EL(16 * c + 12) * scale, P0_EL(16 * c + 13) * scale, P0_EL(16 * c + 14) * scale, P0_EL(16 * c + 15) * scale);
            dst[c] = o; }
    } else { GAS v4u* dst = (GAS v4u*)((bf16*)WTv + (size_t)dr * K + k0);
#pragma unroll
        for (int c = 0; c < 8; ++c) { v4u o; o.x = pk2(P0_EL(8 * c + 0), P0_EL(8 * c + 1)); o.y = pk2(P0_EL(8 * c + 2), P0_EL(8 * c + 3)); o.z = pk2(P0_EL(8 * c + 4), P0_EL(8 * c + 5)); o.w = pk2(P0_EL(8 * c + 6), P0_EL(8 * c + 7));
            dst[c] = o; }
    }
#undef P0_EL
    LDS_WAIT(); asm volatile("" ::: "memory");
}
template <int MODE> __device__ __forceinline__ void p0_matrix8w(const float* W, int K, int N, unsigned char* WT, float scale, LAS float* scr, int lane, int it) {
    const int nblk = N / 32, kb = it / nblk, nb = it % nblk, k0 = 128 * kb, n0 = 32 * nb;
    f32x4 v[16];
#pragma unroll
    for (int i = 0; i < 16; ++i) v[i] = *(const GAS f32x4*)(W + (size_t)(k0 + 8 * i + (lane >> 3)) * N + n0 + 4 * (lane & 7));
#pragma unroll
    for (int i = 0; i < 16; ++i) { const int k = 8 * i + (lane >> 3); *(LAS f32x4*)(scr + k * 32 + ((4 * (lane & 7) + 4 * k) & 31)) = v[i]; }
    LDS_WAIT(); asm volatile("" ::: "memory");
    const int n = lane & 31, kh = lane >> 5; const int dr = (MODE == 0 ? n0 : MODE == 1 ? map_gate(n0) : map_up(n0)) + n;
    GAS v4u* dst = (GAS v4u*)(WT + (size_t)dr * K + k0 + 64 * kh);
#define P0_EL(k) (scr[(64 * kh + (k)) * 32 + ((n + 4 * (64 * kh + (k))) & 31)] * scale)
#pragma unroll
    for (int c = 0; c < 4; ++c) { v4u o;
        o.x = pg8::pk_fp8x4(P0_EL(16 * c + 0), P0_EL(16 * c + 1), P0_EL(16 * c + 2), P0_EL(16 * c + 3)); o.y = pg8::pk_fp8x4(P0_EL(16 * c + 4), P0_EL(16 * c + 5), P0_EL(16 * c + 6), P0_EL(16 * c + 7));
        o.z = pg8::pk_fp8x4(P0_EL(16 * c + 8), P0_EL(16 * c + 9), P0_EL(16 * c + 10), P0_EL(16 * c + 11)); o.w = pg8::pk_fp8x4(P0_EL(16 * c + 12), P0_EL(16 * c + 13), P0_EL(16 * c + 14), P0_EL(16 * c + 15));
        dst[c] = o; }
#undef P0_EL
    LDS_WAIT(); asm volatile("" ::: "memory");
}
__device__ __forceinline__ unsigned pk_i8x4(float a, float b, float c, float d) {
    const int i0 = __float2int_rn(fminf(fmaxf(a, -127.f), 127.f)), i1 = __float2int_rn(fminf(fmaxf(b, -127.f), 127.f)), i2 = __float2int_rn(fminf(fmaxf(c, -127.f), 127.f)), i3 = __float2int_rn(fminf(fmaxf(d, -127.f), 127.f));
    return (unsigned)(i0 & 255) | ((unsigned)(i1 & 255) << 8) | ((unsigned)(i2 & 255) << 16) | ((unsigned)i3 << 24);
}
template <int MODE> __device__ __forceinline__ void p0_matrix_i8w(const float* W, int K, int N, unsigned char* WT, float inv, LAS float* scr, int lane, int it) {
    const int nblk = N / 32, kb = it / nblk, nb = it % nblk, k0 = 128 * kb, n0 = 32 * nb;
    f32x4 v[16];
#pragma unroll
    for (int i = 0; i < 16; ++i) v[i] = *(const GAS f32x4*)(W + (size_t)(k0 + 8 * i + (lane >> 3)) * N + n0 + 4 * (lane & 7));
#pragma unroll
    for (int i = 0; i < 16; ++i) { const int k = 8 * i + (lane >> 3); *(LAS f32x4*)(scr + k * 32 + ((4 * (lane & 7) + 4 * k) & 31)) = v[i]; }
    LDS_WAIT(); asm volatile("" ::: "memory");
    const int n = lane & 31, kh = lane >> 5; const int dr = (MODE == 0 ? n0 : MODE == 1 ? map_gate(n0) : MODE == 2 ? map_up(n0) : map_qkv(n0)) + n;
    GAS v4u* dst = (GAS v4u*)(WT + (size_t)dr * K + k0 + 64 * kh);
#define P0_EL(k) (scr[(64 * kh + (k)) * 32 + ((n + 4 * (64 * kh + (k))) & 31)] * inv)
#pragma unroll
    for (int c = 0; c < 4; ++c) { v4u o;
        o.x = pk_i8x4(P0_EL(16 * c + 0), P0_EL(16 * c + 1), P0_EL(16 * c + 2), P0_EL(16 * c + 3)); o.y = pk_i8x4(P0_EL(16 * c + 4), P0_EL(16 * c + 5), P0_EL(16 * c + 6), P0_EL(16 * c + 7));
        o.z = pk_i8x4(P0_EL(16 * c + 8), P0_EL(16 * c + 9), P0_EL(16 * c + 10), P0_EL(16 * c + 11)); o.w = pk_i8x4(P0_EL(16 * c + 12), P0_EL(16 * c + 13), P0_EL(16 * c + 14), P0_EL(16 * c + 15));
        dst[c] = o; }
#undef P0_EL
    LDS_WAIT(); asm volatile("" ::: "memory");
}
__device__ __forceinline__ float rms_row_to_bf16(const float* xrow, const float* gain, bf16* orow, int lane) {
    const GAS f32x4* xr = (const GAS f32x4*)xrow + lane; const GAS f32x4* gr = (const GAS f32x4*)gain + lane;
    f32x4 v[8]; float s = 0.f;
#pragma unroll
    for (int j = 0; j < 8; ++j) { v[j] = xr[64 * j]; s += (v[j].x * v[j].x + v[j].y * v[j].y) + (v[j].z * v[j].z + v[j].w * v[j].w); }
    const float rstd = 1.f / sqrtf(wave_sum(s) * (1.f / D) + EPS);
    GAS unsigned long long* o8 = (GAS unsigned long long*)orow + lane;
#pragma unroll
    for (int j = 0; j < 8; ++j) { const f32x4 g = gr[64 * j];
        o8[64 * j] = (unsigned long long)pk2(v[j].x * rstd * g.x, v[j].y * rstd * g.y) | ((unsigned long long)pk2(v[j].z * rstd * g.z, v[j].w * rstd * g.w) << 32); }
    return rstd;
}
__device__ __forceinline__ void norm_phase(Frame& F, const float* x, const float* gain, bf16* out) {
    const int gw = F.vcu * NWAVES + F.wave, NGW = F.G * NWAVES, lane = F.lane;
    const GAS f32x4* gr = (const GAS f32x4*)gain + lane;
    f32x4 v[8], nx[8];
    if (gw < M) { const GAS f32x4* xr = (const GAS f32x4*)(x + (size_t)gw * D) + lane;
#pragma unroll
        for (int j = 0; j < 8; ++j) v[j] = xr[64 * j]; }
    for (int m = gw; m < M; m += NGW) {
        const int mn = (m + NGW < M) ? m + NGW : m; const GAS f32x4* xn = (const GAS f32x4*)(x + (size_t)mn * D) + lane;
#pragma unroll
        for (int j = 0; j < 8; ++j) nx[j] = xn[64 * j];
        float s = 0.f;
#pragma unroll
        for (int j = 0; j < 8; ++j) s += (v[j].x * v[j].x + v[j].y * v[j].y) + (v[j].z * v[j].z + v[j].w * v[j].w);
        const float rstd = 1.f / sqrtf(wave_sum(s) * (1.f / D) + EPS);
        GAS unsigned long long* o8 = (GAS unsigned long long*)(out + (size_t)m * D) + lane;
#pragma unroll
        for (int j = 0; j < 8; ++j) { const f32x4 g = gr[64 * j];
            o8[64 * j] = (unsigned long long)pk2(v[j].x * rstd * g.x, v[j].y * rstd * g.y) | ((unsigned long long)pk2(v[j].z * rstd * g.z, v[j].w * rstd * g.w) << 32); }
#pragma unroll
        for (int j = 0; j < 8; ++j) v[j] = nx[j];
    }
}
__device__ __forceinline__ void norm_phase_b(Frame& F, const bf16* x, const float* gain, bf16* out) {
    const int gw = F.vcu * NWAVES + F.wave, NGW = F.G * NWAVES, lane = F.lane;
    const GAS f32x4* gr = (const GAS f32x4*)gain + 2 * lane;
    v4u v[4], nx[4];
    if (gw < M) { const GAS v4u* xr = (const GAS v4u*)(x + (size_t)gw * D) + lane;
#pragma unroll
        for (int j = 0; j < 4; ++j) v[j] = xr[64 * j]; }
    for (int m = gw; m < M; m += NGW) {
        const int mn = (m + NGW < M) ? m + NGW : m; const GAS v4u* xn = (const GAS v4u*)(x + (size_t)mn * D) + lane;
#pragma unroll
        for (int j = 0; j < 4; ++j) nx[j] = xn[64 * j];
        float s = 0.f; f32x4 a[4][2];
#pragma unroll
        for (int j = 0; j < 4; ++j) { a[j][0] = pg8::bf4lo(v[j].x, v[j].y); a[j][1] = pg8::bf4lo(v[j].z, v[j].w);
            s += (a[j][0].x * a[j][0].x + a[j][0].y * a[j][0].y) + (a[j][0].z * a[j][0].z + a[j][0].w * a[j][0].w) + (a[j][1].x * a[j][1].x + a[j][1].y * a[j][1].y) + (a[j][1].z * a[j][1].z + a[j][1].w * a[j][1].w); }
        const float rstd = 1.f / sqrtf(wave_sum(s) * (1.f / D) + EPS);
        GAS v4u* o = (GAS v4u*)(out + (size_t)m * D) + lane;
#pragma unroll
        for (int j = 0; j < 4; ++j) { const f32x4 g0 = gr[128 * j], g1 = gr[128 * j + 1]; v4u w;
            w.x = pk2(a[j][0].x * rstd * g0.x, a[j][0].y * rstd * g0.y); w.y = pk2(a[j][0].z * rstd * g0.z, a[j][0].w * rstd * g0.w);
            w.z = pk2(a[j][1].x * rstd * g1.x, a[j][1].y * rstd * g1.y); w.w = pk2(a[j][1].z * rstd * g1.z, a[j][1].w * rstd * g1.w); o[64 * j] = w; }
#pragma unroll
        for (int j = 0; j < 4; ++j) v[j] = nx[j];
    }
}
__device__ __forceinline__ void norm_phase_qf(Frame& F, const float* x, const float* gain, unsigned char* out, float* rowscale) {
    const int gw = F.vcu * NWAVES + F.wave, NGW = F.G * NWAVES, lane = F.lane;
    const GAS f32x4* gr = (const GAS f32x4*)gain + lane;
    f32x4 v[8], nx[8];
    if (gw < M) { const GAS f32x4* xr = (const GAS f32x4*)(x + (size_t)gw * D) + lane;
#pragma unroll
        for (int j = 0; j < 8; ++j) v[j] = xr[64 * j]; }
    for (int m = gw; m < M; m += NGW) {
        const int mn = (m + NGW < M) ? m + NGW : m; const GAS f32x4* xn = (const GAS f32x4*)(x + (size_t)mn * D) + lane;
#pragma unroll
        for (int j = 0; j < 8; ++j) nx[j] = xn[64 * j];
        float s = 0.f;
#pragma unroll
        for (int j = 0; j < 8; ++j) s += (v[j].x * v[j].x + v[j].y * v[j].y) + (v[j].z * v[j].z + v[j].w * v[j].w);
        const float rstd = 1.f / sqrtf(wave_sum(s) * (1.f / D) + EPS);
        float amax = 0.f;
#pragma unroll
        for (int j = 0; j < 8; ++j) { const f32x4 g = gr[64 * j]; v[j] = (f32x4){v[j].x * rstd * g.x, v[j].y * rstd * g.y, v[j].z * rstd * g.z, v[j].w * rstd * g.w};
            amax = fmaxf(amax, fmaxf(fmaxf(fabsf(v[j].x), fabsf(v[j].y)), fmaxf(fabsf(v[j].z), fabsf(v[j].w)))); }
#pragma unroll
        for (int o = 1; o < 64; o <<= 1) amax = fmaxf(amax, __shfl_xor(amax, o));
        amax = fmaxf(amax, 1e-20f); const float inv = 127.0f / amax;
        GAS unsigned* o4 = (GAS unsigned*)(out + (size_t)m * D) + lane;
#pragma unroll
        for (int j = 0; j < 8; ++j) o4[64 * j] = pk_i8x4(v[j].x * inv, v[j].y * inv, v[j].z * inv, v[j].w * inv);
        if (lane == 0) rowscale[m] = amax * (1.0f / 127.0f);
#pragma unroll
        for (int j = 0; j < 8; ++j) v[j] = nx[j];
    }
}
typedef unsigned v2u_f __attribute__((ext_vector_type(2)));
__device__ __forceinline__ void norm_phase_q(Frame& F, const bf16* x, const float* gain, unsigned char* out, float* rowscale) {
    const int gw = F.vcu * NWAVES + F.wave, NGW = F.G * NWAVES, lane = F.lane;
    const GAS f32x4* gr = (const GAS f32x4*)gain + 2 * lane;
    v4u v[4], nx[4];
    if (gw < M) { const GAS v4u* xr = (const GAS v4u*)(x + (size_t)gw * D) + lane;
#pragma unroll
        for (int j = 0; j < 4; ++j) v[j] = xr[64 * j]; }
    for (int m = gw; m < M; m += NGW) {
        const int mn = (m + NGW < M) ? m + NGW : m; const GAS v4u* xn = (const GAS v4u*)(x + (size_t)mn * D) + lane;
#pragma unroll
        for (int j = 0; j < 4; ++j) nx[j] = xn[64 * j];
        float s = 0.f; f32x4 a[4][2];
#pragma unroll
        for (int j = 0; j < 4; ++j) { a[j][0] = pg8::bf4lo(v[j].x, v[j].y); a[j][1] = pg8::bf4lo(v[j].z, v[j].w);
            s += (a[j][0].x * a[j][0].x + a[j][0].y * a[j][0].y) + (a[j][0].z * a[j][0].z + a[j][0].w * a[j][0].w) + (a[j][1].x * a[j][1].x + a[j][1].y * a[j][1].y) + (a[j][1].z * a[j][1].z + a[j][1].w * a[j][1].w); }
        const float rstd = 1.f / sqrtf(wave_sum(s) * (1.f / D) + EPS);
        float amax = 0.f;
#pragma unroll
        for (int j = 0; j < 4; ++j)
#pragma unroll
            for (int q = 0; q < 2; ++q) { const f32x4 g = gr[128 * j + q]; a[j][q] = (f32x4){a[j][q].x * rstd * g.x, a[j][q].y * rstd * g.y, a[j][q].z * rstd * g.z, a[j][q].w * rstd * g.w};
                amax = fmaxf(amax, fmaxf(fmaxf(fabsf(a[j][q].x), fabsf(a[j][q].y)), fmaxf(fabsf(a[j][q].z), fabsf(a[j][q].w)))); }
#pragma unroll
        for (int o = 1; o < 64; o <<= 1) amax = fmaxf(amax, __shfl_xor(amax, o));
        amax = fmaxf(amax, 1e-20f); const float inv = 127.0f / amax;
        GAS v2u_f* o8 = (GAS v2u_f*)(out + (size_t)m * D) + lane;
#pragma unroll
        for (int j = 0; j < 4; ++j) { v2u_f w; w.x = pk_i8x4(a[j][0].x * inv, a[j][0].y * inv, a[j][0].z * inv, a[j][0].w * inv); w.y = pk_i8x4(a[j][1].x * inv, a[j][1].y * inv, a[j][1].z * inv, a[j][1].w * inv); o8[64 * j] = w; }
        if (lane == 0) rowscale[m] = amax * (1.0f / 127.0f);
#pragma unroll
        for (int j = 0; j < 4; ++j) v[j] = nx[j];
    }
}
struct P0Args { const float *w_in, *w_out, *w_gate, *w_up, *w_down, *w_qkv, *w_o, *w_pool, *we_gate, *we_up, *we_down, *w_spatial; const int* positions; const float* x; const float* norm_mix; };
__device__ __forceinline__ void p0_prologue(Frame& F, const P0Args& a, unsigned char* ws) {
    LAS float* scr = (LAS float*)(F.lds + RING_OFF + F.wave * 16384);
    const int gw = F.vcu * NWAVES + F.wave, NGW = F.G * NWAVES, lane = F.lane;
    norm_phase_qf(F, a.x, a.norm_mix, ws + WS_A, (float*)(ws + WS_HSCALE));
    constexpr int I_IN = (D / 64) * (ZW / 64), I_DD = (D / 64) * (D / 64), I_FF = (D / 64) * (FF / 64), I_QKV = (D / 64) * (NQKV / 64), I_POOL = 4 * 4;
    constexpr int N_DENSE = I_IN + I_DD + 3 * I_FF + I_QKV + I_DD + 4 * I_POOL, N_ALL = N_DENSE + NE * 3 * I_FF;
    { LAS float* red = (LAS float*)(F.lds + RING_OFF + 131072 - 256);     volatile LAS float* LWf = (volatile LAS float*)(F.lds + LDSCTL_OFF);
      float sg_ = 0.f, su_ = 0.f, sq_ = 0.f, so_ = 0.f, si_ = 0.f;
      for (int i = F.tid; i < 16384; i += 512) { const float g_ = a.w_gate[i], u_ = a.w_up[i], q_ = a.w_qkv[i], o_ = a.w_o[i], n_ = a.w_in[i]; sg_ += g_ * g_; su_ += u_ * u_; sq_ += q_ * q_; so_ += o_ * o_; si_ += n_ * n_; }
      sg_ = wave_sum(sg_); su_ = wave_sum(su_); sq_ = wave_sum(sq_); so_ = wave_sum(so_); si_ = wave_sum(si_);
      if (lane == 0) { red[4 * F.wave] = sg_; red[4 * F.wave + 1] = su_; red[4 * F.wave + 2] = sq_; red[4 * F.wave + 3] = so_; red[32 + F.wave] = si_; }
      __syncthreads();
      if (F.tid == 0) { float tg = 0.f, tu = 0.f, tq = 0.f, to = 0.f, ti = 0.f; for (int w_ = 0; w_ < NWAVES; ++w_) { tg += red[4 * w_]; tu += red[4 * w_ + 1]; tq += red[4 * w_ + 2]; to += red[4 * w_ + 3]; ti += red[32 + w_]; }
          LWf[LW_WSC + 20] = 4.0f * sqrtf(ti * (1.0f / 16384.0f)) * (1.0f / 127.0f);
          LWf[LW_WSC + 3] = 4.0f * sqrtf(to * (1.0f / 16384.0f)) * (1.0f / 127.0f);
          LWf[LW_WSC] = 4.0f * sqrtf(tg * (1.0f / 16384.0f)) * (1.0f / 127.0f); LWf[LW_WSC + 1] = 4.0f * sqrtf(tu * (1.0f / 16384.0f)) * (1.0f / 127.0f); LWf[LW_WSC + 2] = 4.0f * sqrtf(tq * (1.0f / 16384.0f)) * (1.0f / 127.0f); }
      __syncthreads();
      for (int e = 0; e < NE; ++e) { float eg = 0.f, eu = 0.f;
          for (int i = F.tid; i < 4096; i += 512) { const float g_ = a.we_gate[(size_t)e * D * FF + i], u_ = a.we_up[(size_t)e * D * FF + i]; eg += g_ * g_; eu += u_ * u_; }
          eg = wave_sum(eg); eu = wave_sum(eu);
          if (lane == 0) { red[2 * F.wave] = eg; red[2 * F.wave + 1] = eu; }
          __syncthreads();
          if (F.tid == 0) { float tg = 0.f, tu = 0.f; for (int w_ = 0; w_ < NWAVES; ++w_) { tg += red[2 * w_]; tu += red[2 * w_ + 1]; }
              LWf[LW_WSC + 4 + 2 * e] = 4.0f * sqrtf(tg * (1.0f / 4096.0f)) * (1.0f / 127.0f); LWf[LW_WSC + 5 + 2 * e] = 4.0f * sqrtf(tu * (1.0f / 4096.0f)) * (1.0f / 127.0f); }
          __syncthreads(); } }
    const float inv_g = 1.0f / ((volatile LAS float*)(F.lds + LDSCTL_OFF))[LW_WSC], inv_u = 1.0f / ((volatile LAS float*)(F.lds + LDSCTL_OFF))[LW_WSC + 1];
    const float inv_q = 1.0f / ((volatile LAS float*)(F.lds + LDSCTL_OFF))[LW_WSC + 2];
    const float inv_o = 1.0f / ((volatile LAS float*)(F.lds + LDSCTL_OFF))[LW_WSC + 3];
    const float inv_i = 1.0f / ((volatile LAS float*)(F.lds + LDSCTL_OFF))[LW_WSC + 20];
    for (int it = gw; it < N_ALL; it += NGW) {
        int r = it;
        if (r < I_IN) { p0_matrix_i8w<0>(a.w_in, D, ZW, ws + WS_WIN, inv_i, scr, lane, r); continue; } r -= I_IN;
        if (r < I_DD) { p0_matrix<0, false>(a.w_out, D, D, ws + WS_WOUT, 1.f, scr, lane, r); continue; } r -= I_DD;
        if (r < I_FF) { p0_matrix_i8w<1>(a.w_gate, D, FF, ws + WS_WGU, inv_g, scr, lane, r); continue; } r -= I_FF;
        if (r < I_FF) { p0_matrix_i8w<2>(a.w_up, D, FF, ws + WS_WGU, inv_u, scr, lane, r); continue; } r -= I_FF;
        if (r < I_FF) { p0_matrix8w<0>(a.w_down, FF, D, ws + WS_WD, W8_SCALE, scr, lane, r); continue; } r -= I_FF;
        if (r < I_QKV) { p0_matrix_i8w<3>(a.w_qkv, D, NQKV, ws + WS_WQKV, inv_q, scr, lane, r); continue; } r -= I_QKV;
        if (r < I_DD) { p0_matrix_i8w<0>(a.w_o, D, D, ws + WS_WO, inv_o, scr, lane, r); continue; } r -= I_DD;
        if (r < 4 * I_POOL) { const int g = r / I_POOL; p0_matrix<0, false>(a.w_pool + (size_t)g * 65536, 256, 256, ws + WS_WPOOL + (size_t)g * 65536 * 2, 1.f, scr, lane, r % I_POOL); continue; } r -= 4 * I_POOL;
        { constexpr int I8 = (D / 128) * (FF / 32); static_assert(I8 == I_FF && (FF / 128) * (D / 32) == I_FF, "same item count in both item shapes");
          const int e = r / (3 * I_FF), q = r % (3 * I_FF), which = q / I_FF, ii = q % I_FF;
          const volatile LAS float* wsc_ = (const volatile LAS float*)(F.lds + LDSCTL_OFF) + LW_WSC + 4;
          if (which == 0) p0_matrix_i8w<1>(a.we_gate + (size_t)e * D * FF, D, FF, ws + WS_WEGU + (size_t)e * 2 * FF * D, 1.0f / wsc_[2 * e], scr, lane, ii);
          else if (which == 1) p0_matrix_i8w<2>(a.we_up + (size_t)e * D * FF, D, FF, ws + WS_WEGU + (size_t)e * 2 * FF * D, 1.0f / wsc_[2 * e + 1], scr, lane, ii);
          else p0_matrix8w<0>(a.we_down + (size_t)e * FF * D, FF, D, ws + WS_WED + (size_t)e * D * FF, W8_SCALE, scr, lane, ii); }
    }
    { bf16* wsp = (bf16*)(ws + WS_WSP); const int gt = F.vcu * NWAVES * 64 + F.tid, NT = F.G * NWAVES * 64;
      for (int i = gt; i < 8 * 128 * 128; i += NT) { const int t = (i >> 7) & 127, s = i & 127; wsp[i] = (bf16)(s <= t ? f2bf(a.w_spatial[i]) : 0u); }
      float* rope = (float*)(ws + WS_ROPE);
      for (int i = gt; i < M * 32; i += NT) { const int r = i >> 5, k = i & 31;
          const float inv = exp2f(-(float)k * (13.287712379549449f / 32.0f)); const float ang = (float)a.positions[r] * inv;
          const double rev = (double)ang * 0.15915494309189535; const float fr = (float)(rev - rint(rev));
          rope[(size_t)r * 64 + k] = __builtin_amdgcn_cosf(fr); rope[(size_t)r * 64 + 32 + k] = __builtin_amdgcn_sinf(fr); } }
}

typedef unsigned v2u __attribute__((ext_vector_type(2)));
__device__ __forceinline__ void p2_mixer(Frame& F, const bf16* Z, bf16* Y, const bf16* WpT, const float* pscale, const bf16* Wsp, const float* bsp, const float* lng, const float* lnb) {
    constexpr int ZP = 136;
    LAS bf16* ZS = (LAS bf16*)(F.lds);
    LAS bf16* PL = (LAS bf16*)(F.lds + 144 * ZP * 2);
    LAS bf16* VT = (LAS bf16*)(F.lds);
    LAS float* ST = (LAS float*)(F.lds + 81920);
    const int tid = F.tid, lane = F.lane, w = F.wave, fr = lane & 15, fq = lane >> 4;
    for (int unit = F.vcu; unit < M / 128; unit += F.G) {
        const int r0 = unit * 128, tpos0 = r0 % SEQ; const bool first = tpos0 == 0;
        for (int g = 0; g < 4; ++g) {
            const int win = 2 << g;
            f32x4 acc[2][8];
#pragma unroll
            for (int a = 0; a < 2; ++a)
#pragma unroll
                for (int b = 0; b < 8; ++b) acc[a][b] = (f32x4){0.f, 0.f, 0.f, 0.f};
            for (int kh = 0; kh < 2; ++kh) {
                __syncthreads();
                for (int i = tid; i < 144 * 16; i += 512) { const int row = i >> 4, ch = i & 15; v4u v = (v4u){0u, 0u, 0u, 0u};
                    if (!(first && row < 16)) v = *(const GAS v4u*)(Z + (size_t)(r0 - 16 + row) * ZW + g * 256 + kh * 128 + ch * 8);
                    *(LAS v4u*)(ZS + row * ZP + ch * 8) = v; }
                __syncthreads();
                { const int ch = tid & 15, tq = tid >> 4;
#pragma unroll 1
                  for (int k = 0; k < 4; ++k) { const int t = tq + 32 * k; float s[8];
#pragma unroll
                      for (int j = 0; j < 8; ++j) s[j] = 0.f;
                      for (int j = 0; j < win; ++j) { const v4u v = *(const LAS v4u*)(ZS + (t + 16 - j) * ZP + ch * 8);
                          s[0] += bflo(v.x); s[1] += bfhi(v.x); s[2] += bflo(v.y); s[3] += bfhi(v.y); s[4] += bflo(v.z); s[5] += bfhi(v.z); s[6] += bflo(v.w); s[7] += bfhi(v.w); }
                      const v4u zc = *(const LAS v4u*)(ZS + (t + 16) * ZP + ch * 8); const int tp = tpos0 + t; const float inv = 1.0f / (float)(tp + 1 < win ? tp + 1 : win);
                      v4u o; o.x = pk2(s[0] * inv - bflo(zc.x), s[1] * inv - bfhi(zc.x)); o.y = pk2(s[2] * inv - bflo(zc.y), s[3] * inv - bfhi(zc.y));
                      o.z = pk2(s[4] * inv - bflo(zc.z), s[5] * inv - bfhi(zc.z)); o.w = pk2(s[6] * inv - bflo(zc.w), s[7] * inv - bfhi(zc.w));
                      *(LAS v4u*)(PL + t * ZP + ch * 8) = o; } }
                __syncthreads();
#pragma unroll 1
                for (int ks = 0; ks < 4; ++ks) { bf16x8 af[2];
#pragma unroll
                    for (int db = 0; db < 2; ++db) af[db] = *(const GAS bf16x8*)(WpT + ((size_t)g * 256 + 32 * w + 16 * db + fr) * 256 + kh * 128 + 32 * ks + 8 * fq);
#pragma unroll
                    for (int tb = 0; tb < 8; ++tb) { const bf16x8 bv = *(const LAS bf16x8*)(PL + (16 * tb + fr) * ZP + 32 * ks + 8 * fq);
#pragma unroll
                        for (int db = 0; db < 2; ++db) acc[db][tb] = __builtin_amdgcn_mfma_f32_16x16x32_bf16(af[db], bv, acc[db][tb], 0, 0, 0); } }
            }
#pragma unroll
            for (int db = 0; db < 2; ++db) { const int col = g * 256 + 32 * w + 16 * db + 4 * fq; const f32x4 sc = *(const GAS f32x4*)(pscale + col);
#pragma unroll
                for (int tb = 0; tb < 8; ++tb) { const f32x4 v = acc[db][tb] * sc; v2u o; o.x = pk2(v[0], v[1]); o.y = pk2(v[2], v[3]);
                    *(GAS v2u*)(Y + (size_t)(r0 + 16 * tb + fr) * D + col) = o; } }
        }
        __syncthreads();
        for (int k = 0; k < 16; ++k) { const int t = 16 * w + k; const GAS v4u* vr = (const GAS v4u*)(Z + (size_t)(r0 + t) * ZW + PW + GW) + lane; const v4u a = vr[0], b = vr[64];
            float x[16] = {bflo(a.x), bfhi(a.x), bflo(a.y), bfhi(a.y), bflo(a.z), bfhi(a.z), bflo(a.w), bfhi(a.w), bflo(b.x), bfhi(b.x), bflo(b.y), bfhi(b.y), bflo(b.z), bfhi(b.z), bflo(b.w), bfhi(b.w)};
            float s = 0.f;
#pragma unroll
            for (int j = 0; j < 16; ++j) s += x[j];
            const float mean = wave_sum(s) * (1.0f / GW); float q = 0.f;
#pragma unroll
            for (int j = 0; j < 16; ++j) { const float d = x[j] - mean; q += d * d; }
            const float rstd = 1.0f / sqrtf(wave_sum(q) * (1.0f / GW) + EPS);
            if (lane == 0) { ST[2 * t] = mean; ST[2 * t + 1] = rstd; } }
        __syncthreads();
        for (int g = 0; g < 8; ++g) {
#pragma unroll 1
            for (int k = 0; k < 4; ++k) { const int i = tid + 512 * k, s = i >> 4, ch = i & 15;
                const v4u v = *(const GAS v4u*)(Z + (size_t)(r0 + s) * ZW + PW + GW + g * 128 + ch * 8); const float mean = ST[2 * s], rstd = ST[2 * s + 1];
                const f32x4 g0 = *(const GAS f32x4*)(lng + g * 128 + ch * 8), g1 = *(const GAS f32x4*)(lng + g * 128 + ch * 8 + 4), b0 = *(const GAS f32x4*)(lnb + g * 128 + ch * 8), b1 = *(const GAS f32x4*)(lnb + g * 128 + ch * 8 + 4);
                LAS bf16* vt = VT + (ch * 8) * ZP + s;
                vt[0 * ZP] = (bf16)f2bf((bflo(v.x) - mean) * rstd * g0[0] + b0[0]); vt[1 * ZP] = (bf16)f2bf((bfhi(v.x) - mean) * rstd * g0[1] + b0[1]);
                vt[2 * ZP] = (bf16)f2bf((bflo(v.y) - mean) * rstd * g0[2] + b0[2]); vt[3 * ZP] = (bf16)f2bf((bfhi(v.y) - mean) * rstd * g0[3] + b0[3]);
                vt[4 * ZP] = (bf16)f2bf((bflo(v.z) - mean) * rstd * g1[0] + b1[0]); vt[5 * ZP] = (bf16)f2bf((bfhi(v.z) - mean) * rstd * g1[1] + b1[1]);
                vt[6 * ZP] = (bf16)f2bf((bflo(v.w) - mean) * rstd * g1[2] + b1[2]); vt[7 * ZP] = (bf16)f2bf((bfhi(v.w) - mean) * rstd * g1[3] + b1[3]); }
            __syncthreads();
            f32x4 acc[8];
#pragma unroll
            for (int b = 0; b < 8; ++b) acc[b] = (f32x4){0.f, 0.f, 0.f, 0.f};
            const int nks = (w >> 1) + 1;
#pragma unroll 1
            for (int ks = 0; ks < nks; ++ks) { const bf16x8 bw = *(const GAS bf16x8*)(Wsp + ((size_t)g * 128 + 16 * w + fr) * 128 + 32 * ks + 8 * fq);
#pragma unroll
                for (int cb = 0; cb < 8; ++cb) { const bf16x8 av = *(const LAS bf16x8*)(VT + (16 * cb + fr) * ZP + 32 * ks + 8 * fq);
                    acc[cb] = __builtin_amdgcn_mfma_f32_16x16x32_bf16(av, bw, acc[cb], 0, 0, 0); } }
            { const int t = 16 * w + fr; const float bias = bsp[g * 128 + t];
#pragma unroll
              for (int cb = 0; cb < 8; ++cb) { const int c = g * 128 + 16 * cb + 4 * fq; const v2u uu = *(const GAS v2u*)(Z + (size_t)(r0 + t) * ZW + PW + c);
                  v2u o; o.x = pk2(bflo(uu.x) * (acc[cb][0] + bias), bfhi(uu.x) * (acc[cb][1] + bias)); o.y = pk2(bflo(uu.y) * (acc[cb][2] + bias), bfhi(uu.y) * (acc[cb][3] + bias));
                  *(GAS v2u*)(Y + (size_t)(r0 + t) * D + PW + c) = o; } }
            __syncthreads();
        }
    }
}

__device__ __forceinline__ void p10_combine(Frame& F, const bf16* O0, const bf16* O1, unsigned char* O, float* rowscale, const float* lq1, const float* lk1, const float* lq2, const float* lk2, const float* subg) {
    const int gw = F.vcu * NWAVES + F.wave, NGW = F.G * NWAVES, lane = F.lane;
    const float s1 = wave_sum(lq1[lane] * lk1[lane]), s2 = wave_sum(lq2[lane] * lk2[lane]);
    const float lam = expf(s1) - expf(s2) + LAMBDA_INIT;
    const int e0 = (lane & 15) * 8;
    const f32x4 g0 = *(const GAS f32x4*)(subg + e0), g1 = *(const GAS f32x4*)(subg + e0 + 4);
    const float post = 1.0f - LAMBDA_INIT;
    for (int m = gw; m < M; m += NGW) {
        const GAS v4u* a = (const GAS v4u*)(O0 + (size_t)m * D) + lane; const GAS v4u* b = (const GAS v4u*)(O1 + (size_t)m * D) + lane; GAS v2u* o = (GAS v2u*)(O + (size_t)m * D) + lane;
        float val[4][8]; float amax = 0.f;
#pragma unroll
        for (int j = 0; j < 4; ++j) { const v4u x = a[64 * j], y = b[64 * j]; float d[8];
            d[0] = bflo(x.x) - lam * bflo(y.x); d[1] = bfhi(x.x) - lam * bfhi(y.x); d[2] = bflo(x.y) - lam * bflo(y.y); d[3] = bfhi(x.y) - lam * bfhi(y.y);
            d[4] = bflo(x.z) - lam * bflo(y.z); d[5] = bfhi(x.z) - lam * bfhi(y.z); d[6] = bflo(x.w) - lam * bflo(y.w); d[7] = bfhi(x.w) - lam * bfhi(y.w);
            float q = 0.f;
#pragma unroll
            for (int i = 0; i < 8; ++i) q += d[i] * d[i];
            q += __shfl_xor(q, 1); q += __shfl_xor(q, 2); q += __shfl_xor(q, 4); q += __shfl_xor(q, 8);
            const float r = post / sqrtf(q * (1.0f / 128.0f) + EPS);
            val[j][0] = d[0] * r * g0[0]; val[j][1] = d[1] * r * g0[1]; val[j][2] = d[2] * r * g0[2]; val[j][3] = d[3] * r * g0[3];
            val[j][4] = d[4] * r * g1[0]; val[j][5] = d[5] * r * g1[1]; val[j][6] = d[6] * r * g1[2]; val[j][7] = d[7] * r * g1[3];
#pragma unroll
            for (int i = 0; i < 8; ++i) amax = fmaxf(amax, fabsf(val[j][i])); }
#pragma unroll
        for (int sft = 1; sft < 64; sft <<= 1) amax = fmaxf(amax, __shfl_xor(amax, sft));
        amax = fmaxf(amax, 1e-20f); const float inv = 127.0f / amax;
#pragma unroll
        for (int j = 0; j < 4; ++j) { v2u w; w.x = pk_i8x4(val[j][0] * inv, val[j][1] * inv, val[j][2] * inv, val[j][3] * inv); w.y = pk_i8x4(val[j][4] * inv, val[j][5] * inv, val[j][6] * inv, val[j][7] * inv); o[64 * j] = w; }
        if (lane == 0) rowscale[m] = amax * (1.0f / 127.0f);
    }
}

__device__ __forceinline__ void p12a_route(Frame& F, const bf16* X, const float* gain, const float* wrt, unsigned char* ws) {
    LAS float* WR = (LAS float*)(F.lds);
    LAS int* SEL = (LAS int*)(F.lds + 65536);
    LAS int* RNK = (LAS int*)(F.lds + 65536 + 1024);
    LAS int* LCNT = (LAS int*)(F.lds + 65536 + 2048);
    int* tok_e = (int*)(ws + WS_TOK); int* tok_p = tok_e + 2 * M; float* tok_w = (float*)(tok_p + 2 * M); float* tok_rstd = tok_w + 2 * M;
    const int tid = F.tid, lane = F.lane, w = F.wave;
    for (int i = tid; i < D * NE; i += 512) WR[(i & 7) * D + (i >> 3)] = wrt[i];
    if (tid < 16) LCNT[tid] = 0;
    __syncthreads();
    const int rows_per_blk = M / F.G;
    const int rbase = F.vcu * rows_per_blk;
    const GAS f32x4* gr = (const GAS f32x4*)gain + 2 * lane;
    for (int li = w; li < rows_per_blk; li += NWAVES) { const int m = rbase + li;
        const GAS v4u* xr = (const GAS v4u*)(X + (size_t)m * D) + lane;
        f32x4 v[4][2]; float s = 0.f;
#pragma unroll
        for (int j = 0; j < 4; ++j) { const v4u t = xr[64 * j]; v[j][0] = pg8::bf4lo(t.x, t.y); v[j][1] = pg8::bf4lo(t.z, t.w);
#pragma unroll
            for (int q = 0; q < 2; ++q) s += (v[j][q].x * v[j][q].x + v[j][q].y * v[j][q].y) + (v[j][q].z * v[j][q].z + v[j][q].w * v[j][q].w); }
        const float rstd = 1.f / sqrtf(wave_sum(s) * (1.f / D) + EPS);
        float lg[8];
#pragma unroll
        for (int e = 0; e < 8; ++e) lg[e] = 0.f;
#pragma unroll
        for (int j = 0; j < 4; ++j)
#pragma unroll
            for (int q = 0; q < 2; ++q) { const f32x4 g = gr[128 * j + q]; const f32x4 h = (f32x4){v[j][q].x * rstd * g.x, v[j][q].y * rstd * g.y, v[j][q].z * rstd * g.z, v[j][q].w * rstd * g.w};
#pragma unroll
                for (int e = 0; e < 8; ++e) { const f32x4 wv = *(const LAS f32x4*)(WR + e * D + 8 * (64 * j + lane) + 4 * q); lg[e] += (h.x * wv.x + h.y * wv.y) + (h.z * wv.z + h.w * wv.w); } }
#pragma unroll
        for (int e = 0; e < 8; ++e) lg[e] = wave_sum(lg[e]);
        if (lane == 0) {
            int e0 = 0; float v0 = lg[0];
#pragma unroll
            for (int e = 1; e < 8; ++e) if (lg[e] > v0) { v0 = lg[e]; e0 = e; }
            int e1 = -1; float v1 = -INFINITY;
#pragma unroll
            for (int e = 0; e < 8; ++e) if (e != e0 && (e1 < 0 || lg[e] > v1)) { v1 = lg[e]; e1 = e; }
            const float w1 = 1.0f / (1.0f + expf(v0 - v1)), w0 = 1.0f - w1;
            SEL[2 * li] = e0; SEL[2 * li + 1] = e1; tok_w[2 * m] = w0; tok_w[2 * m + 1] = w1; tok_rstd[m] = rstd; }
    }
    __syncthreads();
    if (tid < 2 * rows_per_blk) RNK[tid] = __hip_atomic_fetch_add(LCNT + SEL[tid], 1, __ATOMIC_RELAXED, __HIP_MEMORY_SCOPE_WORKGROUP);
    __syncthreads();
    if (tid < 8) LCNT[8 + tid] = (int)__hip_atomic_fetch_add(F.ctl + CW_GCNT + 64 * tid, (unsigned)LCNT[tid], RLX_AGENT);
    __syncthreads();
    if (tid < 2 * rows_per_blk) { const int e = SEL[tid]; tok_e[2 * rbase + tid] = e; tok_p[2 * rbase + tid] = LCNT[8 + e] + RNK[tid]; }
    __syncthreads();
}
__device__ __forceinline__ void p12b_gather(Frame& F, const bf16* X, const float* gain, unsigned char* ws) {
    volatile LAS int* LW = (volatile LAS int*)(F.lds + LDSCTL_OFF);
    if (F.tid == 0) { int ts = 0; LW[LW_TS] = 0; LW[LW_SEG] = 0;
        for (int e = 0; e < 8; ++e) { const unsigned c = __hip_atomic_load(F.ctl + CW_GCNT + 64 * e, RLX_AGENT); const int t0 = ts; ts += (int)((c + 255u) >> 8); LW[LW_TS + e + 1] = ts; LW[LW_SEG + e + 1] = ts * 256;
            for (int t = t0; t < ts && t < MAX_TILES; ++t) LW[LW_TEXP + t] = e; } }
    __syncthreads();
    int* tok_e = (int*)(ws + WS_TOK); int* tok_p = tok_e + 2 * M; float* tok_w = (float*)(tok_p + 2 * M); float* tok_rstd = tok_w + 2 * M;
    unsigned char* Xp = ws + WS_XP;
    const int gw = F.vcu * NWAVES + F.wave, NGW = F.G * NWAVES, lane = F.lane;
    const GAS f32x4* gr = (const GAS f32x4*)gain + 2 * lane;
    for (int m = gw; m < M; m += NGW) {
        const int e0 = tok_e[2 * m], e1 = tok_e[2 * m + 1]; const int p0 = LW[LW_SEG + e0] + tok_p[2 * m], p1 = LW[LW_SEG + e1] + tok_p[2 * m + 1]; const float rstd = tok_rstd[m];
        const GAS v4u* xr = (const GAS v4u*)(X + (size_t)m * D) + lane;
        GAS v2u* d0 = (GAS v2u*)(Xp + (size_t)p0 * D) + lane; GAS v2u* d1 = (GAS v2u*)(Xp + (size_t)p1 * D) + lane;
#pragma unroll
        for (int j = 0; j < 4; ++j) { const v4u t = xr[64 * j]; const f32x4 a = pg8::bf4lo(t.x, t.y), b = pg8::bf4lo(t.z, t.w), g0 = gr[128 * j], g1 = gr[128 * j + 1];
            const float qs = rstd * (127.0f / XP_CLIP);
            v2u o; o.x = pk_i8x4(a.x * qs * g0.x, a.y * qs * g0.y, a.z * qs * g0.z, a.w * qs * g0.w); o.y = pk_i8x4(b.x * qs * g1.x, b.y * qs * g1.y, b.z * qs * g1.z, b.w * qs * g1.w);
            d0[64 * j] = o; d1[64 * j] = o; }
        asm volatile("" ::: "memory");
        if (lane == 0) { tok_p[2 * m] = p0; tok_p[2 * m + 1] = p1; }
    }
}
__device__ __forceinline__ void p15_final(Frame& F, const bf16* X, float* out, const float* gain, unsigned char* ws, bool poison) {
    const int* tok_e = (const int*)(ws + WS_TOK); const int* tok_p = tok_e + 2 * M; const float* tok_w = (const float*)(tok_p + 2 * M);
    const bf16* Ym = (const bf16*)(ws + WS_YM);
    const int gw = F.vcu * NWAVES + F.wave, NGW = F.G * NWAVES, lane = F.lane;
    const GAS f32x4* gr = (const GAS f32x4*)gain + 2 * lane;
    v4u x[4], xn[4], a[4], an[4], b[4], bn[4]; float w0 = 0.f, w1 = 0.f, w0n, w1n;
#define P15_LOAD(m_, X_, A_, B_, W0_, W1_) do { const int p0_ = tok_p[2 * (m_)], p1_ = tok_p[2 * (m_) + 1]; W0_ = tok_w[2 * (m_)]; W1_ = tok_w[2 * (m_) + 1]; \
        const GAS v4u* xr_ = (const GAS v4u*)(X + (size_t)(m_) * D) + lane; const GAS v4u* y0_ = (const GAS v4u*)(Ym + (size_t)p0_ * D) + lane; const GAS v4u* y1_ = (const GAS v4u*)(Ym + (size_t)p1_ * D) + lane; \
        _Pragma("unroll") for (int j = 0; j < 4; ++j) { X_[j] = xr_[64 * j]; A_[j] = y0_[64 * j]; B_[j] = y1_[64 * j]; } } while (0)
    if (gw < M) P15_LOAD(gw, x, a, b, w0, w1);
    for (int m = gw; m < M; m += NGW) {
        const int mn = (m + NGW < M) ? m + NGW : m;
        P15_LOAD(mn, xn, an, bn, w0n, w1n);
        f32x4 v[4][2]; float s = 0.f;
#pragma unroll
        for (int j = 0; j < 4; ++j) {
            v[j][0] = pg8::bf4lo(x[j].x, x[j].y) + pg8::bf4lo(a[j].x, a[j].y) * w0 + pg8::bf4lo(b[j].x, b[j].y) * w1;
            v[j][1] = pg8::bf4lo(x[j].z, x[j].w) + pg8::bf4lo(a[j].z, a[j].w) * w0 + pg8::bf4lo(b[j].z, b[j].w) * w1;
#pragma unroll
            for (int q = 0; q < 2; ++q) s += (v[j][q].x * v[j][q].x + v[j][q].y * v[j][q].y) + (v[j][q].z * v[j][q].z + v[j][q].w * v[j][q].w); }
        float rstd = 1.f / sqrtf(wave_sum(s) * (1.f / D) + EPS);
        if (poison) rstd = __builtin_nanf("");
        GAS f32x4* xo = (GAS f32x4*)(out + (size_t)m * D) + 2 * lane;
#pragma unroll
        for (int j = 0; j < 4; ++j)
#pragma unroll
            for (int q = 0; q < 2; ++q) { const f32x4 g = gr[128 * j + q]; xo[128 * j + q] = (f32x4){v[j][q].x * rstd * g.x, v[j][q].y * rstd * g.y, v[j][q].z * rstd * g.z, v[j][q].w * rstd * g.w}; }
#pragma unroll
        for (int j = 0; j < 4; ++j) { x[j] = xn[j]; a[j] = an[j]; b[j] = bn[j]; }
        w0 = w0n; w1 = w1n;
    }
#undef P15_LOAD
}
struct Args { const void* in[29]; float* out; unsigned char* ws; };
__global__ void __launch_bounds__(NWAVES * 64, 2) hybrid_fwd(Args args) {
    extern __shared__ __attribute__((aligned(16))) unsigned char lds[];
    Frame F;
    F.lds = (LAS unsigned char*)lds;
    F.MISC = (volatile LAS unsigned*)(F.lds + MISC_OFF);
    F.tid = threadIdx.x; F.lane = F.tid & 63; F.wave = __builtin_amdgcn_readfirstlane(F.tid >> 6);
    F.G = gridDim.x; { const int bx = blockIdx.x; F.vcu = (F.G % 8 == 0) ? (bx % 8) * (F.G / 8) + bx / 8 : bx; }
    unsigned char* ws = args.ws;
    F.ctl = (gu32*)(ws + WS_CTL);
    for (int u = F.tid; u < (LDS_BYTES - LDSCTL_OFF) / 4; u += NWAVES * 64) ((LAS unsigned*)(F.lds + LDSCTL_OFF))[u] = 0u;
    __syncthreads();
    XcdBarrier bar = xcd_barrier_post((unsigned*)(F.ctl + CW_BAR), F.MISC + 8);
#define GRID_BAR() do { xcd_barrier(bar); int t_ = threadIdx.x; asm volatile("" : "+v"(t_)); F.tid = t_; F.lane = t_ & 63; } while (0)
    const float* x = (const float*)args.in[0]; float* out = args.out;
    bf16* const A = (bf16*)(ws + WS_A); bf16* const XR = (bf16*)(ws + WS_XR);
    typedef pg8::bf16_t pb;

    { P0Args a; a.w_in = (const float*)args.in[3]; a.w_out = (const float*)args.in[10]; a.w_gate = (const float*)args.in[12]; a.w_up = (const float*)args.in[13]; a.w_down = (const float*)args.in[14];
      a.w_qkv = (const float*)args.in[16]; a.w_o = (const float*)args.in[22]; a.w_pool = (const float*)args.in[4]; a.we_gate = (const float*)args.in[25]; a.we_up = (const float*)args.in[26]; a.we_down = (const float*)args.in[27];
      a.w_spatial = (const float*)args.in[8]; a.positions = (const int*)args.in[1]; a.x = x; a.norm_mix = (const float*)args.in[2];
      p0_prologue(F, a, ws); }
    GRID_BAR();
    { pg8::Gemm g{(const pb*)A, (const pb*)(ws + WS_WIN), D / 2, 0}; pg8::StaticOrder S; S.init(M, ZW, F.G, (int)blockIdx.x);
      pg8::EpiZq E{(pb*)(ws + WS_Z), ZW, PW / 256, (const float*)(ws + WS_HSCALE), ((volatile LAS float*)(F.lds + LDSCTL_OFF))[LW_WSC + 20]};
      pg8::gemm_phase<pg8::EpiZq, pg8::StaticOrder, true, true, false, true>(F.lds + RING_OFF, g, S, E); }
    GRID_BAR();
    p2_mixer(F, (const bf16*)(ws + WS_Z), (bf16*)(ws + WS_Y1), (const bf16*)(ws + WS_WPOOL), (const float*)args.in[5], (const bf16*)(ws + WS_WSP), (const float*)args.in[9], (const float*)args.in[6], (const float*)args.in[7]);
    GRID_BAR();
    { pg8::Gemm g{(const pb*)(ws + WS_Y1), (const pb*)(ws + WS_WOUT), D, 0}; pg8::StaticOrder S; S.init(M, D, F.G, (int)blockIdx.x);
      pg8::EpiResB<true> E{x, (pb*)XR, D, 1.0f};
      pg8::gemm_phase<pg8::EpiResB<true>, pg8::StaticOrder, true, true>(F.lds + RING_OFF, g, S, E); }
    GRID_BAR();
    norm_phase_q(F, XR, (const float*)args.in[11], (unsigned char*)A, (float*)(ws + WS_HSCALE));
    GRID_BAR();
    { pg8::Gemm g{(const pb*)A, (const pb*)(ws + WS_WGU), D / 2, 0}; pg8::StaticOrder S; S.init(M, 2 * FF, F.G, (int)blockIdx.x);
      volatile LAS float* LWf = (volatile LAS float*)(F.lds + LDSCTL_OFF);
      pg8::EpiSwiGLUq E{ws + WS_ACT, FF, (const float*)(ws + WS_HSCALE), LWf[LW_WSC], LWf[LW_WSC + 1]};
      pg8::gemm_phase<pg8::EpiSwiGLUq, pg8::StaticOrder, true, true, false, true>(F.lds + RING_OFF, g, S, E); }
    GRID_BAR();
    { pg8::Gemm g{(const pb*)(ws + WS_ACT), (const pb*)(ws + WS_WD), FF / 2, 0}; pg8::StaticOrder S; S.init(M, D, F.G, (int)blockIdx.x);
      pg8::EpiResB<false> E{(const pb*)XR, (pb*)XR, D, 1.0f / W8_SCALE};
      pg8::gemm_phase<pg8::EpiResB<false>, pg8::StaticOrder, true, true, true>(F.lds + RING_OFF, g, S, E); }
    GRID_BAR();
    norm_phase_q(F, XR, (const float*)args.in[15], (unsigned char*)A, (float*)(ws + WS_HSCALE));
    GRID_BAR();
    { pg8::Gemm g{(const pb*)A, (const pb*)(ws + WS_WQKV), D / 2, 0}; pg8::StaticOrder S; S.init(M, 2 * D, F.G, (int)blockIdx.x);
      pg8::EpiQKVq8 E{ws + WS_Q, ws + WS_K, D, (const float*)(ws + WS_ROPE), attn_body::C2, (const float*)(ws + WS_HSCALE), ((volatile LAS float*)(F.lds + LDSCTL_OFF))[LW_WSC + 2]};
      pg8::gemm_phase<pg8::EpiQKVq8, pg8::StaticOrder, true, true, false, true>(F.lds + RING_OFF, g, S, E); }
    { pg8::Gemm g{(const pb*)(ws + WS_WQKV + (size_t)2 * D * D), (const pb*)A, D / 2, 0}; pg8::StaticOrder S; S.init(D, M, F.G, (int)blockIdx.x);
      pg8::EpiVT E{ws + WS_V, (const float*)(ws + WS_HSCALE), ((volatile LAS float*)(F.lds + LDSCTL_OFF))[LW_WSC + 2], SEQ};
      pg8::gemm_phase<pg8::EpiVT, pg8::StaticOrder, true, true, false, true>(F.lds + RING_OFF, g, S, E); }
    GRID_BAR();
    { const attn_body::DiffOrder S(F.vcu); attn_body::AttnUnit u;
      const unsigned char* Qb = ws + WS_Q; const unsigned char* Kb = ws + WS_K;     const unsigned char* VTb = ws + WS_V;
#define ATTN_UNITS(TRAIL) for (int i = 0; S.next(i, u); ++i) { const int qc = (u.h * 2 + u.c) * 64, vc = u.h * 128; \
          attn_body::bf16* Ob = (attn_body::bf16*)(ws + (u.c ? WS_O1 : WS_O0)); \
          attn_body::attn_unit<8, TRAIL>(u.b, 0, u.qb, Qb + qc, Kb + qc, VTb + (size_t)(u.b * 16 + u.h) * 128 * SEQ, Ob + vc, (char*)lds + RING_OFF); }
      if (F.wave < 4) { ATTN_UNITS(false) } else { ATTN_UNITS(true) }
#undef ATTN_UNITS
    }
    GRID_BAR();
    p10_combine(F, (const bf16*)(ws + WS_O0), (const bf16*)(ws + WS_O1), (unsigned char*)A, (float*)(ws + WS_HSCALE), (const float*)args.in[17], (const float*)args.in[18], (const float*)args.in[19], (const float*)args.in[20], (const float*)args.in[21]);
    GRID_BAR();
    { pg8::Gemm g{(const pb*)A, (const pb*)(ws + WS_WO), D / 2, 0}; pg8::StaticOrder S; S.init(M, D, F.G, (int)blockIdx.x);
      pg8::EpiResBq E{(pb*)XR, D, (const float*)(ws + WS_HSCALE), ((volatile LAS float*)(F.lds + LDSCTL_OFF))[LW_WSC + 3]};
      pg8::gemm_phase<pg8::EpiResBq, pg8::StaticOrder, true, true, false, true>(F.lds + RING_OFF, g, S, E); }
    GRID_BAR();
    p12a_route(F, XR, (const float*)args.in[23], (const float*)args.in[24], ws);
    GRID_BAR();
    p12b_gather(F, XR, (const float*)args.in[23], ws);
    GRID_BAR();
    { volatile LAS int* LW = (volatile LAS int*)(F.lds + LDSCTL_OFF); const int n_tiles = __builtin_amdgcn_readfirstlane(LW[LW_TS + 8]);
      { pg8::Gemm g{(const pb*)(ws + WS_XP), (const pb*)(ws + WS_WEGU), D / 2, (size_t)2 * FF * D}; pg8::MoeOrder S; S.init(n_tiles * 256, 2 * FF, F.G, (int)blockIdx.x); S.tile0 = 0;
        S.texp = (const volatile LAS int*)(F.lds + LDSCTL_OFF) + LW_TEXP;
        pg8::EpiSwiGLUqs E{ws + WS_ACTC, FF, XP_CLIP / 127.0f, (const volatile LAS float*)(F.lds + LDSCTL_OFF) + LW_WSC + 4};
        pg8::gemm_phase<pg8::EpiSwiGLUqs, pg8::MoeOrder, true, true, false, true>(F.lds + RING_OFF, g, S, E); }
      GRID_BAR();
      { pg8::Gemm g{(const pb*)(ws + WS_ACTC), (const pb*)(ws + WS_WED), FF / 2, (size_t)D * FF}; pg8::MoeOrder S; S.init(n_tiles * 256, D, F.G, (int)blockIdx.x); S.tile0 = 0;
        S.texp = (const volatile LAS int*)(F.lds + LDSCTL_OFF) + LW_TEXP;
        pg8::EpiPlainS E{(pb*)(ws + WS_YM), D, 1.0f / W8_SCALE};
        pg8::gemm_phase<pg8::EpiPlainS, pg8::MoeOrder, true, true, true>(F.lds + RING_OFF, g, S, E); }
      GRID_BAR();
    }
    { const bool poison = __hip_atomic_load(F.ctl + CW_BAR + XB_TMO, RLX_AGENT) != 0u;
      p15_final(F, XR, out, (const float*)args.in[28], ws, poison); }
}

extern "C" void kernel_launch(void* const* d_in, const int* in_sizes, int n_in, void* d_out, int out_size, void* d_ws, size_t ws_size, hipStream_t stream) {
    static int grid = 0;
    if (grid == 0) {
        if (n_in != 29 || in_sizes[0] != M * D || out_size != M * D || ws_size < WS_END) { fprintf(stderr, "kernel_launch: unexpected shapes (n_in %d, in0 %d, out %d, ws %zu < %zu); nothing launched\n", n_in, n_in > 0 ? in_sizes[0] : -1, out_size, ws_size, (size_t)WS_END); grid = -1; return; }
        int dev = 0, cus = 0, per_cu = 0;
        if (hipGetDevice(&dev) != hipSuccess || hipDeviceGetAttribute(&cus, hipDeviceAttributeMultiprocessorCount, dev) != hipSuccess) { grid = -1; return; }
        if (hipFuncSetAttribute((const void*)hybrid_fwd, hipFuncAttributeMaxDynamicSharedMemorySize, LDS_BYTES) != hipSuccess) { fprintf(stderr, "kernel_launch: hipFuncSetAttribute failed\n"); grid = -1; return; }
        if (hipOccupancyMaxActiveBlocksPerMultiprocessor(&per_cu, (const void*)hybrid_fwd, NWAVES * 64, LDS_BYTES) != hipSuccess || per_cu < 1) fprintf(stderr, "kernel_launch: occupancy query says %d\n", per_cu);
        (void)hipGetLastError();
        if (cus < 256) { fprintf(stderr, "kernel_launch: needs 256 CUs, device has %d\n", cus); grid = -1; return; }
        grid = 256;
    }
    if (grid < 0) return;
    if (hipMemsetAsync((char*)d_ws + WS_CTL, 0, CTL_ZERO_BYTES, stream) != hipSuccess) return;
    Args a{};
    for (int i = 0; i < 29; ++i) a.in[i] = d_in[i];
    a.out = (float*)d_out; a.ws = (unsigned char*)d_ws;
    hipLaunchKernelGGL(hybrid_fwd, dim3(grid), dim3(NWAVES * 64), LDS_BYTES, stream, a);
    const hipError_t le = hipPeekAtLastError();
    if (le != hipSuccess) fprintf(stderr, "kernel_launch: launch failed: %s\n", hipGetErrorName(le));
}
```

```cpp
#include <hip/hip_runtime.h>
#include <hip/hip_bf16.h>
#include <cstdio>
#include <cstdint>
#include <cmath>
namespace pg8 {
#define PG8_LAS __attribute__((address_space(3)))
typedef unsigned short bf16_t;
typedef short bf16x8 __attribute__((ext_vector_type(8)));
typedef float f32x4 __attribute__((ext_vector_type(4)));
typedef unsigned u32x4 __attribute__((ext_vector_type(4)));
constexpr int BM = 256, BK = 64, HALF = 128, HTB = HALF * BK * 2  , STAGE_BYTES = 8 * HTB, NXCD = 8, WGM = 8;

__host__ __device__ __forceinline__ int lds_byte(int r, int c) { const int st = (r >> 4) * 2 + (c >> 5), rr = r & 15, cc = c & 31, ob = rr * 64 + cc * 2; return st * 1024 + (ob ^ (((ob >> 9) & 1) << 5)); }
__host__ __device__ __forceinline__ void stage_rc(int b, int& R, int& C) { const int st = b / 1024, sb = b % 1024, swz = sb ^ (((sb >> 9) & 1) << 5); R = (st >> 1) * 16 + swz / 64; C = (st & 1) * 32 + (swz % 64) / 2; }
__host__ __device__ __forceinline__ int perm32(int rho) { const int n = rho >> 4, i = rho & 15; return 8 * (i >> 2) + 4 * n + (i & 3); }

struct Unit { int pm, pn, be; };
struct Gemm { const bf16_t* A; const bf16_t* Bt; int K; size_t bstride; };

struct StaticOrder {
    int nM, nN, nwg, G, c;
    __host__ __device__ void init(int M, int N, int G_, int c_) { nM = M / BM; nN = N / BM; nwg = nM * nN; G = G_; c = c_; }
    __host__ __device__ bool next(int i, Unit& u) const {
        const long L = (long)i * G + c; if (L >= nwg) return false;
        int wgid = (int)L; { const int q = nwg / NXCD, r = nwg % NXCD, xcd = wgid % NXCD, off = wgid / NXCD; wgid = (xcd < r ? xcd * (q + 1) : r * (q + 1) + (xcd - r) * q) + off; }
        const int nig = WGM * nN, gid = wgid / nig, fm = gid * WGM, gsz = (nM - fm) < WGM ? (nM - fm) : WGM;
        u.pm = fm + ((wgid % nig) % gsz); u.pn = (wgid % nig) / gsz; u.be = 0; return true;
    }
    __device__ __forceinline__ void a_ready(const Unit&) const {}
    __device__ __forceinline__ void done(const Unit&) const {}
};

__device__ __forceinline__ unsigned cvt_pk_bf16(float lo, float hi) { unsigned r; asm volatile("v_cvt_pk_bf16_f32 %0, %1, %2" : "=v"(r) : "v"(lo), "v"(hi)); return r; }
typedef float f32x2 __attribute__((ext_vector_type(2)));
__device__ __forceinline__ f32x2 gelu_pk(f32x2 v) {
    const f32x2 av = __builtin_elementwise_abs(v), d = av * 0.2316418882f + 1.0f;
    f32x2 t; t.x = __builtin_amdgcn_rcpf(d.x); t.y = __builtin_amdgcn_rcpf(d.y);
    f32x2 q = t * 0.5307027145f + (-0.7265760135f); q = q * t + 0.7107068705f; q = q * t + (-0.142248368f); q = q * t + 0.127414796f; q = q * t;
    const f32x2 s = (v * v) * (-0.72134752044f);
    f32x2 e; e.x = __builtin_amdgcn_exp2f(s.x); e.y = __builtin_amdgcn_exp2f(s.y);
    const f32x2 m = v * (q * e), r = v - m;
    f32x2 o; o.x = v.x < 0.f ? m.x : r.x; o.y = v.y < 0.f ? m.y : r.y; return o;
}

typedef int v4i_t __attribute__((ext_vector_type(4)));
__device__ __forceinline__ u32x4 pack8(f32x4 v0, f32x4 v1) { u32x4 w; w.x = cvt_pk_bf16(v0[0], v0[1]); w.y = cvt_pk_bf16(v0[2], v0[3]); w.z = cvt_pk_bf16(v1[0], v1[1]); w.w = cvt_pk_bf16(v1[2], v1[3]); return w; }
__device__ __forceinline__ f32x4 gelu4(f32x4 v) { const f32x2 a = gelu_pk((f32x2){v[0], v[1]}), b = gelu_pk((f32x2){v[2], v[3]}); return (f32x4){a.x, a.y, b.x, b.y}; }
__device__ __forceinline__ float silu1(float x) { return x * __builtin_amdgcn_rcpf(1.0f + __builtin_amdgcn_exp2f(x * -1.4426950408889634f)); }
__device__ __forceinline__ f32x4 swiglu4(f32x4 g, f32x4 u) { return (f32x4){silu1(g[0]) * u[0], silu1(g[1]) * u[1], silu1(g[2]) * u[2], silu1(g[3]) * u[3]}; }

struct EpiZ {
    static constexpr bool PERM = true, AFTER_DRAIN = false;
    bf16_t* O; int ldc; int gelu_from;
    __device__ __forceinline__ void operator()(const f32x4 (&acc)[2][2][4][2], const Unit& u, int wr, int wc, int fr, int fq) const {
        const int row0 = u.pm * BM + wr * 64 + fr, col0 = u.pn * BM + wc * 32 + 8 * fq; const bool gel = u.pn >= gelu_from;
#pragma unroll
        for (int ai = 0; ai < 2; ++ai)
#pragma unroll
            for (int m = 0; m < 4; ++m) { bf16_t* rowp = O + (size_t)(row0 + ai * HALF + m * 16) * ldc + col0;
#pragma unroll
                for (int bj = 0; bj < 2; ++bj) { f32x4 v0 = acc[ai][bj][m][0], v1 = acc[ai][bj][m][1];
                    if (gel) { v0 = gelu4(v0); v1 = gelu4(v1); }
                    *(u32x4*)(rowp + bj * HALF) = pack8(v0, v1); } }
    }
};
struct EpiPlain {
    static constexpr bool PERM = true, AFTER_DRAIN = false;
    bf16_t* O; int ldc;
    __device__ __forceinline__ void operator()(const f32x4 (&acc)[2][2][4][2], const Unit& u, int wr, int wc, int fr, int fq) const {
        const int row0 = u.pm * BM + wr * 64 + fr, col0 = u.pn * BM + wc * 32 + 8 * fq;
#pragma unroll
        for (int ai = 0; ai < 2; ++ai)
#pragma unroll
            for (int m = 0; m < 4; ++m) { bf16_t* rowp = O + (size_t)(row0 + ai * HALF + m * 16) * ldc + col0;
#pragma unroll
                for (int bj = 0; bj < 2; ++bj) *(u32x4*)(rowp + bj * HALF) = pack8(acc[ai][bj][m][0], acc[ai][bj][m][1]); }
    }
};
__device__ __forceinline__ f32x4 bf4lo(unsigned a, unsigned b) { return (f32x4){__uint_as_float(a << 16), __uint_as_float(a & 0xffff0000u), __uint_as_float(b << 16), __uint_as_float(b & 0xffff0000u)}; }
template <bool RES32> struct EpiResB {
    static constexpr bool PERM = true, AFTER_DRAIN = false;
    const void* res; bf16_t* out; int ldc; float s;
    __device__ __forceinline__ void operator()(const f32x4 (&acc)[2][2][4][2], const Unit& u, int wr, int wc, int fr, int fq) const {
        const int row0 = u.pm * BM + wr * 64 + fr, col0 = u.pn * BM + wc * 32 + 8 * fq;
#pragma unroll
        for (int ai = 0; ai < 2; ++ai) { f32x4 r[4][2][2];
#pragma unroll
            for (int m = 0; m < 4; ++m) { const size_t off = (size_t)(row0 + ai * HALF + m * 16) * ldc + col0;
#pragma unroll
                for (int bj = 0; bj < 2; ++bj) {
                    if constexpr (RES32) { r[m][bj][0] = *(const f32x4*)((const float*)res + off + bj * HALF); r[m][bj][1] = *(const f32x4*)((const float*)res + off + bj * HALF + 4); }
                    else { const u32x4 w = *(const u32x4*)((const bf16_t*)res + off + bj * HALF); r[m][bj][0] = bf4lo(w.x, w.y); r[m][bj][1] = bf4lo(w.z, w.w); } } }
#pragma unroll
            for (int m = 0; m < 4; ++m) { const size_t off = (size_t)(row0 + ai * HALF + m * 16) * ldc + col0;
#pragma unroll
                for (int bj = 0; bj < 2; ++bj) *(u32x4*)(out + off + bj * HALF) = pack8(r[m][bj][0] + acc[ai][bj][m][0] * s, r[m][bj][1] + acc[ai][bj][m][1] * s); }
            asm volatile("" ::: "memory"); }
    }
};
struct EpiSwiGLU {
    static constexpr bool PERM = true, AFTER_DRAIN = false;
    bf16_t* O; int ldc;
    __device__ __forceinline__ void operator()(const f32x4 (&acc)[2][2][4][2], const Unit& u, int wr, int wc, int fr, int fq) const {
        const int row0 = u.pm * BM + wr * 64 + fr, col0 = u.pn * HALF + wc * 32 + 8 * fq;
#pragma unroll
        for (int ai = 0; ai < 2; ++ai)
#pragma unroll
            for (int m = 0; m < 4; ++m) { bf16_t* rowp = O + (size_t)(row0 + ai * HALF + m * 16) * ldc + col0;
                const f32x4 a0 = swiglu4(acc[ai][0][m][0], acc[ai][1][m][0]), a1 = swiglu4(acc[ai][0][m][1], acc[ai][1][m][1]);
                *(u32x4*)rowp = pack8(a0, a1); }
    }
};
struct EpiQKV {
    static constexpr bool PERM = true, AFTER_DRAIN = false;
    bf16_t* Q; bf16_t* Kk; bf16_t* V; int ldc; const float* rope; float qscale;
    __device__ __forceinline__ void operator()(const f32x4 (&acc)[2][2][4][2], const Unit& u, int wr, int wc, int fr, int fq) const {
        const int row0 = u.pm * BM + wr * 64 + fr;
        if (u.pn < 16) {
            bf16_t* base = (u.pn < 8) ? Q : Kk; const float sc = (u.pn < 8) ? qscale : 1.0f; const int col0 = (u.pn & 7) * BM + wc * 64 + 8 * fq;
#pragma unroll
            for (int ai = 0; ai < 2; ++ai)
#pragma unroll
                for (int m = 0; m < 4; ++m) { const int r = row0 + ai * HALF + m * 16; const float* cs = rope + (size_t)r * 64 + 8 * fq;
                    const f32x4 c0 = *(const f32x4*)(cs), c1 = *(const f32x4*)(cs + 4), s0 = *(const f32x4*)(cs + 32), s1 = *(const f32x4*)(cs + 36);
                    const f32x4 x10 = acc[ai][0][m][0], x11 = acc[ai][0][m][1], x20 = acc[ai][1][m][0], x21 = acc[ai][1][m][1];
                    const f32x4 o10 = (x10 * c0 - x20 * s0) * sc, o11 = (x11 * c1 - x21 * s1) * sc, o20 = (x20 * c0 + x10 * s0) * sc, o21 = (x21 * c1 + x11 * s1) * sc;
                    bf16_t* rowp = base + (size_t)r * ldc + col0;
                    *(u32x4*)rowp = pack8(o10, o11); *(u32x4*)(rowp + 32) = pack8(o20, o21); }
        } else {
            const int col0 = (u.pn - 16) * BM + wc * 32 + 8 * fq;
#pragma unroll
            for (int ai = 0; ai < 2; ++ai)
#pragma unroll
                for (int m = 0; m < 4; ++m) { bf16_t* rowp = V + (size_t)(row0 + ai * HALF + m * 16) * ldc + col0;
#pragma unroll
                    for (int bj = 0; bj < 2; ++bj) *(u32x4*)(rowp + bj * HALF) = pack8(acc[ai][bj][m][0], acc[ai][bj][m][1]); }
        }
    }
};
__device__ __forceinline__ f32x4 cvti4(f32x4 a, float f) { return __builtin_convertvector(__builtin_bit_cast(v4i_t, a), f32x4) * f; }
struct EpiQKVq {
    static constexpr bool PERM = true, AFTER_DRAIN = false;
    bf16_t* Q; bf16_t* Kk; bf16_t* V; int ldc; const float* rope; float qscale; const float* rowscale; float sw;
    __device__ __forceinline__ void operator()(const f32x4 (&acc)[2][2][4][2], const Unit& u, int wr, int wc, int fr, int fq) const {
        const int row0 = u.pm * BM + wr * 64 + fr;
        if (u.pn < 16) {
            bf16_t* base = (u.pn < 8) ? Q : Kk; const float sc = (u.pn < 8) ? qscale : 1.0f; const int col0 = (u.pn & 7) * BM + wc * 64 + 8 * fq;
#pragma unroll
            for (int ai = 0; ai < 2; ++ai)
#pragma unroll
                for (int m = 0; m < 4; ++m) { const int r = row0 + ai * HALF + m * 16; const float* cs = rope + (size_t)r * 64 + 8 * fq; const float f = rowscale[r] * sw;
                    const f32x4 c0 = *(const f32x4*)(cs), c1 = *(const f32x4*)(cs + 4), s0 = *(const f32x4*)(cs + 32), s1 = *(const f32x4*)(cs + 36);
                    const f32x4 x10 = cvti4(acc[ai][0][m][0], f), x11 = cvti4(acc[ai][0][m][1], f), x20 = cvti4(acc[ai][1][m][0], f), x21 = cvti4(acc[ai][1][m][1], f);
                    const f32x4 o10 = (x10 * c0 - x20 * s0) * sc, o11 = (x11 * c1 - x21 * s1) * sc, o20 = (x20 * c0 + x10 * s0) * sc, o21 = (x21 * c1 + x11 * s1) * sc;
                    bf16_t* rowp = base + (size_t)r * ldc + col0;
                    *(u32x4*)rowp = pack8(o10, o11); *(u32x4*)(rowp + 32) = pack8(o20, o21); }
        } else {
            const int col0 = (u.pn - 16) * BM + wc * 32 + 8 * fq;
#pragma unroll
            for (int ai = 0; ai < 2; ++ai)
#pragma unroll
                for (int m = 0; m < 4; ++m) { const int r = row0 + ai * HALF + m * 16; bf16_t* rowp = V + (size_t)r * ldc + col0; const float f = rowscale[r] * sw;
#pragma unroll
                    for (int bj = 0; bj < 2; ++bj) *(u32x4*)(rowp + bj * HALF) = pack8(cvti4(acc[ai][bj][m][0], f), cvti4(acc[ai][bj][m][1], f)); }
        }
    }
};
struct EpiResBq {
    static constexpr bool PERM = true, AFTER_DRAIN = false;
    bf16_t* xr; int ldc; const float* rowscale; float sw;
    __device__ __forceinline__ void operator()(const f32x4 (&acc)[2][2][4][2], const Unit& u, int wr, int wc, int fr, int fq) const {
        const int row0 = u.pm * BM + wr * 64 + fr, col0 = u.pn * BM + wc * 32 + 8 * fq;
#pragma unroll
        for (int ai = 0; ai < 2; ++ai) { u32x4 r[4][2]; float f[4];
#pragma unroll
            for (int m = 0; m < 4; ++m) { const int rr = row0 + ai * HALF + m * 16; const size_t off = (size_t)rr * ldc + col0; f[m] = rowscale[rr] * sw;
#pragma unroll
                for (int bj = 0; bj < 2; ++bj) r[m][bj] = *(const u32x4*)(xr + off + bj * HALF); }
#pragma unroll
            for (int m = 0; m < 4; ++m) { const size_t off = (size_t)(row0 + ai * HALF + m * 16) * ldc + col0;
#pragma unroll
                for (int bj = 0; bj < 2; ++bj) *(u32x4*)(xr + off + bj * HALF) = pack8(bf4lo(r[m][bj].x, r[m][bj].y) + cvti4(acc[ai][bj][m][0], f[m]), bf4lo(r[m][bj].z, r[m][bj].w) + cvti4(acc[ai][bj][m][1], f[m])); }
            asm volatile("" ::: "memory"); }
    }
};
__device__ __forceinline__ unsigned pk_fp8x4(float a, float b, float c, float d) { unsigned w = 0u; w = (unsigned)__builtin_amdgcn_cvt_pk_fp8_f32(a, b, (int)w, false); w = (unsigned)__builtin_amdgcn_cvt_pk_fp8_f32(c, d, (int)w, true); return w; }
typedef unsigned u32x2 __attribute__((ext_vector_type(2)));
struct EpiSwiGLU8 {
    static constexpr bool PERM = true, AFTER_DRAIN = false;
    unsigned char* O; int ldc; float s;
    __device__ __forceinline__ void operator()(const f32x4 (&acc)[2][2][4][2], const Unit& u, int wr, int wc, int fr, int fq) const {
        const int row0 = u.pm * BM + wr * 64 + fr, col0 = u.pn * HALF + wc * 32 + 8 * fq;
#pragma unroll
        for (int ai = 0; ai < 2; ++ai)
#pragma unroll
            for (int m = 0; m < 4; ++m) { unsigned char* rowp = O + (size_t)(row0 + ai * HALF + m * 16) * ldc + col0;
                const f32x4 a0 = swiglu4(acc[ai][0][m][0] * s, acc[ai][1][m][0] * s), a1 = swiglu4(acc[ai][0][m][1] * s, acc[ai][1][m][1] * s);
                u32x2 w; w.x = pk_fp8x4(a0[0], a0[1], a0[2], a0[3]); w.y = pk_fp8x4(a1[0], a1[1], a1[2], a1[3]);
                *(u32x2*)rowp = w; }
    }
};
struct EpiSwiGLUq {
    static constexpr bool PERM = true, AFTER_DRAIN = false;
    unsigned char* O; int ldc; const float* rowscale; float sg, su;
    __device__ __forceinline__ void operator()(const f32x4 (&acc)[2][2][4][2], const Unit& u, int wr, int wc, int fr, int fq) const {
        const int row0 = u.pm * BM + wr * 64 + fr, col0 = u.pn * HALF + wc * 32 + 8 * fq;
#pragma unroll
        for (int ai = 0; ai < 2; ++ai)
#pragma unroll
            for (int m = 0; m < 4; ++m) { const int r = row0 + ai * HALF + m * 16; unsigned char* rowp = O + (size_t)r * ldc + col0; const float rs = rowscale[r]; const float fg = rs * sg, fu = rs * su;
                const f32x4 g0 = __builtin_convertvector(__builtin_bit_cast(v4i_t, acc[ai][0][m][0]), f32x4) * fg, g1 = __builtin_convertvector(__builtin_bit_cast(v4i_t, acc[ai][0][m][1]), f32x4) * fg;
                const f32x4 u0 = __builtin_convertvector(__builtin_bit_cast(v4i_t, acc[ai][1][m][0]), f32x4) * fu, u1 = __builtin_convertvector(__builtin_bit_cast(v4i_t, acc[ai][1][m][1]), f32x4) * fu;
                const f32x4 a0 = swiglu4(g0, u0), a1 = swiglu4(g1, u1);
                u32x2 w; w.x = pk_fp8x4(a0[0], a0[1], a0[2], a0[3]); w.y = pk_fp8x4(a1[0], a1[1], a1[2], a1[3]);
                *(u32x2*)rowp = w; }
    }
};
struct EpiQKVq8 {
    static constexpr bool PERM = true, AFTER_DRAIN = false;
    unsigned char* Q; unsigned char* Kk; int ldc; const float* rope; float qscale; const float* rowscale; float sw;
    __device__ __forceinline__ void operator()(const f32x4 (&acc)[2][2][4][2], const Unit& u, int wr, int wc, int fr, int fq) const {
        const int row0 = u.pm * BM + wr * 64 + fr;
        unsigned char* base = (u.pn < 8) ? Q : Kk; const float sc = (u.pn < 8) ? qscale : 1.0f; const int col0 = (u.pn & 7) * BM + wc * 64 + 8 * fq;
#pragma unroll
        for (int ai = 0; ai < 2; ++ai)
#pragma unroll
            for (int m = 0; m < 4; ++m) { const int r = row0 + ai * HALF + m * 16; const float* cs = rope + (size_t)r * 64 + 8 * fq; const float f = rowscale[r] * sw;
                const f32x4 c0 = *(const f32x4*)(cs), c1 = *(const f32x4*)(cs + 4), s0 = *(const f32x4*)(cs + 32), s1 = *(const f32x4*)(cs + 36);
                const f32x4 x10 = cvti4(acc[ai][0][m][0], f), x11 = cvti4(acc[ai][0][m][1], f), x20 = cvti4(acc[ai][1][m][0], f), x21 = cvti4(acc[ai][1][m][1], f);
                const f32x4 o10 = (x10 * c0 - x20 * s0) * sc, o11 = (x11 * c1 - x21 * s1) * sc, o20 = (x20 * c0 + x10 * s0) * sc, o21 = (x21 * c1 + x11 * s1) * sc;
                unsigned char* rowp = base + (size_t)r * ldc + col0;
                u32x2 w1, w2; w1.x = pk_fp8x4(o10[0], o10[1], o10[2], o10[3]); w1.y = pk_fp8x4(o11[0], o11[1], o11[2], o11[3]); w2.x = pk_fp8x4(o20[0], o20[1], o20[2], o20[3]); w2.y = pk_fp8x4(o21[0], o21[1], o21[2], o21[3]);
                *(u32x2*)rowp = w1; *(u32x2*)(rowp + 32) = w2; }
    }
};
struct EpiVT {
    static constexpr bool PERM = true, AFTER_DRAIN = false;
    unsigned char* VT; const float* rowscale; float sw; int seq;
    __device__ __forceinline__ void operator()(const f32x4 (&acc)[2][2][4][2], const Unit& u, int wr, int wc, int fr, int fq) const {
        const int row0 = u.pm * BM + wr * 64 + fr;
#pragma unroll
        for (int bj = 0; bj < 2; ++bj) { const int c0 = u.pn * BM + bj * HALF + wc * 32 + 8 * fq;
            const f32x4 s0 = *(const f32x4*)(rowscale + c0) * sw, s1 = *(const f32x4*)(rowscale + c0 + 4) * sw;
            const int b = c0 / seq, pos = c0 % seq, k0 = pos & 63; const int basep = (pos & ~63) + 16 * ((k0 >> 5) & 1) + 4 * ((k0 & 31) >> 3);
#pragma unroll
            for (int ai = 0; ai < 2; ++ai)
#pragma unroll
                for (int m = 0; m < 4; ++m) { const int r = row0 + ai * HALF + m * 16;
                    const f32x4 v0 = __builtin_convertvector(__builtin_bit_cast(v4i_t, acc[ai][bj][m][0]), f32x4) * s0, v1 = __builtin_convertvector(__builtin_bit_cast(v4i_t, acc[ai][bj][m][1]), f32x4) * s1;
                    unsigned char* p = VT + ((size_t)(b * 16 + (r >> 7)) * 128 + (r & 127)) * seq + basep;
                    *(unsigned*)p = pk_fp8x4(v0[0], v0[1], v0[2], v0[3]); *(unsigned*)(p + 32) = pk_fp8x4(v1[0], v1[1], v1[2], v1[3]); } }
    }
};
struct EpiSwiGLUqs {
    static constexpr bool PERM = true, AFTER_DRAIN = false;
    unsigned char* O; int ldc; float sa; const volatile PG8_LAS float* wsc;
    __device__ __forceinline__ void operator()(const f32x4 (&acc)[2][2][4][2], const Unit& u, int wr, int wc, int fr, int fq) const {
        const int row0 = u.pm * BM + wr * 64 + fr, col0 = u.pn * HALF + wc * 32 + 8 * fq; const float fg = sa * wsc[2 * u.be], fu = sa * wsc[2 * u.be + 1];
#pragma unroll
        for (int ai = 0; ai < 2; ++ai)
#pragma unroll
            for (int m = 0; m < 4; ++m) { unsigned char* rowp = O + (size_t)(row0 + ai * HALF + m * 16) * ldc + col0;
                const f32x4 a0 = swiglu4(cvti4(acc[ai][0][m][0], fg), cvti4(acc[ai][1][m][0], fu)), a1 = swiglu4(cvti4(acc[ai][0][m][1], fg), cvti4(acc[ai][1][m][1], fu));
                u32x2 w; w.x = pk_fp8x4(a0[0], a0[1], a0[2], a0[3]); w.y = pk_fp8x4(a1[0], a1[1], a1[2], a1[3]);
                *(u32x2*)rowp = w; }
    }
};
struct EpiZq {
    static constexpr bool PERM = true, AFTER_DRAIN = false;
    bf16_t* O; int ldc; int gelu_from; const float* rowscale; float sw;
    __device__ __forceinline__ void operator()(const f32x4 (&acc)[2][2][4][2], const Unit& u, int wr, int wc, int fr, int fq) const {
        const int row0 = u.pm * BM + wr * 64 + fr, col0 = u.pn * BM + wc * 32 + 8 * fq; const bool gel = u.pn >= gelu_from;
#pragma unroll
        for (int ai = 0; ai < 2; ++ai)
#pragma unroll
            for (int m = 0; m < 4; ++m) { const int r = row0 + ai * HALF + m * 16; bf16_t* rowp = O + (size_t)r * ldc + col0; const float f = rowscale[r] * sw;
#pragma unroll
                for (int bj = 0; bj < 2; ++bj) { f32x4 v0 = cvti4(acc[ai][bj][m][0], f), v1 = cvti4(acc[ai][bj][m][1], f);
                    if (gel) { v0 = gelu4(v0); v1 = gelu4(v1); }
                    *(u32x4*)(rowp + bj * HALF) = pack8(v0, v1); } }
    }
};
struct EpiPlainS {
    static constexpr bool PERM = true, AFTER_DRAIN = false;
    bf16_t* O; int ldc; float s;
    __device__ __forceinline__ void operator()(const f32x4 (&acc)[2][2][4][2], const Unit& u, int wr, int wc, int fr, int fq) const {
        const int row0 = u.pm * BM + wr * 64 + fr, col0 = u.pn * BM + wc * 32 + 8 * fq;
#pragma unroll
        for (int ai = 0; ai < 2; ++ai)
#pragma unroll
            for (int m = 0; m < 4; ++m) { bf16_t* rowp = O + (size_t)(row0 + ai * HALF + m * 16) * ldc + col0;
#pragma unroll
                for (int bj = 0; bj < 2; ++bj) *(u32x4*)(rowp + bj * HALF) = pack8(acc[ai][bj][m][0] * s, acc[ai][bj][m][1] * s); }
    }
};
struct MoeOrder : StaticOrder {
    int tile0; const volatile PG8_LAS int* texp;
    __device__ __forceinline__ bool next(int i, Unit& u) const {
        if (!StaticOrder::next(i, u)) return false;
        u.be = __builtin_amdgcn_readfirstlane(texp[tile0 + u.pm]); return true;
    }
};
typedef int v4i_t __attribute__((ext_vector_type(4))); typedef int v8i_t __attribute__((ext_vector_type(8)));
__device__ __forceinline__ void mma8(f32x4& c, bf16x8 b0, bf16x8 b1, bf16x8 a0, bf16x8 a1, int sc) {
    const v4i_t x0 = __builtin_bit_cast(v4i_t, b0), x1 = __builtin_bit_cast(v4i_t, b1), y0 = __builtin_bit_cast(v4i_t, a0), y1 = __builtin_bit_cast(v4i_t, a1);
    const v8i_t X = __builtin_shufflevector(x0, x1, 0, 1, 2, 3, 4, 5, 6, 7), Y = __builtin_shufflevector(y0, y1, 0, 1, 2, 3, 4, 5, 6, 7);
    asm volatile("v_mfma_scale_f32_16x16x128_f8f6f4 %0, %1, %2, %0, %3, %3 op_sel_hi:[0,0,0]" : "+v"(c) : "v"(X), "v"(Y), "v"(sc));
}
__device__ __forceinline__ f32x4 mma_i8(bf16x8 b, bf16x8 a, f32x4 c) {
    return __builtin_bit_cast(f32x4, __builtin_amdgcn_mfma_i32_16x16x64_i8(__builtin_bit_cast(v4i_t, b), __builtin_bit_cast(v4i_t, a), __builtin_bit_cast(v4i_t, c), 0, 0, 0));
}
template <class Epi, class Sched, bool ALIGN_EPI = false, bool SP2 = false, bool FP8 = false, bool I8 = false>
__device__ __forceinline__ void gemm_phase(PG8_LAS unsigned char* lds, const Gemm g, const Sched& S, const Epi& E) {
    int tid_ = threadIdx.x; asm volatile("" : "+v"(tid_));
    const int tid = tid_, wid = __builtin_amdgcn_readfirstlane(tid >> 6), lane = tid & 63, wr = wid >> 2, wc = wid & 3, fr = lane & 15, fq = lane >> 4;
    const int K = g.K, nt = K / BK;
    unsigned voffA[2], voffB[2];
#pragma unroll
    for (int i = 0; i < 2; ++i) { int R, C; stage_rc(tid * 16 + i * 8192, R, C); const int Rb = Epi::PERM ? ((R & ~31) + perm32(R & 31)) : R;
        voffA[i] = (unsigned)(R * K + C) * 2u; voffB[i] = (unsigned)(Rb * K + C) * 2u; }
    const size_t kstep = (size_t)(BK * 2);
    const size_t hstep = (size_t)HALF * K * 2;
    const size_t tstep = 2 * hstep;
    const unsigned ldsw = (unsigned)wid * 1024u;
    const int aoff = lds_byte(wr * 64 + fr, fq * 8), boff = lds_byte(wc * 32 + fr, fq * 8);
#define PG8_SA(b, h) (((b) * 2 + (h)) * HTB)
#define PG8_SB(b, h) ((4 + (b) * 2 + (h)) * HTB)
#define PG8_STAGE(bufoff, gbase, voff) do { _Pragma("unroll") for (int _i = 0; _i < 2; ++_i) \
        __builtin_amdgcn_global_load_lds((const unsigned*)((const char*)(gbase) + (voff)[_i]), (PG8_LAS unsigned*)(lds + (bufoff) + ldsw + _i * 8192), 16, 0, 0); } while (0)
#define PG8_LDA(dst, b, h) do { _Pragma("unroll") for (int m = 0; m < 4; ++m) _Pragma("unroll") for (int k = 0; k < 2; ++k) dst[m][k] = *(const PG8_LAS bf16x8*)(lds + PG8_SA(b, h) + aoff + m * 2048 + k * 1024); } while (0)
#define PG8_LDB(dst, b, h) do { _Pragma("unroll") for (int n = 0; n < 2; ++n) _Pragma("unroll") for (int k = 0; k < 2; ++k) dst[n][k] = *(const PG8_LAS bf16x8*)(lds + PG8_SB(b, h) + boff + n * 2048 + k * 1024); } while (0)
#define PG8_MMA(ai, bj, At, Bt) do { __builtin_amdgcn_s_setprio(1); _Pragma("unroll") for (int m = 0; m < 4; ++m) _Pragma("unroll") for (int n = 0; n < 2; ++n) { \
        if constexpr (FP8) mma8(acc[ai][bj][m][n], Bt[n][0], Bt[n][1], At[m][0], At[m][1], sc8); \
        else if constexpr (I8) { _Pragma("unroll") for (int k = 0; k < 2; ++k) acc[ai][bj][m][n] = mma_i8(Bt[n][k], At[m][k], acc[ai][bj][m][n]); } \
        else { _Pragma("unroll") for (int k = 0; k < 2; ++k) acc[ai][bj][m][n] = __builtin_amdgcn_mfma_f32_16x16x32_bf16(Bt[n][k], At[m][k], acc[ai][bj][m][n], 0, 0, 0); } } __builtin_amdgcn_s_setprio(0); } while (0)
#define PG8_WAIT_V(n) asm volatile("s_waitcnt vmcnt(" #n ")" ::: "memory")
#define PG8_WAIT_L(n) asm volatile("s_waitcnt lgkmcnt(" #n ")" ::: "memory")
#define PG8_BAR __builtin_amdgcn_s_barrier()
#define PG8_SCHED __builtin_amdgcn_sched_barrier(0)
    int sc8 = 0x7F7F7F7F; asm volatile("" : "+v"(sc8));
    Unit cur, nxt; int ui = 0;
    if (!S.next(0, cur)) return;
    f32x4 acc[2][2][4][2];
#pragma unroll
    for (int a = 0; a < 2; ++a)
#pragma unroll
        for (int b = 0; b < 2; ++b)
#pragma unroll
            for (int m = 0; m < 4; ++m)
#pragma unroll
                for (int n = 0; n < 2; ++n) acc[a][b][m][n] = (f32x4){0.f, 0.f, 0.f, 0.f};
    bf16x8 At[4][2], B0[2][2], B1[2][2];
    const char* cA = (const char*)g.A + (size_t)cur.pm * tstep; const char* cB = (const char*)g.Bt + (size_t)cur.be * g.bstride + (size_t)cur.pn * tstep;
    S.a_ready(cur);
    if constexpr (SP2) {
        PG8_STAGE(PG8_SB(0, 0), cB, voffB); PG8_STAGE(PG8_SB(0, 1), cB + hstep, voffB); PG8_STAGE(PG8_SA(0, 0), cA, voffA); PG8_STAGE(PG8_SA(0, 1), cA + hstep, voffA);
        if (wr == 1) PG8_BAR;
        PG8_WAIT_V(2); PG8_BAR;
        PG8_STAGE(PG8_SB(1, 0), cB + kstep, voffB); PG8_STAGE(PG8_SA(1, 0), cA + kstep, voffA); PG8_STAGE(PG8_SB(1, 1), cB + hstep + kstep, voffB);
        PG8_WAIT_V(6); PG8_BAR;
    } else {
        PG8_STAGE(PG8_SB(0, 0), cB, voffB); PG8_STAGE(PG8_SA(0, 0), cA, voffA); PG8_STAGE(PG8_SB(0, 1), cB + hstep, voffB); PG8_STAGE(PG8_SA(0, 1), cA + hstep, voffA);
        if (wr == 1) PG8_BAR;
        PG8_WAIT_V(4); PG8_BAR;
        PG8_STAGE(PG8_SB(1, 0), cB + kstep, voffB); PG8_STAGE(PG8_SA(1, 0), cA + kstep, voffA); PG8_STAGE(PG8_SB(1, 1), cB + hstep + kstep, voffB);
        PG8_WAIT_V(6); PG8_BAR;
    }
    for (;;) {
        const bool has_next = S.next(ui + 1, nxt);
        const char* nA = has_next ? (const char*)g.A + (size_t)nxt.pm * tstep : cA; const char* nB = has_next ? (const char*)g.Bt + (size_t)nxt.be * g.bstride + (size_t)nxt.pn * tstep : cB;
        for (int t = 0; t < nt; t += 2) {
            const bool last = (t == nt - 2);
            const char* a1 = cA + (size_t)(t + 1) * kstep;
            const char* a2 = last ? nA : cA + (size_t)(t + 2) * kstep; const char* b2 = last ? nB : cB + (size_t)(t + 2) * kstep;
            const char* a3 = a2 + kstep; const char* b3 = b2 + kstep;
            if (last && has_next) S.a_ready(nxt);
            if constexpr (SP2) {
            PG8_LDB(B0, 0, 0); PG8_LDB(B1, 0, 1); PG8_SCHED; PG8_LDA(At, 0, 0); PG8_STAGE(PG8_SA(1, 1), a1 + hstep, voffA);
            PG8_WAIT_V(8); PG8_WAIT_L(0); PG8_BAR; PG8_MMA(0, 0, At, B0); PG8_MMA(0, 1, At, B1); PG8_BAR; PG8_SCHED;
            PG8_LDA(At, 0, 1); PG8_STAGE(PG8_SB(0, 0), b2, voffB); PG8_STAGE(PG8_SB(0, 1), b2 + hstep, voffB); PG8_STAGE(PG8_SA(0, 0), a2, voffA);
            PG8_WAIT_V(8); PG8_WAIT_L(0); PG8_BAR; PG8_MMA(1, 0, At, B0); PG8_MMA(1, 1, At, B1); PG8_BAR; PG8_SCHED;
            PG8_LDB(B0, 1, 0); PG8_LDB(B1, 1, 1); PG8_SCHED; PG8_LDA(At, 1, 0); PG8_STAGE(PG8_SA(0, 1), a2 + hstep, voffA);
            PG8_WAIT_V(8); PG8_WAIT_L(0); PG8_BAR; PG8_MMA(0, 0, At, B0); PG8_MMA(0, 1, At, B1); PG8_BAR; PG8_SCHED;
            PG8_LDA(At, 1, 1); PG8_STAGE(PG8_SB(1, 0), b3, voffB); PG8_STAGE(PG8_SB(1, 1), b3 + hstep, voffB); PG8_STAGE(PG8_SA(1, 0), a3, voffA);
            PG8_WAIT_V(8); PG8_WAIT_L(0); PG8_BAR; PG8_MMA(1, 0, At, B0); PG8_MMA(1, 1, At, B1); PG8_BAR; PG8_SCHED;
            } else {
            PG8_LDB(B0, 0, 0); PG8_SCHED; PG8_LDA(At, 0, 0); PG8_STAGE(PG8_SA(1, 1), a1 + hstep, voffA);
            PG8_WAIT_L(8); PG8_BAR; PG8_WAIT_L(0); PG8_MMA(0, 0, At, B0); PG8_BAR; PG8_SCHED;
            PG8_LDB(B1, 0, 1); PG8_STAGE(PG8_SB(0, 0), b2, voffB);
            PG8_BAR; PG8_WAIT_L(0); PG8_MMA(0, 1, At, B1); PG8_BAR;
            PG8_LDA(At, 0, 1); PG8_STAGE(PG8_SA(0, 0), a2, voffA);
            PG8_BAR; PG8_WAIT_L(0); PG8_MMA(1, 0, At, B0); PG8_BAR; PG8_SCHED;
            PG8_STAGE(PG8_SB(0, 1), b2 + hstep, voffB);
            PG8_WAIT_V(6); PG8_BAR; PG8_MMA(1, 1, At, B1); PG8_BAR;
            PG8_LDB(B0, 1, 0); PG8_SCHED; PG8_LDA(At, 1, 0); PG8_STAGE(PG8_SA(0, 1), a2 + hstep, voffA);
            PG8_WAIT_L(8); PG8_BAR; PG8_WAIT_L(0); PG8_MMA(0, 0, At, B0); PG8_BAR; PG8_SCHED;
            PG8_LDB(B1, 1, 1); PG8_STAGE(PG8_SB(1, 0), b3, voffB);
            PG8_BAR; PG8_WAIT_L(0); PG8_MMA(0, 1, At, B1); PG8_BAR;
            PG8_LDA(At, 1, 1); PG8_STAGE(PG8_SA(1, 0), a3, voffA);
            PG8_BAR; PG8_WAIT_L(0); PG8_MMA(1, 0, At, B0); PG8_BAR; PG8_SCHED;
            PG8_STAGE(PG8_SB(1, 1), b3 + hstep, voffB);
            PG8_WAIT_V(6); PG8_BAR; PG8_MMA(1, 1, At, B1); PG8_BAR;
            }
        }
        if constexpr (ALIGN_EPI) { if (wr == 0) PG8_BAR; }
        if constexpr (FP8) asm volatile("s_nop 15\n\ts_nop 15" ::: "memory");
        if constexpr (!Epi::AFTER_DRAIN) { E(acc, cur, wr, wc, fr, fq); S.done(cur); }
        if (!has_next) break;
#pragma unroll
        for (int a = 0; a < 2; ++a)
#pragma unroll
            for (int b = 0; b < 2; ++b)
#pragma unroll
                for (int m = 0; m < 4; ++m)
#pragma unroll
                    for (int n = 0; n < 2; ++n) acc[a][b][m][n] = (f32x4){0.f, 0.f, 0.f, 0.f};
        cur = nxt; cA = nA; cB = nB; ++ui;
        if constexpr (ALIGN_EPI) { if (wr == 1) PG8_BAR; }
    }
    PG8_WAIT_V(0);
    if constexpr (!ALIGN_EPI) { if (wr == 0) PG8_BAR; }
    PG8_BAR;
    if constexpr (Epi::AFTER_DRAIN) { E.fused(acc, cur, wr, wc, fr, fq, lds, wid, lane); S.done(cur); }
#undef PG8_SA
#undef PG8_SB
#undef PG8_STAGE
#undef PG8_LDA
#undef PG8_LDB
#undef PG8_MMA
#undef PG8_WAIT_V
#undef PG8_WAIT_L
#undef PG8_BAR
#undef PG8_SCHED
}
}

#ifndef PG8_SP2
#define PG8_SP2 true
#endif
#include <hip/hip_bf16.h>
#include <cmath>
namespace attn_body {
using bf16=__hip_bfloat16;
using bf16x8=__attribute__((ext_vector_type(8)))short;
using s16x4=__attribute__((ext_vector_type(4)))short;
using f32x16=__attribute__((ext_vector_type(16)))float;
using u32x4=__attribute__((ext_vector_type(4)))unsigned;
constexpr int BATCH=2,NHEAD=16,SEQ=16384,D=64,DM=2048;
constexpr int NW=8,QBLK=32,QB=QBLK*NW,KVBLK=64,NQB=SEQ/QB;
constexpr int ATTN_PITCH=DM, ATTN_UNIT_ROWS=QB;
__device__ __forceinline__ int crow(int r,int hi){return (r&3)+8*(r>>2)+4*hi;}
#define SBAR() __builtin_amdgcn_sched_barrier(0)
__device__ __forceinline__ void cmask(f32x16&p0,f32x16&p1,int jb,int qrel,int hi){
  const float NEG=-INFINITY; int kb=64*jb+4*hi;
  #pragma unroll
  for(int r=0;r<16;++r){int kv=kb+(r&3)+8*(r>>2); if(kv>qrel)p0[r]=NEG; if(kv+32>qrel)p1[r]=NEG;}
}

constexpr int NSLOT=3, SLOTB=8192;
constexpr int LDS_K=0, LDS_V=NSLOT*SLOTB, LDS_WS=2*NSLOT*SLOTB, LDS_OST=LDS_WS+NW*64*4, LDS_BYTES=LDS_OST+NW*4096;
constexpr int ATTN_PARAM_OFF=131072+2048;
constexpr float C2=0.125f*1.4426950408889634f;
__device__ __forceinline__ void glds16(const void*gsrc,unsigned lds_dst){unsigned keep;
  asm volatile("s_mov_b32 %0, m0\n\ts_mov_b32 m0, %2\n\ts_nop 0\n\tglobal_load_lds_dwordx4 %1, off\n\ts_mov_b32 m0, %0":"=&s"(keep):"v"(gsrc),"s"(lds_dst):"memory");}
__device__ __forceinline__ float max3f(float a,float b,float c){float r;asm("v_max3_f32 %0, %1, %2, %3":"=v"(r):"v"(a),"v"(b),"v"(c));return r;}
__device__ __forceinline__ float max2f(float a,float b){float r;asm("v_max_f32_e32 %0, %1, %2":"=v"(r):"v"(a),"v"(b));return r;}
__device__ __forceinline__ float fadd_s(float a,float b){float r;asm("v_add_f32_e32 %0, %1, %2":"=v"(r):"v"(a),"v"(b));return r;}
__device__ __forceinline__ float fsub_s(float a,float b){float r;asm("v_sub_f32_e32 %0, %1, %2":"=v"(r):"v"(a),"v"(b));return r;}
typedef float f32x2_t __attribute__((ext_vector_type(2))); typedef __bf16 bf16x2_t __attribute__((ext_vector_type(2)));
__device__ __forceinline__ unsigned cvtpk_s(float lo,float hi){f32x2_t v={lo,hi};bf16x2_t b=__builtin_convertvector(v,bf16x2_t);return __builtin_bit_cast(unsigned,b);}
__device__ __forceinline__ void glds16s(const void*sbase,unsigned voff,unsigned lds_dst){unsigned keep;
  asm volatile("s_mov_b32 %0, m0\n\ts_mov_b32 m0, %2\n\ts_nop 0\n\tglobal_load_lds_dwordx4 %1, %3\n\ts_mov_b32 m0, %0":"=&s"(keep):"v"(voff),"s"(lds_dst),"s"(sbase):"memory");}
#define WAIT_BAR(N) asm volatile("s_waitcnt vmcnt(" #N ") lgkmcnt(0)\n\ts_barrier":::"memory")

__device__ __forceinline__ void qkt(f32x16&p0,f32x16&p1,const char*Kslot,const bf16x8*qr,const f32x16&negm,int r32,int hi){
  const char*kb=Kslot+hi*1024+r32*16;
  #pragma unroll
  for(int d0=0;d0<4;++d0){
    const bf16x8 b0=*reinterpret_cast<const bf16x8*>(kb+d0*2048);
    const bf16x8 b1=*reinterpret_cast<const bf16x8*>(kb+d0*2048+512);
    if(d0==0){p0=__builtin_amdgcn_mfma_f32_32x32x16_bf16(b0,qr[0],negm,0,0,0);p1=__builtin_amdgcn_mfma_f32_32x32x16_bf16(b1,qr[0],negm,0,0,0);}
    else{p0=__builtin_amdgcn_mfma_f32_32x32x16_bf16(b0,qr[d0],p0,0,0,0);p1=__builtin_amdgcn_mfma_f32_32x32x16_bf16(b1,qr[d0],p1,0,0,0);}}
}
typedef __attribute__((address_space(3))) const char* lds_cptr;
typedef short v4i16_t __attribute__((ext_vector_type(4)));
__device__ __forceinline__ void kload8(bf16x8*kf,lds_cptr kp){
  kf[0]=*(const __attribute__((address_space(3))) bf16x8*)(kp);      kf[1]=*(const __attribute__((address_space(3))) bf16x8*)(kp+512);
  kf[2]=*(const __attribute__((address_space(3))) bf16x8*)(kp+2048); kf[3]=*(const __attribute__((address_space(3))) bf16x8*)(kp+2560);
  kf[4]=*(const __attribute__((address_space(3))) bf16x8*)(kp+4096); kf[5]=*(const __attribute__((address_space(3))) bf16x8*)(kp+4608);
  kf[6]=*(const __attribute__((address_space(3))) bf16x8*)(kp+6144); kf[7]=*(const __attribute__((address_space(3))) bf16x8*)(kp+6656);
}
__device__ __forceinline__ void kload2(bf16x8*kf,lds_cptr kp,int j){ kf[2*j]=*(const __attribute__((address_space(3))) bf16x8*)(kp+j*2048); kf[2*j+1]=*(const __attribute__((address_space(3))) bf16x8*)(kp+j*2048+512); }
__device__ __forceinline__ s16x4 vtr(lds_cptr p){ return __builtin_bit_cast(s16x4,__builtin_amdgcn_ds_read_tr16_b64_v4i16((__attribute__((address_space(3))) v4i16_t*)p)); }
__device__ __forceinline__ float rowmax(const f32x16&p0,const f32x16&p1){
  float a=max3f(p0[0],p0[1],p1[0]),b=max3f(p0[2],p0[3],p1[1]);a=max3f(a,p1[2],p1[3]);
  #pragma unroll
  for(int r=4;r<16;r+=4){a=max3f(a,p0[r],p0[r+1]);b=max3f(b,p0[r+2],p0[r+3]);a=max3f(a,p1[r],p1[r+1]);b=max3f(b,p1[r+2],p1[r+3]);}
  const float m=max2f(a,b);
  auto rr=__builtin_amdgcn_permlane32_swap(__float_as_uint(m),__float_as_uint(m),false,false);
  return max2f(__uint_as_float(rr[0]),__uint_as_float(rr[1]));
}
typedef int v8i_a __attribute__((ext_vector_type(8))); typedef int v4i_a __attribute__((ext_vector_type(4)));
#define MFMA8(ACC,A,B) asm volatile("s_nop 1\n\tv_mfma_scale_f32_32x32x64_f8f6f4 %0, %1, %2, %0, %3, %3 op_sel_hi:[0,0,0]":"+v"(ACC):"v"(A),"v"(B),"v"(sc8_))
#ifndef ATTN_STORE16
#define ATTN_STORE16(p,v) (*(u32x4*)(p)=(v))
#endif
template<int THRL,bool TRAIL> __device__ __forceinline__ void attn_unit(int b,int h,int qb,const unsigned char*Q,const unsigned char*__restrict__ K,const unsigned char*__restrict__ VT,bf16*O,char*shm){
  int tid_=threadIdx.x; asm volatile("":"+v"(tid_)); const int tid=tid_,lane=tid&63,r32=lane&31,hi=lane>>5; const int wid=__builtin_amdgcn_readfirstlane(tid>>6);
  const long rowbase=(long)b*SEQ; const int q0=qb*QB;
  const unsigned char*Qw=Q+(rowbase+q0+wid*QBLK)*DM+h*D;
  const unsigned char*Kh=K+rowbase*DM+h*D;
  const unsigned lds0=(unsigned)(uintptr_t)shm;
  float*wsf=(float*)(shm+LDS_WS)+wid*64;
  const int krow_=8*wid+((lane&31)>>2); const unsigned koff=(unsigned)(krow_*DM+(((lane&3)^((krow_>>2)&3))*16));
  const int vrow_=16*wid+(lane>>2); const unsigned voff=(unsigned)(vrow_*SEQ+(((lane&3)^((vrow_>>2)&3))*16));
  const unsigned kdst=lds0+LDS_K+wid*512, vdst=lds0+LDS_V+wid*1024;
  #define DMA_K(t,slot) do{ if(lane<32) glds16s(Kh+(long)(t)*KVBLK*DM,koff,(unsigned)__builtin_amdgcn_readfirstlane(kdst+(slot))); }while(0)
  #define DMA_V(t,slot) glds16s(VT+(long)(t)*KVBLK,voff,(unsigned)__builtin_amdgcn_readfirstlane(vdst+(slot)))
  int sc8_=0x7F7F7F7F; asm volatile("":"+v"(sc8_));
  v8i_a kf0,kf1;
  const lds_cptr shm3=(lds_cptr)shm; const lds_cptr kpa=shm3+LDS_K+r32*64+(((2*hi)^((r32>>2)&3))*16), kpb=shm3+LDS_K+r32*64+(((2*hi+1)^((r32>>2)&3))*16); const lds_cptr vpa=shm3+LDS_V+r32*64+(((2*hi)^((r32>>2)&3))*16), vpb=shm3+LDS_V+r32*64+(((2*hi+1)^((r32>>2)&3))*16);
  const int NT=(q0+QB)/KVBLK;
  DMA_K(0,0);DMA_V(0,0);DMA_K(1,SLOTB);
  v8i_a qf; { const v4i_a a_=*reinterpret_cast<const v4i_a*>(Qw+(long)r32*DM+32*hi), b_=*reinterpret_cast<const v4i_a*>(Qw+(long)r32*DM+32*hi+16); qf=__builtin_shufflevector(a_,b_,0,1,2,3,4,5,6,7); }
  #define KLD(KF,n,SL) do{ const v4i_a a_=*(const __attribute__((address_space(3))) v4i_a*)(kpa+(SL)+(n)*2048), b_=*(const __attribute__((address_space(3))) v4i_a*)(kpb+(SL)+(n)*2048); KF=__builtin_shufflevector(a_,b_,0,1,2,3,4,5,6,7); }while(0)
  #define QK8(DD,KF) asm volatile("s_nop 1\n\tv_mfma_scale_f32_32x32x64_f8f6f4 %0, %1, %2, %3, %4, %4 op_sel_hi:[0,0,0]":"=&v"(DD):"v"(KF),"v"(qf),"v"(negm),"v"(sc8_))
  float mhat=0.f; float z_=0.f; asm volatile("":"+v"(z_)); const f32x16 zv_={z_,z_,z_,z_,z_,z_,z_,z_,z_,z_,z_,z_,z_,z_,z_,z_};     f32x16 o[4];o[0]=zv_;o[1]=zv_;o[2]=zv_;o[3]=zv_;f32x16 negm=zv_;asm volatile("":"+v"(negm)); f32x16 osum=zv_;
  int one8_=0x38383838; asm volatile("":"+v"(one8_)); const v8i_a onesv={one8_,one8_,one8_,one8_,one8_,one8_,one8_,one8_};
  const int qrel=wid*QBLK+r32;
  #define CMASK(P0,P1,t) do{int jb_=(t)-(NT-4); if(jb_>=0)cmask(P0,P1,jb_,qrel,hi);}while(0)
  bool resc=false;
  #define START(P0,P1) do{ const float rm=rowmax(P0,P1); resc=false; \
    { const float dl=rm; mhat=fadd_s(mhat,dl); \
      _Pragma("unroll") for(int r=0;r<16;++r){P0[r]=fsub_s(P0[r],dl);P1[r]=fsub_s(P1[r],dl);} \
      _Pragma("unroll") for(int r=0;r<16;++r)negm[r]=-mhat; asm volatile("":"+v"(negm)); } \
    _Pragma("unroll") for(int r=0;r<16;++r)P0[r]=__builtin_amdgcn_exp2f(P0[r]); }while(0)
  #define RESC() do{ if(resc){ asm volatile("s_waitcnt lgkmcnt(0)\n\ts_nop 15\n\ts_nop 15":::"memory"); \
      _Pragma("unroll") for(int r=0;r<16;++r){const float f_=wsf[crow(r,hi)]; o[0][r]*=f_;o[1][r]*=f_;o[2][r]*=f_;o[3][r]*=f_;osum[r]*=f_;} } }while(0)
  f32x16 pA0,pA1,pB0,pB1;
  int sl_prev=0,sl_cur=0,sl_next=SLOTB;
  #define ROT() do{sl_prev=sl_cur;sl_cur=sl_next;sl_next=(sl_next==(NSLOT-1)*SLOTB)?0:sl_next+SLOTB;}while(0)
  DMA_K(2,2*SLOTB);
  WAIT_BAR(4);
  KLD(kf0,0,0); KLD(kf1,1,0); QK8(pA0,kf0); QK8(pA1,kf1); asm volatile("s_nop 15\n\ts_nop 15":"+v"(pA0),"+v"(pA1));CMASK(pA0,pA1,0);
  START(pA0,pA1);
  _Pragma("unroll") for(int r=0;r<8;++r)pA1[r]=__builtin_amdgcn_exp2f(pA1[r]);
  WAIT_BAR(0);
  DMA_K(3,0);DMA_V(1,SLOTB);
  ROT();
  KLD(kf0,0,sl_cur); KLD(kf1,1,sl_cur);
  WAIT_BAR(2);
  v8i_a pfv=onesv, vf0, vf1, vf2, vf3;
  #define KEEP(x) asm volatile(""::"v"(x))
  #define PKF(i,P,B) do{ int w_=__builtin_amdgcn_cvt_pk_fp8_f32(P[B],P[B+1],pfv[i],false); pfv[i]=__builtin_amdgcn_cvt_pk_fp8_f32(P[B+2],P[B+3],w_,true); }while(0)
  #define PIN(x) asm volatile("":"+v"(x))
  #define MX3(a,b,c) __builtin_fmaxf(__builtin_fmaxf((a),(b)),(c))
  #define GAPA(MF,A0,A1,A2,A3,PK) do{ MF; PK; SBAR(); }while(0)
  #define EX(v) __builtin_amdgcn_exp2f(v)
  #define EX8(X,B) do{ X[B]=EX(X[B]); X[B+1]=EX(X[B+1]); X[B+2]=EX(X[B+2]); X[B+3]=EX(X[B+3]); X[B+4]=EX(X[B+4]); X[B+5]=EX(X[B+5]); X[B+6]=EX(X[B+6]); X[B+7]=EX(X[B+7]); PIN(X); }while(0)
  #define VLD(VF,db) do{ const v4i_a a_=*(const __attribute__((address_space(3))) v4i_a*)(vp_a_+(db)*2048), b_=*(const __attribute__((address_space(3))) v4i_a*)(vp_b_+(db)*2048); VF=__builtin_shufflevector(a_,b_,0,1,2,3,4,5,6,7); }while(0)
  #define KRDP(G,KF,n) do{ if(G){ KLD(KF,n,sl_next); } }while(0)
  #define SEC_A(C0,C1,P0,P1,VL) do{ \
    PKF(0,P0,0); PKF(1,P0,4); PKF(2,P0,8); PKF(3,P0,12); PKF(4,P1,0); PKF(5,P1,4); \
    QK8(C0,kf0); SBAR(); \
    if(VL){ VLD(vf0,0); KEEP(kf0); SBAR(); } \
    QK8(C1,kf1); EX8(P1,8); PKF(6,P1,8); PKF(7,P1,12); SBAR(); \
    PIN(pfv); asm volatile("s_nop 7":"+v"(C0),"+v"(C1)); }while(0)
  #define SEC_DMA(t,GK,GV) do{ if(GK){DMA_K((t)+3,sl_cur);} if(GV){DMA_V((t)+1,sl_next);} }while(0)
  #define SEC_MAX(C0,C1) do{ float a=MX3(C0[0],C0[1],C1[0]),b=MX3(C0[2],C0[3],C1[1]); a=MX3(a,C1[2],C1[3]); \
      _Pragma("unroll") for(int r=4;r<16;r+=4){a=MX3(a,C0[r],C0[r+1]);b=MX3(b,C0[r+2],C0[r+3]);a=MX3(a,C1[r],C1[r+1]);b=MX3(b,C1[r+2],C1[r+3]);} \
      float rm=__builtin_fmaxf(a,b); { auto rr=__builtin_amdgcn_permlane32_swap(__float_as_uint(rm),__float_as_uint(rm),false,false); rm=__builtin_fmaxf(__uint_as_float(rr[0]),__uint_as_float(rr[1])); } \
      resc=false; \
      if(__builtin_expect(__any(rm>(float)THRL),0)){ const float dl=__builtin_fmaxf(rm,0.f); mhat+=dl; \
        _Pragma("unroll") for(int r=0;r<16;++r){C0[r]-=dl;C1[r]-=dl;} \
        _Pragma("unroll") for(int r=0;r<16;++r)negm[r]=-mhat; asm volatile("":"+v"(negm)); \
        const float f=__builtin_amdgcn_exp2f(-dl); if(hi==0)wsf[r32]=f; resc=true; } }while(0)
  #define SEC_B(C0,C1,GL) do{ \
    VLD(vf1,1); SBAR(); MFMA8(o[0],pfv,vf0); KRDP(GL,kf0,0); KEEP(vf0); EX8(C0,0); SBAR(); \
    VLD(vf2,2); KEEP(vf0); SBAR(); MFMA8(o[1],pfv,vf1); KRDP(GL,kf1,1); KEEP(vf1); EX8(C0,8); SBAR(); \
    VLD(vf3,3); KEEP(vf1); SBAR(); MFMA8(o[2],pfv,vf2); EX8(C1,0); SBAR(); \
    MFMA8(o[3],pfv,vf3); SBAR(); \
    MFMA8(osum,pfv,onesv); SBAR(); }while(0)
  #define STEP(C0,C1,P0,P1,t,GK,GV,GL) do{ SBAR(); \
    const lds_cptr vp_a_=vpa+sl_prev, vp_b_=vpb+sl_prev; \
    SEC_A(C0,C1,P0,P1,true); \
    SEC_DMA(t,GK,GV); \
    CMASK(C0,C1,t); \
    SEC_MAX(C0,C1); \
    SBAR(); \
    SEC_B(C0,C1,GL); \
    }while(0)
  #define STEP_T(C0,C1,N0,N1,t,GK,GV,GL,GA) do{ SBAR(); \
    const lds_cptr vp_a_=vpa+sl_prev, vp_b_=vpb+sl_prev; \
    SEC_DMA(t,GK,GV); \
    VLD(vf0,0); SBAR(); \
    SEC_MAX(C0,C1); \
    SBAR(); \
    SEC_B(C0,C1,GL); \
    if(GA){ SEC_A(N0,N1,C0,C1,false); CMASK(N0,N1,(t)+1); } \
    }while(0)
  int t=1;
  constexpr bool trail_=TRAIL;
  if constexpr(trail_){ const lds_cptr vp_a_=vpa, vp_b_=vpb; SEC_A(pB0,pB1,pA0,pA1,false); CMASK(pB0,pB1,1); }
  #undef CMASK
  #define CMASK(P0,P1,t) do{}while(0)
  if constexpr(!trail_){
    for(;t+5<NT;t+=2){
      STEP(pB0,pB1,pA0,pA1,t,true,true,true);     WAIT_BAR(2); RESC(); ROT();
      STEP(pA0,pA1,pB0,pB1,t+1,true,true,true);   WAIT_BAR(2); RESC(); ROT();
    }
  } else {
    for(;t+5<NT;t+=2){
      STEP_T(pB0,pB1,pA0,pA1,t,true,true,true,true);     WAIT_BAR(2); RESC(); ROT();
      STEP_T(pA0,pA1,pB0,pB1,t+1,true,true,true,true);   WAIT_BAR(2); RESC(); ROT();
    }
  }
  #undef CMASK
  #define CMASK(P0,P1,t) do{int jb_=(t)-(NT-4); if(jb_>=0)cmask(P0,P1,jb_,qrel,hi);}while(0)
  #define ENDW(tt) do{ if((tt)+3<NT){WAIT_BAR(2);} else if((tt)+2<NT){WAIT_BAR(1);} else {WAIT_BAR(0);} }while(0)
  if constexpr(!trail_){
    for(;t+1<NT;t+=2){
      STEP(pB0,pB1,pA0,pA1,t,(t+3<NT),(t+1<NT),(t+1<NT));       ENDW(t);   RESC(); ROT();
      STEP(pA0,pA1,pB0,pB1,t+1,(t+4<NT),(t+2<NT),(t+2<NT));     ENDW(t+1); RESC(); ROT();
    }
    STEP(pB0,pB1,pA0,pA1,NT-1,false,false,false); RESC();
  } else {
    for(;t+1<NT;t+=2){
      STEP_T(pB0,pB1,pA0,pA1,t,(t+3<NT),(t+1<NT),(t+1<NT),true);       ENDW(t);   RESC(); ROT();
      STEP_T(pA0,pA1,pB0,pB1,t+1,(t+4<NT),(t+2<NT),(t+2<NT),true);     ENDW(t+1); RESC(); ROT();
    }
    STEP_T(pB0,pB1,pA0,pA1,NT-1,false,false,false,false); RESC();
  }
  {
    EX8(pB1,8); PKF(0,pB0,0);PKF(1,pB0,4);PKF(2,pB0,8);PKF(3,pB0,12);PKF(4,pB1,0);PKF(5,pB1,4);PKF(6,pB1,8);PKF(7,pB1,12); PIN(pfv);
    const lds_cptr vp_a_=vpa+sl_cur, vp_b_=vpb+sl_cur;
    VLD(vf0,0); VLD(vf1,1); VLD(vf2,2); VLD(vf3,3); SBAR(); MFMA8(o[0],pfv,vf0); MFMA8(o[1],pfv,vf1); MFMA8(o[2],pfv,vf2); MFMA8(o[3],pfv,vf3); MFMA8(osum,pfv,onesv); SBAR();
    asm volatile("s_nop 15\n\ts_nop 15\n\ts_nop 15\n\ts_nop 15\n\ts_nop 7":"+v"(o[0]),"+v"(o[1]),"+v"(o[2]),"+v"(o[3]),"+v"(osum)); }
  #undef PKF
  #undef EX8
  #undef VLD
  #undef PAF
  #undef VFR
  #undef PIN
  #undef MX3
  #undef GAPA
  #undef GAPB
  #undef EX
  #undef KRDP
  #undef KLD
  #undef QK8
  #undef KRD
  #undef STEP
  #undef STEP_T
  #undef SEC_A
  #undef KEEP
  #undef SEC_B
  #undef SEC_MAX
  #undef SEC_DMA
  #undef ENDW
  float rli[16];
  #pragma unroll
  for(int r=0;r<16;++r)rli[r]=__builtin_amdgcn_rcpf(osum[r]);
  bf16*Ow=O+(rowbase+q0+wid*QBLK)*DM+h*D;
  { bf16*stg=(bf16*)(shm+LDS_OST)+wid*2048;
    #pragma unroll
    for(int hh=0;hh<2;++hh){
    #pragma unroll
    for(int r=0;r<16;++r){const int orow=crow(r,hi);
      #pragma unroll
      for(int d0=0;d0<2;++d0)stg[orow*64+d0*32+r32]=__float2bfloat16(o[2*hh+d0][r]*rli[r]);}
    asm volatile("s_waitcnt lgkmcnt(0)":::"memory");
    #pragma unroll
    for(int i=0;i<4;++i){const int row=i*8+(lane>>3),ch=lane&7; const u32x4 v=*(const u32x4*)(stg+row*64+ch*8); ATTN_STORE16(Ow+(long)row*DM+hh*64+ch*8,v);}
    asm volatile("s_waitcnt lgkmcnt(0)":::"memory"); } }
  asm volatile("s_waitcnt lgkmcnt(0)\n\ts_barrier":::"memory");
  #undef DMA_K
  #undef DMA_V
  #undef CMASK
  #undef START
  #undef RESC
  #undef ROT
}
constexpr int ATTN_LDS_BYTES=LDS_BYTES;
struct AttnUnit { int b, h, c, qb; };
struct DiffOrder {
  int vcu;
  __device__ __forceinline__ explicit DiffOrder(int v):vcu(v){}
  __device__ __forceinline__ bool next(int i,AttnUnit&u)const{ if(i>=16)return false; const int r=i>>2,k=i&3,x=vcu>>5,loc=vcu&31,j=loc&15; const int bh=r*8+x;
    u.b=bh>>4; u.h=bh&15; u.c=loc>>4; const int pair=j+16*(k>>1); u.qb=(k&1)?63-pair:pair; return true; }
};
#undef SBAR
#undef WAIT_BAR
}
#define GAS __attribute__((address_space(1)))
#define LAS __attribute__((address_space(3)))
typedef unsigned short bf16;
typedef unsigned v4u __attribute__((ext_vector_type(4)));
typedef float f32x4 __attribute__((ext_vector_type(4)));
typedef short bf16x8 __attribute__((ext_vector_type(8)));
typedef GAS unsigned gu32;
typedef GAS unsigned long long gu64;
#define RLX_AGENT __ATOMIC_RELAXED, __HIP_MEMORY_SCOPE_AGENT
#define LDS_WAIT() asm volatile("s_waitcnt lgkmcnt(0)" ::: "memory")
#define VM_WAIT() asm volatile("s_waitcnt vmcnt(0)" ::: "memory")
__device__ __forceinline__ unsigned long long rt() { return __builtin_amdgcn_s_memrealtime(); }
__device__ __forceinline__ unsigned f2bf(float f) { unsigned u = __builtin_bit_cast(unsigned, f); return (u + 0x7fffu + ((u >> 16) & 1u)) >> 16; }
__device__ __forceinline__ unsigned pk2(float lo, float hi) { return f2bf(lo) | (f2bf(hi) << 16); }

#define XB_TMO      128
#define XB_XCNT(j)  (256  + 64 * (j))
#define XB_XSUB(j)  (1280 + 64 * (j))
#define XB_XGEN(j)  (2304 + 64 * (j))
#define XB_TOP      3328
#define XB_TOPGEN   3392
#define XCD_BAR_WORDS 3456
#define XB_SPIN_CAP (1u << 18)

__device__ __forceinline__ unsigned xb_ld(unsigned* p)              { return __hip_atomic_load(p, __ATOMIC_RELAXED, __HIP_MEMORY_SCOPE_AGENT); }
__device__ __forceinline__ unsigned xb_add(unsigned* p, unsigned v) { return __hip_atomic_fetch_add(p, v, __ATOMIC_RELAXED, __HIP_MEMORY_SCOPE_AGENT); }
__device__ __forceinline__ unsigned xb_xcc_id() { return (unsigned)__builtin_amdgcn_s_getreg((3 << 11) | 20) & 0xFu; }
#define XB_SPIN(cond, bar) do { unsigned _sp = 0; while (cond) { __builtin_amdgcn_s_sleep(1); \
    if ((++_sp & 255u) == 0u) { if (xb_ld(&(bar)[XB_TMO])) break; if (_sp > XB_SPIN_CAP) { atomicAdd(&(bar)[XB_TMO], 1u); break; } } } } while (0)

struct XcdBarrier {
    unsigned* bar; unsigned x;
    volatile LAS unsigned* st;
};

__device__ __forceinline__ XcdBarrier xcd_barrier_post(unsigned* bar, volatile LAS unsigned* st) {
    XcdBarrier b; b.bar = bar; b.x = xb_xcc_id(); b.st = st;
    if (threadIdx.x == 0) (void)xb_add(&bar[XB_XCNT(b.x)], 1u);
    return b;
}
__device__ __forceinline__ void xcd_barrier_complete(unsigned* bar, unsigned x, unsigned& nloc, unsigned& nx) {
    const unsigned G = gridDim.x * gridDim.y * gridDim.z;
    unsigned sum, cnt, mine, sp = 0u;
    for (;;) {
        sum = 0u; cnt = 0u; mine = 0u;
#pragma unroll
        for (unsigned j = 0; j < 16; ++j) { const unsigned c = xb_ld(&bar[XB_XCNT(j)]); sum += c; cnt += (c > 0u) ? 1u : 0u; mine = (j == x) ? c : mine; }
        if (sum == G) break;
        __builtin_amdgcn_s_sleep(1);
        if ((++sp & 255u) == 0u) { if (xb_ld(&bar[XB_TMO])) break; if (sp > XB_SPIN_CAP) { atomicAdd(&bar[XB_TMO], 1u); break; } }
    }
    nloc = mine > 0u ? mine : 1u; nx = cnt > 0u ? cnt : 1u;
}

__device__ __forceinline__ void xcd_barrier(const XcdBarrier& b) {
    asm volatile("s_waitcnt vmcnt(0)" ::: "memory");
    __syncthreads();
    if (threadIdx.x == 0) {
        unsigned* bar = b.bar;
        __builtin_amdgcn_s_waitcnt(0);
        unsigned nloc = b.st[0], nx = b.st[1];
        if (nloc == 0u) { xcd_barrier_complete(bar, b.x, nloc, nx); b.st[0] = nloc; b.st[1] = nx; }
        const unsigned old = xb_add(&bar[XB_XSUB(b.x)], 1u);
        const unsigned gen = old / nloc;
        if (old + 1u == (gen + 1u) * nloc) {
            __builtin_amdgcn_fence(__ATOMIC_RELEASE, "agent");
            asm volatile("s_waitcnt vmcnt(0)" ::: "memory");
            const unsigned og = xb_add(&bar[XB_TOP], 1u);
            const unsigned tg = og / nx;
            if (og + 1u == (tg + 1u) * nx) xb_add(&bar[XB_TOPGEN], 1u);
            else XB_SPIN(xb_ld(&bar[XB_TOPGEN]) == tg, bar);
            __builtin_amdgcn_fence(__ATOMIC_ACQUIRE, "agent");
            xb_add(&bar[XB_XGEN(b.x)], 1u);
            asm volatile("s_waitcnt vmcnt(0)" ::: "memory");
        } else {
            XB_SPIN(xb_ld(&bar[XB_XGEN(b.x)]) == gen, bar);
            __builtin_amdgcn_fence(__ATOMIC_ACQUIRE, "agent");
            asm volatile("s_waitcnt vmcnt(0)" ::: "memory");
        }
    }
    __syncthreads();
}
__device__ __forceinline__ void xcd_barrier_local(const XcdBarrier& b) {
    asm volatile("s_waitcnt vmcnt(0)" ::: "memory");
    __syncthreads();
    if (threadIdx.x == 0) {
        unsigned* bar = b.bar;
        __builtin_amdgcn_s_waitcnt(0);
        const unsigned nloc = b.st[0];
        const unsigned old = xb_add(&bar[XB_XSUB(b.x)], 1u);
        const unsigned gen = old / nloc;
        if (old + 1u == (gen + 1u) * nloc) xb_add(&bar[XB_XGEN(b.x)], 1u);
        else XB_SPIN(xb_ld(&bar[XB_XGEN(b.x)]) == gen, bar);
        __builtin_amdgcn_fence(__ATOMIC_ACQUIRE, "agent");
        asm volatile("s_waitcnt vmcnt(0)" ::: "memory");
    }
    __syncthreads();
}
constexpr int NWAVES = 8;
constexpr int BATCH = 2, SEQ = 16384, D = 2048, M = BATCH * SEQ;
constexpr int ZW = 3072, PW = 1024, GW = 1024, FF = 5632, NE = 8, NQKV = 3 * D;
constexpr int CHUNK_TILES = 64, MAX_TILES = 264;
constexpr float EPS = 1e-5f;
constexpr float LAMBDA_INIT = 0.35550906759096927f;
constexpr size_t MiB = 1u << 20;
constexpr size_t WS_CTL = 0, CTL_ZERO_BYTES = 1 * MiB;
constexpr size_t WS_ROPE = 2 * MiB;
constexpr size_t WS_TOK = 10 * MiB;
constexpr size_t WS_WSP = 12 * MiB, WS_WPOOL = 12 * MiB + 512 * 1024;
constexpr size_t WS_WIN = 16 * MiB, WS_WOUT = 28 * MiB, WS_WGU = 36 * MiB, WS_WD = 80 * MiB, WS_WQKV = 102 * MiB, WS_WO = 126 * MiB, WS_WEGU = 134 * MiB, WS_WED = 486 * MiB;
constexpr size_t WS_XR = 320 * MiB;
constexpr size_t WS_A = 662 * MiB;
constexpr size_t WS_B = 790 * MiB;
constexpr size_t WS_Z = WS_B, WS_Y1 = WS_B + 192 * MiB, WS_ACT = WS_B;
constexpr size_t WS_Q = WS_B, WS_K = WS_B + 128 * MiB, WS_V = WS_B + 256 * MiB, WS_O0 = WS_B + 384 * MiB, WS_O1 = WS_B + 512 * MiB;
constexpr size_t WS_XP = WS_A, WS_YM = 794 * MiB, WS_ACTC = 1058 * MiB;
constexpr size_t WS_END = 1430 * MiB;
constexpr float W8_SCALE = 32.0f;
static_assert(WS_XP + (size_t)MAX_TILES * 256 * D <= WS_YM && WS_YM + (size_t)MAX_TILES * 256 * D * 2 <= WS_ACTC && WS_ACTC + (size_t)MAX_TILES * 256 * FF <= WS_END, "moe map");
static_assert(WS_ACT + (size_t)M * FF * 2 <= WS_END && WS_Y1 + (size_t)M * D * 2 <= WS_END && WS_WED + (size_t)NE * D * FF <= WS_A && WS_WEGU + (size_t)NE * 2 * FF * D <= WS_XR && WS_XR + (size_t)M * D * 2 <= WS_WED, "map");
constexpr int CW_TMO = 0, CW_CODE = 1, CW_ALIGN = 2048  , CW_MISMATCH = 3072, CW_BAR = 4096, CW_GCNT = 16384;
constexpr int RING_OFF = 0, RING_BYTES = 131072;
constexpr int LDSCTL_OFF = RING_BYTES, MISC_OFF = LDSCTL_OFF + 320;
constexpr int LDS_BYTES = 147456;
constexpr int LW_TS = 0, LW_SEG = 16, LW_TEXP = 128;
constexpr int LW_WSC = 48;
constexpr float XP_CLIP = 5.0f;
constexpr size_t WS_HSCALE = WS_TOK + 896 * 1024;

struct Frame {
    LAS unsigned char* lds;
    volatile LAS unsigned* MISC;
    gu32* ctl;
    int tid, lane, wave;
    int vcu, G;
    int local_ok;
};

__device__ __forceinline__ float wave_sum(float v) {
#pragma unroll
    for (int o = 1; o < 64; o <<= 1) v += __shfl_xor(v, o);
    return v;
}
__device__ __forceinline__ float bf2f(unsigned short b) { return __uint_as_float((unsigned)b << 16); }
__device__ __forceinline__ float bflo(unsigned w) { return __uint_as_float(w << 16); }
__device__ __forceinline__ float bfhi(unsigned w) { return __uint_as_float(w & 0xffff0000u); }

__device__ __forceinline__ int map_gate(int n) { return 256 * (n >> 7) + (n & 127); }
__device__ __forceinline__ int map_up(int n) { return 256 * (n >> 7) + 128 + (n & 127); }
__device__ __forceinline__ int map_qkv(int n) {
    if (n >= 2 * D) return n;
    const int sec = n / D, cs = n % D, tile = cs >> 8, hh = (cs & 255) >> 6, d = cs & 63;
    return sec * D + tile * 256 + (d >> 5) * 128 + hh * 32 + (d & 31);
}
template <int MODE, bool FP8> __device__ __forceinline__ void p0_matrix(const float* W, int K, int N, void* WTv, float scale, LAS float* scr, int lane, int it) {
    const int nblk = N / 64, kb = it / nblk, nb = it % nblk, k0 = 64 * kb, n0 = 64 * nb;
    f32x4 v[16];
#pragma unroll
    for (int i = 0; i < 16; ++i) v[i] = *(const GAS f32x4*)(W + (size_t)(k0 + 4 * i + (lane >> 4)) * N + n0 + 4 * (lane & 15));
#pragma unroll
    for (int i = 0; i < 16; ++i) { const int k = 4 * i + (lane >> 4); *(LAS f32x4*)(scr + k * 64 + ((4 * (lane & 15) + 4 * k) & 63)) = v[i]; }
    LDS_WAIT(); asm volatile("" ::: "memory");
    const int ns = n0 + (lane & 32); const int dr = (MODE == 0 ? ns : MODE == 1 ? map_gate(ns) : MODE == 2 ? map_up(ns) : map_qkv(ns)) + (lane & 31);
#define P0_EL(k) scr[(k) * 64 + ((lane + 4 * (k)) & 63)]
    if constexpr (FP8) { GAS v4u* dst = (GAS v4u*)((unsigned char*)WTv + (size_t)dr * K + k0);
#pragma unroll
        for (int c = 0; c < 4; ++c) { v4u o;
            o.x = pg8::pk_fp8x4(P0_EL(16 * c + 0) * scale, P0_EL(16 * c + 1) * scale, P0_EL(16 * c + 2) * scale, P0_EL(16 * c + 3) * scale);
            o.y = pg8::pk_fp8x4(P0_EL(16 * c + 4) * scale, P0_EL(16 * c + 5) * scale, P0_EL(16 * c + 6) * scale, P0_EL(16 * c + 7) * scale);
            o.z = pg8::pk_fp8x4(P0_EL(16 * c + 8) * scale, P0_EL(16 * c + 9) * scale, P0_EL(16 * c + 10) * scale, P0_EL(16 * c + 11) * scale);
            o.w = pg8::pk_fp8x4(P0_EL(16 * c + 12) * scale, P0_EL(16 * c + 13) * scale, P0_EL(16 * c + 14) * scale, P0_EL(16 * c + 15) * scale);
            dst[c] = o; }
    } else { GAS v4u* dst = (GAS v4u*)((bf16*)WTv + (size_t)dr * K + k0);
#pragma unroll
        for (int c = 0; c < 8; ++c) { v4u o; o.x = pk2(P0_EL(8 * c + 0), P0_EL(8 * c + 1)); o.y = pk2(P0_EL(8 * c + 2), P0_EL(8 * c + 3)); o.z = pk2(P0_EL(8 * c + 4), P0_EL(8 * c + 5)); o.w = pk2(P0_EL(8 * c + 6), P0_EL(8 * c + 7));
            dst[c] = o; }
    }
#undef P0_EL
    LDS_WAIT(); asm volatile("" ::: "memory");
}
template <int MODE> __device__ __forceinline__ void p0_matrix8w(const float* W, int K, int N, unsigned char* WT, float scale, LAS float* scr, int lane, int it) {
    const int nblk = N / 32, kb = it / nblk, nb = it % nblk, k0 = 128 * kb, n0 = 32 * nb;
    f32x4 v[16];
#pragma unroll
    for (int i = 0; i < 16; ++i) v[i] = *(const GAS f32x4*)(W + (size_t)(k0 + 8 * i + (lane >> 3)) * N + n0 + 4 * (lane & 7));
#pragma unroll
    for (int i = 0; i < 16; ++i) { const int k = 8 * i + (lane >> 3); *(LAS f32x4*)(scr + k * 32 + ((4 * (lane & 7) + 4 * k) & 31)) = v[i]; }
    LDS_WAIT(); asm volatile("" ::: "memory");
    const int n = lane & 31, kh = lane >> 5; const int dr = (MODE == 0 ? n0 : MODE == 1 ? map_gate(n0) : map_up(n0)) + n;
    GAS v4u* dst = (GAS v4u*)(WT + (size_t)dr * K + k0 + 64 * kh);
#define P0_EL(k) (scr[(64 * kh + (k)) * 32 + ((n + 4 * (64 * kh + (k))) & 31)] * scale)
#pragma unroll
    for (int c = 0; c < 4; ++c) { v4u o;
        o.x = pg8::pk_fp8x4(P0_EL(16 * c + 0), P0_EL(16 * c + 1), P0_EL(16 * c + 2), P0_EL(16 * c + 3)); o.y = pg8::pk_fp8x4(P0_EL(16 * c + 4), P0_EL(16 * c + 5), P0_EL(16 * c + 6), P0_EL(16 * c + 7));
        o.z = pg8::pk_fp8x4(P0_EL(16 * c + 8), P0_EL(16 * c + 9), P0_EL(16 * c + 10), P0_EL(16 * c + 11)); o.w = pg8::pk_fp8x4(P0_EL(16 * c + 12), P0_EL(16 * c + 13), P0_EL(16 * c + 14), P0_EL(16 * c + 15));
        dst[c] = o; }
#undef P0_EL
    LDS_WAIT(); asm volatile("" ::: "memory");
}
__device__ __forceinline__ unsigned pk_i8x4(float a, float b, float c, float d) {
    const int i0 = __float2int_rn(fminf(fmaxf(a, -127.f), 127.f)), i1 = __float2int_rn(fminf(fmaxf(b, -127.f), 127.f)), i2 = __float2int_rn(fminf(fmaxf(c, -127.f), 127.f)), i3 = __float2int_rn(fminf(fmaxf(d, -127.f), 127.f));
    return (unsigned)(i0 & 255) | ((unsigned)(i1 & 255) << 8) | ((unsigned)(i2 & 255) << 16) | ((unsigned)i3 << 24);
}
template <int MODE> __device__ __forceinline__ void p0_matrix_i8w(const float* W, int K, int N, unsigned char* WT, float inv, LAS float* scr, int lane, int it) {
    const int nblk = N / 32, kb = it / nblk, nb = it % nblk, k0 = 128 * kb, n0 = 32 * nb;
    f32x4 v[16];
#pragma unroll
    for (int i = 0; i < 16; ++i) v[i] = *(const GAS f32x4*)(W + (size_t)(k0 + 8 * i + (lane >> 3)) * N + n0 + 4 * (lane & 7));
#pragma unroll
    for (int i = 0; i < 16; ++i) { const int k = 8 * i + (lane >> 3); *(LAS f32x4*)(scr + k * 32 + ((4 * (lane & 7) + 4 * k) & 31)) = v[i]; }
    LDS_WAIT(); asm volatile("" ::: "memory");
    const int n = lane & 31, kh = lane >> 5; const int dr = (MODE == 0 ? n0 : MODE == 1 ? map_gate(n0) : MODE == 2 ? map_up(n0) : map_qkv(n0)) + n;
    GAS v4u* dst = (GAS v4u*)(WT + (size_t)dr * K + k0 + 64 * kh);
#define P0_EL(k) (scr[(64 * kh + (k)) * 32 + ((n + 4 * (64 * kh + (k))) & 31)] * inv)
#pragma unroll
    for (int c = 0; c < 4; ++c) { v4u o;
        o.x = pk_i8x4(P0_EL(16 * c + 0), P0_EL(16 * c + 1), P0_EL(16 * c + 2), P0_EL(16 * c + 3)); o.y = pk_i8x4(P0_EL(16 * c + 4), P0_EL(16 * c + 5), P0_EL(16 * c + 6), P0_EL(16 * c + 7));
        o.z = pk_i8x4(P0_EL(16 * c + 8), P0_EL(16 * c + 9), P0_EL(16 * c + 10), P0_EL(16 * c + 11)); o.w = pk_i8x4(P0_EL(16 * c + 12), P0_EL(16 * c + 13), P0_EL(16 * c + 14), P0_EL(16 * c + 15));
        dst[c] = o; }
#undef P0_EL
    LDS_WAIT(); asm volatile("" ::: "memory");
}
__device__ __forceinline__ float rms_row_to_bf16(const float* xrow, const float* gain, bf16* orow, int lane) {
    const GAS f32x4* xr = (const GAS f32x4*)xrow + lane; const GAS f32x4* gr = (const GAS f32x4*)gain + lane;
    f32x4 v[8]; float s = 0.f;
#pragma unroll
    for (int j = 0; j < 8; ++j) { v[j] = xr[64 * j]; s += (v[j].x * v[j].x + v[j].y * v[j].y) + (v[j].z * v[j].z + v[j].w * v[j].w); }
    const float rstd = 1.f / sqrtf(wave_sum(s) * (1.f / D) + EPS);
    GAS unsigned long long* o8 = (GAS unsigned long long*)orow + lane;
#pragma unroll
    for (int j = 0; j < 8; ++j) { const f32x4 g = gr[64 * j];
        o8[64 * j] = (unsigned long long)pk2(v[j].x * rstd * g.x, v[j].y * rstd * g.y) | ((unsigned long long)pk2(v[j].z * rstd * g.z, v[j].w * rstd * g.w) << 32); }
    return rstd;
}
__device__ __forceinline__ void norm_phase(Frame& F, const float* x, const float* gain, bf16* out) {
    const int gw = F.vcu * NWAVES + F.wave, NGW = F.G * NWAVES, lane = F.lane;
    const GAS f32x4* gr = (const GAS f32x4*)gain + lane;
    f32x4 v[8], nx[8];
    if (gw < M) { const GAS f32x4* xr = (const GAS f32x4*)(x + (size_t)gw * D) + lane;
#pragma unroll
        for (int j = 0; j < 8; ++j) v[j] = xr[64 * j]; }
    for (int m = gw; m < M; m += NGW) {
        const int mn = (m + NGW < M) ? m + NGW : m; const GAS f32x4* xn = (const GAS f32x4*)(x + (size_t)mn * D) + lane;
#pragma unroll
        for (int j = 0; j < 8; ++j) nx[j] = xn[64 * j];
        float s = 0.f;
#pragma unroll
        for (int j = 0; j < 8; ++j) s += (v[j].x * v[j].x + v[j].y * v[j].y) + (v[j].z * v[j].z + v[j].w * v[j].w);
        const float rstd = 1.f / sqrtf(wave_sum(s) * (1.f / D) + EPS);
        GAS unsigned long long* o8 = (GAS unsigned long long*)(out + (size_t)m * D) + lane;
#pragma unroll
        for (int j = 0; j < 8; ++j) { const f32x4 g = gr[64 * j];
            o8[64 * j] = (unsigned long long)pk2(v[j].x * rstd * g.x, v[j].y * rstd * g.y) | ((unsigned long long)pk2(v[j].z * rstd * g.z, v[j].w * rstd * g.w) << 32); }
#pragma unroll
        for (int j = 0; j < 8; ++j) v[j] = nx[j];
    }
}
__device__ __forceinline__ void norm_phase_b(Frame& F, const bf16* x, const float* gain, bf16* out) {
    const int gw = F.vcu * NWAVES + F.wave, NGW = F.G * NWAVES, lane = F.lane;
    const GAS f32x4* gr = (const GAS f32x4*)gain + 2 * lane;
    v4u v[4], nx[4];
    if (gw < M) { const GAS v4u* xr = (const GAS v4u*)(x + (size_t)gw * D) + lane;
#pragma unroll
        for (int j = 0; j < 4; ++j) v[j] = xr[64 * j]; }
    for (int m = gw; m < M; m += NGW) {
        const int mn = (m + NGW < M) ? m + NGW : m; const GAS v4u* xn = (const GAS v4u*)(x + (size_t)mn * D) + lane;
#pragma unroll
        for (int j = 0; j < 4; ++j) nx[j] = xn[64 * j];
        float s = 0.f; f32x4 a[4][2];
#pragma unroll
        for (int j = 0; j < 4; ++j) { a[j][0] = pg8::bf4lo(v[j].x, v[j].y); a[j][1] = pg8::bf4lo(v[j].z, v[j].w);
            s += (a[j][0].x * a[j][0].x + a[j][0].y * a[j][0].y) + (a[j][0].z * a[j][0].z + a[j][0].w * a[j][0].w) + (a[j][1].x * a[j][1].x + a[j][1].y * a[j][1].y) + (a[j][1].z * a[j][1].z + a[j][1].w * a[j][1].w); }
        const float rstd = 1.f / sqrtf(wave_sum(s) * (1.f / D) + EPS);
        GAS v4u* o = (GAS v4u*)(out + (size_t)m * D) + lane;
#pragma unroll
        for (int j = 0; j < 4; ++j) { const f32x4 g0 = gr[128 * j], g1 = gr[128 * j + 1]; v4u w;
            w.x = pk2(a[j][0].x * rstd * g0.x, a[j][0].y * rstd * g0.y); w.y = pk2(a[j][0].z * rstd * g0.z, a[j][0].w * rstd * g0.w);
            w.z = pk2(a[j][1].x * rstd * g1.x, a[j][1].y * rstd * g1.y); w.w = pk2(a[j][1].z * rstd * g1.z, a[j][1].w * rstd * g1.w); o[64 * j] = w; }
#pragma unroll
        for (int j = 0; j < 4; ++j) v[j] = nx[j];
    }
}
__device__ __forceinline__ void norm_phase_qf(Frame& F, const float* x, const float* gain, unsigned char* out, float* rowscale) {
    const int gw = F.vcu * NWAVES + F.wave, NGW = F.G * NWAVES, lane = F.lane;
    const GAS f32x4* gr = (const GAS f32x4*)gain + lane;
    f32x4 v[8], nx[8];
    if (gw < M) { const GAS f32x4* xr = (const GAS f32x4*)(x + (size_t)gw * D) + lane;
#pragma unroll
        for (int j = 0; j < 8; ++j) v[j] = xr[64 * j]; }
    for (int m = gw; m < M; m += NGW) {
        const int mn = (m + NGW < M) ? m + NGW : m; const GAS f32x4* xn = (const GAS f32x4*)(x + (size_t)mn * D) + lane;
#pragma unroll
        for (int j = 0; j < 8; ++j) nx[j] = xn[64 * j];
        float s = 0.f;
#pragma unroll
        for (int j = 0; j < 8; ++j) s += (v[j].x * v[j].x + v[j].y * v[j].y) + (v[j].z * v[j].z + v[j].w * v[j].w);
        const float rstd = 1.f / sqrtf(wave_sum(s) * (1.f / D) + EPS);
        float amax = 0.f;
#pragma unroll
        for (int j = 0; j < 8; ++j) { const f32x4 g = gr[64 * j]; v[j] = (f32x4){v[j].x * rstd * g.x, v[j].y * rstd * g.y, v[j].z * rstd * g.z, v[j].w * rstd * g.w};
            amax = fmaxf(amax, fmaxf(fmaxf(fabsf(v[j].x), fabsf(v[j].y)), fmaxf(fabsf(v[j].z), fabsf(v[j].w)))); }
#pragma unroll
        for (int o = 1; o < 64; o <<= 1) amax = fmaxf(amax, __shfl_xor(amax, o));
        amax = fmaxf(amax, 1e-20f); const float inv = 127.0f / amax;
        GAS unsigned* o4 = (GAS unsigned*)(out + (size_t)m * D) + lane;
#pragma unroll
        for (int j = 0; j < 8; ++j) o4[64 * j] = pk_i8x4(v[j].x * inv, v[j].y * inv, v[j].z * inv, v[j].w * inv);
        if (lane == 0) rowscale[m] = amax * (1.0f / 127.0f);
#pragma unroll
        for (int j = 0; j < 8; ++j) v[j] = nx[j];
    }
}
typedef unsigned v2u_f __attribute__((ext_vector_type(2)));
__device__ __forceinline__ void norm_phase_q(Frame& F, const bf16* x, const float* gain, unsigned char* out, float* rowscale) {
    const int rpx = M / 8, xq = F.vcu >> 5, gw = xq * rpx + (F.vcu & 31) * NWAVES + F.wave, NGW = 32 * NWAVES, M_END = (xq + 1) * rpx, lane = F.lane;
    const GAS f32x4* gr = (const GAS f32x4*)gain + 2 * lane;
    v4u v[4], nx[4];
    if (gw < M_END) { const GAS v4u* xr = (const GAS v4u*)(x + (size_t)gw * D) + lane;
#pragma unroll
        for (int j = 0; j < 4; ++j) v[j] = xr[64 * j]; }
    for (int m = gw; m < M_END; m += NGW) {
        const int mn = (m + NGW < M_END) ? m + NGW : m; const GAS v4u* xn = (const GAS v4u*)(x + (size_t)mn * D) + lane;
#pragma unroll
        for (int j = 0; j < 4; ++j) nx[j] = xn[64 * j];
        float s = 0.f; f32x4 a[4][2];
#pragma unroll
        for (int j = 0; j < 4; ++j) { a[j][0] = pg8::bf4lo(v[j].x, v[j].y); a[j][1] = pg8::bf4lo(v[j].z, v[j].w);
            s += (a[j][0].x * a[j][0].x + a[j][0].y * a[j][0].y) + (a[j][0].z * a[j][0].z + a[j][0].w * a[j][0].w) + (a[j][1].x * a[j][1].x + a[j][1].y * a[j][1].y) + (a[j][1].z * a[j][1].z + a[j][1].w * a[j][1].w); }
        const float rstd = 1.f / sqrtf(wave_sum(s) * (1.f / D) + EPS);
        float amax = 0.f;
#pragma unroll
        for (int j = 0; j < 4; ++j)
#pragma unroll
            for (int q = 0; q < 2; ++q) { const f32x4 g = gr[128 * j + q]; a[j][q] = (f32x4){a[j][q].x * rstd * g.x, a[j][q].y * rstd * g.y, a[j][q].z * rstd * g.z, a[j][q].w * rstd * g.w};
                amax = fmaxf(amax, fmaxf(fmaxf(fabsf(a[j][q].x), fabsf(a[j][q].y)), fmaxf(fabsf(a[j][q].z), fabsf(a[j][q].w)))); }
#pragma unroll
        for (int o = 1; o < 64; o <<= 1) amax = fmaxf(amax, __shfl_xor(amax, o));
        amax = fmaxf(amax, 1e-20f); const float inv = 127.0f / amax;
        GAS v2u_f* o8 = (GAS v2u_f*)(out + (size_t)m * D) + lane;
#pragma unroll
        for (int j = 0; j < 4; ++j) { v2u_f w; w.x = pk_i8x4(a[j][0].x * inv, a[j][0].y * inv, a[j][0].z * inv, a[j][0].w * inv); w.y = pk_i8x4(a[j][1].x * inv, a[j][1].y * inv, a[j][1].z * inv, a[j][1].w * inv); o8[64 * j] = w; }
        if (lane == 0) rowscale[m] = amax * (1.0f / 127.0f);
#pragma unroll
        for (int j = 0; j < 4; ++j) v[j] = nx[j];
    }
}
struct P0Args { const float *w_in, *w_out, *w_gate, *w_up, *w_down, *w_qkv, *w_o, *w_pool, *we_gate, *we_up, *we_down, *w_spatial; const int* positions; const float* x; const float* norm_mix; };
__device__ __forceinline__ void p0_prologue(Frame& F, const P0Args& a, unsigned char* ws) {
    LAS float* scr = (LAS float*)(F.lds + RING_OFF + F.wave * 16384);
    const int gw = F.vcu * NWAVES + F.wave, NGW = F.G * NWAVES, lane = F.lane;
    norm_phase_qf(F, a.x, a.norm_mix, ws + WS_A, (float*)(ws + WS_HSCALE));
    constexpr int I_IN = (D / 64) * (ZW / 64), I_DD = (D / 64) * (D / 64), I_FF = (D / 64) * (FF / 64), I_QKV = (D / 64) * (NQKV / 64), I_POOL = 4 * 4;
    constexpr int N_DENSE = I_IN + I_DD + 3 * I_FF + I_QKV + I_DD + 4 * I_POOL, N_ALL = N_DENSE + NE * 3 * I_FF;
    { LAS float* red = (LAS float*)(F.lds + RING_OFF + 131072 - 256);     volatile LAS float* LWf = (volatile LAS float*)(F.lds + LDSCTL_OFF);
      float sg_ = 0.f, su_ = 0.f, sq_ = 0.f, so_ = 0.f, si_ = 0.f;
      for (int i = F.tid; i < 16384; i += 512) { const float g_ = a.w_gate[i], u_ = a.w_up[i], q_ = a.w_qkv[i], o_ = a.w_o[i], n_ = a.w_in[i]; sg_ += g_ * g_; su_ += u_ * u_; sq_ += q_ * q_; so_ += o_ * o_; si_ += n_ * n_; }
      sg_ = wave_sum(sg_); su_ = wave_sum(su_); sq_ = wave_sum(sq_); so_ = wave_sum(so_); si_ = wave_sum(si_);
      if (lane == 0) { red[4 * F.wave] = sg_; red[4 * F.wave + 1] = su_; red[4 * F.wave + 2] = sq_; red[4 * F.wave + 3] = so_; red[32 + F.wave] = si_; }
      __syncthreads();
      if (F.tid == 0) { float tg = 0.f, tu = 0.f, tq = 0.f, to = 0.f, ti = 0.f; for (int w_ = 0; w_ < NWAVES; ++w_) { tg += red[4 * w_]; tu += red[4 * w_ + 1]; tq += red[4 * w_ + 2]; to += red[4 * w_ + 3]; ti += red[32 + w_]; }
          LWf[LW_WSC + 20] = 4.0f * sqrtf(ti * (1.0f / 16384.0f)) * (1.0f / 127.0f);
          LWf[LW_WSC + 3] = 4.0f * sqrtf(to * (1.0f / 16384.0f)) * (1.0f / 127.0f);
          LWf[LW_WSC] = 4.0f * sqrtf(tg * (1.0f / 16384.0f)) * (1.0f / 127.0f); LWf[LW_WSC + 1] = 4.0f * sqrtf(tu * (1.0f / 16384.0f)) * (1.0f / 127.0f); LWf[LW_WSC + 2] = 4.0f * sqrtf(tq * (1.0f / 16384.0f)) * (1.0f / 127.0f); }
      __syncthreads();
      for (int e = 0; e < NE; ++e) { float eg = 0.f, eu = 0.f;
          for (int i = F.tid; i < 4096; i += 512) { const float g_ = a.we_gate[(size_t)e * D * FF + i], u_ = a.we_up[(size_t)e * D * FF + i]; eg += g_ * g_; eu += u_ * u_; }
          eg = wave_sum(eg); eu = wave_sum(eu);
          if (lane == 0) { red[2 * F.wave] = eg; red[2 * F.wave + 1] = eu; }
          __syncthreads();
          if (F.tid == 0) { float tg = 0.f, tu = 0.f; for (int w_ = 0; w_ < NWAVES; ++w_) { tg += red[2 * w_]; tu += red[2 * w_ + 1]; }
              LWf[LW_WSC + 4 + 2 * e] = 4.0f * sqrtf(tg * (1.0f / 4096.0f)) * (1.0f / 127.0f); LWf[LW_WSC + 5 + 2 * e] = 4.0f * sqrtf(tu * (1.0f / 4096.0f)) * (1.0f / 127.0f); }
          __syncthreads(); } }
    const float inv_g = 1.0f / ((volatile LAS float*)(F.lds + LDSCTL_OFF))[LW_WSC], inv_u = 1.0f / ((volatile LAS float*)(F.lds + LDSCTL_OFF))[LW_WSC + 1];
    const float inv_q = 1.0f / ((volatile LAS float*)(F.lds + LDSCTL_OFF))[LW_WSC + 2];
    const float inv_o = 1.0f / ((volatile LAS float*)(F.lds + LDSCTL_OFF))[LW_WSC + 3];
    const float inv_i = 1.0f / ((volatile LAS float*)(F.lds + LDSCTL_OFF))[LW_WSC + 20];
    for (int it = gw; it < N_ALL; it += NGW) {
        int r = it;
        if (r < I_IN) { p0_matrix_i8w<0>(a.w_in, D, ZW, ws + WS_WIN, inv_i, scr, lane, r); continue; } r -= I_IN;
        if (r < I_DD) { p0_matrix<0, false>(a.w_out, D, D, ws + WS_WOUT, 1.f, scr, lane, r); continue; } r -= I_DD;
        if (r < I_FF) { p0_matrix_i8w<1>(a.w_gate, D, FF, ws + WS_WGU, inv_g, scr, lane, r); continue; } r -= I_FF;
        if (r < I_FF) { p0_matrix_i8w<2>(a.w_up, D, FF, ws + WS_WGU, inv_u, scr, lane, r); continue; } r -= I_FF;
        if (r < I_FF) { p0_matrix8w<0>(a.w_down, FF, D, ws + WS_WD, W8_SCALE, scr, lane, r); continue; } r -= I_FF;
        if (r < I_QKV) { p0_matrix_i8w<3>(a.w_qkv, D, NQKV, ws + WS_WQKV, inv_q, scr, lane, r); continue; } r -= I_QKV;
        if (r < I_DD) { p0_matrix_i8w<0>(a.w_o, D, D, ws + WS_WO, inv_o, scr, lane, r); continue; } r -= I_DD;
        if (r < 4 * I_POOL) { const int g = r / I_POOL; p0_matrix<0, false>(a.w_pool + (size_t)g * 65536, 256, 256, ws + WS_WPOOL + (size_t)g * 65536 * 2, 1.f, scr, lane, r % I_POOL); continue; } r -= 4 * I_POOL;
        { constexpr int I8 = (D / 128) * (FF / 32); static_assert(I8 == I_FF && (FF / 128) * (D / 32) == I_FF, "same item count in both item shapes");
          const int e = r / (3 * I_FF), q = r % (3 * I_FF), which = q / I_FF, ii = q % I_FF;
          const volatile LAS float* wsc_ = (const volatile LAS float*)(F.lds + LDSCTL_OFF) + LW_WSC + 4;
          if (which == 0) p0_matrix_i8w<1>(a.we_gate + (size_t)e * D * FF, D, FF, ws + WS_WEGU + (size_t)e * 2 * FF * D, 1.0f / wsc_[2 * e], scr, lane, ii);
          else if (which == 1) p0_matrix_i8w<2>(a.we_up + (size_t)e * D * FF, D, FF, ws + WS_WEGU + (size_t)e * 2 * FF * D, 1.0f / wsc_[2 * e + 1], scr, lane, ii);
          else p0_matrix8w<0>(a.we_down + (size_t)e * FF * D, FF, D, ws + WS_WED + (size_t)e * D * FF, W8_SCALE, scr, lane, ii); }
    }
    { bf16* wsp = (bf16*)(ws + WS_WSP); const int gt = F.vcu * NWAVES * 64 + F.tid, NT = F.G * NWAVES * 64;
      for (int i = gt; i < 8 * 128 * 128; i += NT) { const int t = (i >> 7) & 127, s = i & 127; wsp[i] = (bf16)(s <= t ? f2bf(a.w_spatial[i]) : 0u); }
      float* rope = (float*)(ws + WS_ROPE);
      for (int i = gt; i < M * 32; i += NT) { const int r = i >> 5, k = i & 31;
          const float inv = exp2f(-(float)k * (13.287712379549449f / 32.0f)); const float ang = (float)a.positions[r] * inv;
          const double rev = (double)ang * 0.15915494309189535; const float fr = (float)(rev - rint(rev));
          rope[(size_t)r * 64 + k] = __builtin_amdgcn_cosf(fr); rope[(size_t)r * 64 + 32 + k] = __builtin_amdgcn_sinf(fr); } }
}

typedef unsigned v2u __attribute__((ext_vector_type(2)));
__device__ __forceinline__ void p2_mixer(Frame& F, const bf16* Z, bf16* Y, const bf16* WpT, const float* pscale, const bf16* Wsp, const float* bsp, const float* lng, const float* lnb) {
    constexpr int ZP = 136;
    LAS bf16* ZS = (LAS bf16*)(F.lds);
    LAS bf16* PL = (LAS bf16*)(F.lds + 144 * ZP * 2);
    LAS bf16* VT = (LAS bf16*)(F.lds);
    LAS float* ST = (LAS float*)(F.lds + 81920);
    const int tid = F.tid, lane = F.lane, w = F.wave, fr = lane & 15, fq = lane >> 4;
    for (int unit = F.vcu; unit < M / 128; unit += F.G) {
        const int r0 = unit * 128, tpos0 = r0 % SEQ; const bool first = tpos0 == 0;
        for (int g = 0; g < 4; ++g) {
            const int win = 2 << g;
            f32x4 acc[2][8];
#pragma unroll
            for (int a = 0; a < 2; ++a)
#pragma unroll
                for (int b = 0; b < 8; ++b) acc[a][b] = (f32x4){0.f, 0.f, 0.f, 0.f};
            for (int kh = 0; kh < 2; ++kh) {
                __syncthreads();
                for (int i = tid; i < 144 * 16; i += 512) { const int row = i >> 4, ch = i & 15; v4u v = (v4u){0u, 0u, 0u, 0u};
                    if (!(first && row < 16)) v = *(const GAS v4u*)(Z + (size_t)(r0 - 16 + row) * ZW + g * 256 + kh * 128 + ch * 8);
                    *(LAS v4u*)(ZS + row * ZP + ch * 8) = v; }
                __syncthreads();
                { const int ch = tid & 15, tq = tid >> 4;
#pragma unroll 1
                  for (int k = 0; k < 4; ++k) { const int t = tq + 32 * k; float s[8];
#pragma unroll
                      for (int j = 0; j < 8; ++j) s[j] = 0.f;
                      for (int j = 0; j < win; ++j) { const v4u v = *(const LAS v4u*)(ZS + (t + 16 - j) * ZP + ch * 8);
                          s[0] += bflo(v.x); s[1] += bfhi(v.x); s[2] += bflo(v.y); s[3] += bfhi(v.y); s[4] += bflo(v.z); s[5] += bfhi(v.z); s[6] += bflo(v.w); s[7] += bfhi(v.w); }
                      const v4u zc = *(const LAS v4u*)(ZS + (t + 16) * ZP + ch * 8); const int tp = tpos0 + t; const float inv = 1.0f / (float)(tp + 1 < win ? tp + 1 : win);
                      v4u o; o.x = pk2(s[0] * inv - bflo(zc.x), s[1] * inv - bfhi(zc.x)); o.y = pk2(s[2] * inv - bflo(zc.y), s[3] * inv - bfhi(zc.y));
                      o.z = pk2(s[4] * inv - bflo(zc.z), s[5] * inv - bfhi(zc.z)); o.w = pk2(s[6] * inv - bflo(zc.w), s[7] * inv - bfhi(zc.w));
                      *(LAS v4u*)(PL + t * ZP + ch * 8) = o; } }
                __syncthreads();
#pragma unroll 1
                for (int ks = 0; ks < 4; ++ks) { bf16x8 af[2];
#pragma unroll
                    for (int db = 0; db < 2; ++db) af[db] = *(const GAS bf16x8*)(WpT + ((size_t)g * 256 + 32 * w + 16 * db + fr) * 256 + kh * 128 + 32 * ks + 8 * fq);
#pragma unroll
                    for (int tb = 0; tb < 8; ++tb) { const bf16x8 bv = *(const LAS bf16x8*)(PL + (16 * tb + fr) * ZP + 32 * ks + 8 * fq);
#pragma unroll
                        for (int db = 0; db < 2; ++db) acc[db][tb] = __builtin_amdgcn_mfma_f32_16x16x32_bf16(af[db], bv, acc[db][tb], 0, 0, 0); } }
            }
#pragma unroll
            for (int db = 0; db < 2; ++db) { const int col = g * 256 + 32 * w + 16 * db + 4 * fq; const f32x4 sc = *(const GAS f32x4*)(pscale + col);
#pragma unroll
                for (int tb = 0; tb < 8; ++tb) { const f32x4 v = acc[db][tb] * sc; v2u o; o.x = pk2(v[0], v[1]); o.y = pk2(v[2], v[3]);
                    *(GAS v2u*)(Y + (size_t)(r0 + 16 * tb + fr) * D + col) = o; } }
        }
        __syncthreads();
        for (int k = 0; k < 16; ++k) { const int t = 16 * w + k; const GAS v4u* vr = (const GAS v4u*)(Z + (size_t)(r0 + t) * ZW + PW + GW) + lane; const v4u a = vr[0], b = vr[64];
            float x[16] = {bflo(a.x), bfhi(a.x), bflo(a.y), bfhi(a.y), bflo(a.z), bfhi(a.z), bflo(a.w), bfhi(a.w), bflo(b.x), bfhi(b.x), bflo(b.y), bfhi(b.y), bflo(b.z), bfhi(b.z), bflo(b.w), bfhi(b.w)};
            float s = 0.f;
#pragma unroll
            for (int j = 0; j < 16; ++j) s += x[j];
            const float mean = wave_sum(s) * (1.0f / GW); float q = 0.f;
#pragma unroll
            for (int j = 0; j < 16; ++j) { const float d = x[j] - mean; q += d * d; }
            const float rstd = 1.0f / sqrtf(wave_sum(q) * (1.0f / GW) + EPS);
            if (lane == 0) { ST[2 * t] = mean; ST[2 * t + 1] = rstd; } }
        __syncthreads();
        for (int g = 0; g < 8; ++g) {
#pragma unroll 1
            for (int k = 0; k < 4; ++k) { const int i = tid + 512 * k, s = i >> 4, ch = i & 15;
                const v4u v = *(const GAS v4u*)(Z + (size_t)(r0 + s) * ZW + PW + GW + g * 128 + ch * 8); const float mean = ST[2 * s], rstd = ST[2 * s + 1];
                const f32x4 g0 = *(const GAS f32x4*)(lng + g * 128 + ch * 8), g1 = *(const GAS f32x4*)(lng + g * 128 + ch * 8 + 4), b0 = *(const GAS f32x4*)(lnb + g * 128 + ch * 8), b1 = *(const GAS f32x4*)(lnb + g * 128 + ch * 8 + 4);
                LAS bf16* vt = VT + (ch * 8) * ZP + s;
                vt[0 * ZP] = (bf16)f2bf((bflo(v.x) - mean) * rstd * g0[0] + b0[0]); vt[1 * ZP] = (bf16)f2bf((bfhi(v.x) - mean) * rstd * g0[1] + b0[1]);
                vt[2 * ZP] = (bf16)f2bf((bflo(v.y) - mean) * rstd * g0[2] + b0[2]); vt[3 * ZP] = (bf16)f2bf((bfhi(v.y) - mean) * rstd * g0[3] + b0[3]);
                vt[4 * ZP] = (bf16)f2bf((bflo(v.z) - mean) * rstd * g1[0] + b1[0]); vt[5 * ZP] = (bf16)f2bf((bfhi(v.z) - mean) * rstd * g1[1] + b1[1]);
                vt[6 * ZP] = (bf16)f2bf((bflo(v.w) - mean) * rstd * g1[2] + b1[2]); vt[7 * ZP] = (bf16)f2bf((bfhi(v.w) - mean) * rstd * g1[3] + b1[3]); }
            __syncthreads();
            f32x4 acc[8];
#pragma unroll
            for (int b = 0; b < 8; ++b) acc[b] = (f32x4){0.f, 0.f, 0.f, 0.f};
            const int nks = (w >> 1) + 1;
#pragma unroll 1
            for (int ks = 0; ks < nks; ++ks) { const bf16x8 bw = *(const GAS bf16x8*)(Wsp + ((size_t)g * 128 + 16 * w + fr) * 128 + 32 * ks + 8 * fq);
#pragma unroll
                for (int cb = 0; cb < 8; ++cb) { const bf16x8 av = *(const LAS bf16x8*)(VT + (16 * cb + fr) * ZP + 32 * ks + 8 * fq);
                    acc[cb] = __builtin_amdgcn_mfma_f32_16x16x32_bf16(av, bw, acc[cb], 0, 0, 0); } }
            { const int t = 16 * w + fr; const float bias = bsp[g * 128 + t];
#pragma unroll
              for (int cb = 0; cb < 8; ++cb) { const int c = g * 128 + 16 * cb + 4 * fq; const v2u uu = *(const GAS v2u*)(Z + (size_t)(r0 + t) * ZW + PW + c);
                  v2u o; o.x = pk2(bflo(uu.x) * (acc[cb][0] + bias), bfhi(uu.x) * (acc[cb][1] + bias)); o.y = pk2(bflo(uu.y) * (acc[cb][2] + bias), bfhi(uu.y) * (acc[cb][3] + bias));
                  *(GAS v2u*)(Y + (size_t)(r0 + t) * D + PW + c) = o; } }
            __syncthreads();
        }
    }
}

__device__ __forceinline__ void p10_combine(Frame& F, const bf16* O0, const bf16* O1, unsigned char* O, float* rowscale, const float* lq1, const float* lk1, const float* lq2, const float* lk2, const float* subg) {
    const int rpx = M / 8, xq = F.vcu >> 5, gw = xq * rpx + (F.vcu & 31) * NWAVES + F.wave, NGW = 32 * NWAVES, M_END = (xq + 1) * rpx, lane = F.lane;
    const float s1 = wave_sum(lq1[lane] * lk1[lane]), s2 = wave_sum(lq2[lane] * lk2[lane]);
    const float lam = expf(s1) - expf(s2) + LAMBDA_INIT;
    const int e0 = (lane & 15) * 8;
    const f32x4 g0 = *(const GAS f32x4*)(subg + e0), g1 = *(const GAS f32x4*)(subg + e0 + 4);
    const float post = 1.0f - LAMBDA_INIT;
    for (int m = gw; m < M_END; m += NGW) {
        const GAS v4u* a = (const GAS v4u*)(O0 + (size_t)m * D) + lane; const GAS v4u* b = (const GAS v4u*)(O1 + (size_t)m * D) + lane; GAS v2u* o = (GAS v2u*)(O + (size_t)m * D) + lane;
        float val[4][8]; float amax = 0.f;
#pragma unroll
        for (int j = 0; j < 4; ++j) { const v4u x = a[64 * j], y = b[64 * j]; float d[8];
            d[0] = bflo(x.x) - lam * bflo(y.x); d[1] = bfhi(x.x) - lam * bfhi(y.x); d[2] = bflo(x.y) - lam * bflo(y.y); d[3] = bfhi(x.y) - lam * bfhi(y.y);
            d[4] = bflo(x.z) - lam * bflo(y.z); d[5] = bfhi(x.z) - lam * bfhi(y.z); d[6] = bflo(x.w) - lam * bflo(y.w); d[7] = bfhi(x.w) - lam * bfhi(y.w);
            float q = 0.f;
#pragma unroll
            for (int i = 0; i < 8; ++i) q += d[i] * d[i];
            q += __shfl_xor(q, 1); q += __shfl_xor(q, 2); q += __shfl_xor(q, 4); q += __shfl_xor(q, 8);
            const float r = post / sqrtf(q * (1.0f / 128.0f) + EPS);
            val[j][0] = d[0] * r * g0[0]; val[j][1] = d[1] * r * g0[1]; val[j][2] = d[2] * r * g0[2]; val[j][3] = d[3] * r * g0[3];
            val[j][4] = d[4] * r * g1[0]; val[j][5] = d[5] * r * g1[1]; val[j][6] = d[6] * r * g1[2]; val[j][7] = d[7] * r * g1[3];
#pragma unroll
            for (int i = 0; i < 8; ++i) amax = fmaxf(amax, fabsf(val[j][i])); }
#pragma unroll
        for (int sft = 1; sft < 64; sft <<= 1) amax = fmaxf(amax, __shfl_xor(amax, sft));
        amax = fmaxf(amax, 1e-20f); const float inv = 127.0f / amax;
#pragma unroll
        for (int j = 0; j < 4; ++j) { v2u w; w.x = pk_i8x4(val[j][0] * inv, val[j][1] * inv, val[j][2] * inv, val[j][3] * inv); w.y = pk_i8x4(val[j][4] * inv, val[j][5] * inv, val[j][6] * inv, val[j][7] * inv); o[64 * j] = w; }
        if (lane == 0) rowscale[m] = amax * (1.0f / 127.0f);
    }
}

__device__ __forceinline__ void p12a_route(Frame& F, const bf16* X, const float* gain, const float* wrt, unsigned char* ws) {
    LAS float* WR = (LAS float*)(F.lds);
    LAS int* SEL = (LAS int*)(F.lds + 65536);
    LAS int* RNK = (LAS int*)(F.lds + 65536 + 1024);
    LAS int* LCNT = (LAS int*)(F.lds + 65536 + 2048);
    int* tok_e = (int*)(ws + WS_TOK); int* tok_p = tok_e + 2 * M; float* tok_w = (float*)(tok_p + 2 * M); float* tok_rstd = tok_w + 2 * M;
    const int tid = F.tid, lane = F.lane, w = F.wave;
    for (int i = tid; i < D * NE; i += 512) WR[(i & 7) * D + (i >> 3)] = wrt[i];
    if (tid < 16) LCNT[tid] = 0;
    __syncthreads();
    const int rows_per_blk = M / F.G;
    const int rbase = F.vcu * rows_per_blk;
    const GAS f32x4* gr = (const GAS f32x4*)gain + 2 * lane;
    for (int li = w; li < rows_per_blk; li += NWAVES) { const int m = rbase + li;
        const GAS v4u* xr = (const GAS v4u*)(X + (size_t)m * D) + lane;
        f32x4 v[4][2]; float s = 0.f;
#pragma unroll
        for (int j = 0; j < 4; ++j) { const v4u t = xr[64 * j]; v[j][0] = pg8::bf4lo(t.x, t.y); v[j][1] = pg8::bf4lo(t.z, t.w);
#pragma unroll
            for (int q = 0; q < 2; ++q) s += (v[j][q].x * v[j][q].x + v[j][q].y * v[j][q].y) + (v[j][q].z * v[j][q].z + v[j][q].w * v[j][q].w); }
        const float rstd = 1.f / sqrtf(wave_sum(s) * (1.f / D) + EPS);
        float lg[8];
#pragma unroll
        for (int e = 0; e < 8; ++e) lg[e] = 0.f;
#pragma unroll
        for (int j = 0; j < 4; ++j)
#pragma unroll
            for (int q = 0; q < 2; ++q) { const f32x4 g = gr[128 * j + q]; const f32x4 h = (f32x4){v[j][q].x * rstd * g.x, v[j][q].y * rstd * g.y, v[j][q].z * rstd * g.z, v[j][q].w * rstd * g.w};
#pragma unroll
                for (int e = 0; e < 8; ++e) { const f32x4 wv = *(const LAS f32x4*)(WR + e * D + 8 * (64 * j + lane) + 4 * q); lg[e] += (h.x * wv.x + h.y * wv.y) + (h.z * wv.z + h.w * wv.w); } }
#pragma unroll
        for (int e = 0; e < 8; ++e) lg[e] = wave_sum(lg[e]);
        if (lane == 0) {
            int e0 = 0; float v0 = lg[0];
#pragma unroll
            for (int e = 1; e < 8; ++e) if (lg[e] > v0) { v0 = lg[e]; e0 = e; }
            int e1 = -1; float v1 = -INFINITY;
#pragma unroll
            for (int e = 0; e < 8; ++e) if (e != e0 && (e1 < 0 || lg[e] > v1)) { v1 = lg[e]; e1 = e; }
            const float w1 = 1.0f / (1.0f + expf(v0 - v1)), w0 = 1.0f - w1;
            SEL[2 * li] = e0; SEL[2 * li + 1] = e1; tok_w[2 * m] = w0; tok_w[2 * m + 1] = w1; tok_rstd[m] = rstd; }
    }
    __syncthreads();
    if (tid < 2 * rows_per_blk) RNK[tid] = __hip_atomic_fetch_add(LCNT + SEL[tid], 1, __ATOMIC_RELAXED, __HIP_MEMORY_SCOPE_WORKGROUP);
    __syncthreads();
    if (tid < 8) LCNT[8 + tid] = (int)__hip_atomic_fetch_add(F.ctl + CW_GCNT + 64 * tid, (unsigned)LCNT[tid], RLX_AGENT);
    __syncthreads();
    if (tid < 2 * rows_per_blk) { const int e = SEL[tid]; tok_e[2 * rbase + tid] = e; tok_p[2 * rbase + tid] = LCNT[8 + e] + RNK[tid]; }
    __syncthreads();
}
__device__ __forceinline__ void p12b_gather(Frame& F, const bf16* X, const float* gain, unsigned char* ws) {
    volatile LAS int* LW = (volatile LAS int*)(F.lds + LDSCTL_OFF);
    if (F.tid == 0) { int ts = 0; LW[LW_TS] = 0; LW[LW_SEG] = 0;
        for (int e = 0; e < 8; ++e) { const unsigned c = __hip_atomic_load(F.ctl + CW_GCNT + 64 * e, RLX_AGENT); const int t0 = ts; ts += (int)((c + 255u) >> 8); LW[LW_TS + e + 1] = ts; LW[LW_SEG + e + 1] = ts * 256;
            for (int t = t0; t < ts && t < MAX_TILES; ++t) LW[LW_TEXP + t] = e; } }
    __syncthreads();
    int* tok_e = (int*)(ws + WS_TOK); int* tok_p = tok_e + 2 * M; float* tok_w = (float*)(tok_p + 2 * M); float* tok_rstd = tok_w + 2 * M;
    unsigned char* Xp = ws + WS_XP;
    const int gw = F.vcu * NWAVES + F.wave, NGW = F.G * NWAVES, lane = F.lane;
    const GAS f32x4* gr = (const GAS f32x4*)gain + 2 * lane;
    for (int m = gw; m < M; m += NGW) {
        const int e0 = tok_e[2 * m], e1 = tok_e[2 * m + 1]; const int p0 = LW[LW_SEG + e0] + tok_p[2 * m], p1 = LW[LW_SEG + e1] + tok_p[2 * m + 1]; const float rstd = tok_rstd[m];
        const GAS v4u* xr = (const GAS v4u*)(X + (size_t)m * D) + lane;
        GAS v2u* d0 = (GAS v2u*)(Xp + (size_t)p0 * D) + lane; GAS v2u* d1 = (GAS v2u*)(Xp + (size_t)p1 * D) + lane;
#pragma unroll
        for (int j = 0; j < 4; ++j) { const v4u t = xr[64 * j]; const f32x4 a = pg8::bf4lo(t.x, t.y), b = pg8::bf4lo(t.z, t.w), g0 = gr[128 * j], g1 = gr[128 * j + 1];
            const float qs = rstd * (127.0f / XP_CLIP);
            v2u o; o.x = pk_i8x4(a.x * qs * g0.x, a.y * qs * g0.y, a.z * qs * g0.z, a.w * qs * g0.w); o.y = pk_i8x4(b.x * qs * g1.x, b.y * qs * g1.y, b.z * qs * g1.z, b.w * qs * g1.w);
            d0[64 * j] = o; d1[64 * j] = o; }
        asm volatile("" ::: "memory");
        if (lane == 0) { tok_p[2 * m] = p0; tok_p[2 * m + 1] = p1; }
    }
}
__device__ __forceinline__ void p15_final(Frame& F, const bf16* X, float* out, const float* gain, unsigned char* ws, bool poison) {
    const int* tok_e = (const int*)(ws + WS_TOK); const int* tok_p = tok_e + 2 * M; const float* tok_w = (const float*)(tok_p + 2 * M);
    const bf16* Ym = (const bf16*)(ws + WS_YM);
    const int gw = F.vcu * NWAVES + F.wave, NGW = F.G * NWAVES, lane = F.lane;
    const GAS f32x4* gr = (const GAS f32x4*)gain + 2 * lane;
    v4u x[4], xn[4], a[4], an[4], b[4], bn[4]; float w0 = 0.f, w1 = 0.f, w0n, w1n;
#define P15_LOAD(m_, X_, A_, B_, W0_, W1_) do { const int p0_ = tok_p[2 * (m_)], p1_ = tok_p[2 * (m_) + 1]; W0_ = tok_w[2 * (m_)]; W1_ = tok_w[2 * (m_) + 1]; \
        const GAS v4u* xr_ = (const GAS v4u*)(X + (size_t)(m_) * D) + lane; const GAS v4u* y0_ = (const GAS v4u*)(Ym + (size_t)p0_ * D) + lane; const GAS v4u* y1_ = (const GAS v4u*)(Ym + (size_t)p1_ * D) + lane; \
        _Pragma("unroll") for (int j = 0; j < 4; ++j) { X_[j] = xr_[64 * j]; A_[j] = y0_[64 * j]; B_[j] = y1_[64 * j]; } } while (0)
    if (gw < M) P15_LOAD(gw, x, a, b, w0, w1);
    for (int m = gw; m < M; m += NGW) {
        const int mn = (m + NGW < M) ? m + NGW : m;
        P15_LOAD(mn, xn, an, bn, w0n, w1n);
        f32x4 v[4][2]; float s = 0.f;
#pragma unroll
        for (int j = 0; j < 4; ++j) {
            v[j][0] = pg8::bf4lo(x[j].x, x[j].y) + pg8::bf4lo(a[j].x, a[j].y) * w0 + pg8::bf4lo(b[j].x, b[j].y) * w1;
            v[j][1] = pg8::bf4lo(x[j].z, x[j].w) + pg8::bf4lo(a[j].z, a[j].w) * w0 + pg8::bf4lo(b[j].z, b[j].w) * w1;
#pragma unroll
            for (int q = 0; q < 2; ++q) s += (v[j][q].x * v[j][q].x + v[j][q].y * v[j][q].y) + (v[j][q].z * v[j][q].z + v[j][q].w * v[j][q].w); }
        float rstd = 1.f / sqrtf(wave_sum(s) * (1.f / D) + EPS);
        if (poison) rstd = __builtin_nanf("");
        GAS f32x4* xo = (GAS f32x4*)(out + (size_t)m * D) + 2 * lane;
#pragma unroll
        for (int j = 0; j < 4; ++j)
#pragma unroll
            for (int q = 0; q < 2; ++q) { const f32x4 g = gr[128 * j + q]; xo[128 * j + q] = (f32x4){v[j][q].x * rstd * g.x, v[j][q].y * rstd * g.y, v[j][q].z * rstd * g.z, v[j][q].w * rstd * g.w}; }
#pragma unroll
        for (int j = 0; j < 4; ++j) { x[j] = xn[j]; a[j] = an[j]; b[j] = bn[j]; }
        w0 = w0n; w1 = w1n;
    }
#undef P15_LOAD
}
struct Args { const void* in[29]; float* out; unsigned char* ws; };
__global__ void __launch_bounds__(NWAVES * 64, 2) hybrid_fwd(Args args) {
    extern __shared__ __attribute__((aligned(16))) unsigned char lds[];
    Frame F;
    F.lds = (LAS unsigned char*)lds;
    F.MISC = (volatile LAS unsigned*)(F.lds + MISC_OFF);
    F.tid = threadIdx.x; F.lane = F.tid & 63; F.wave = __builtin_amdgcn_readfirstlane(F.tid >> 6);
    F.G = gridDim.x; { const int bx = blockIdx.x; F.vcu = (F.G % 8 == 0) ? (bx % 8) * (F.G / 8) + bx / 8 : bx; }
    unsigned char* ws = args.ws;
    F.ctl = (gu32*)(ws + WS_CTL);
    for (int u = F.tid; u < (LDS_BYTES - LDSCTL_OFF) / 4; u += NWAVES * 64) ((LAS unsigned*)(F.lds + LDSCTL_OFF))[u] = 0u;
    __syncthreads();
    XcdBarrier bar = xcd_barrier_post((unsigned*)(F.ctl + CW_BAR), F.MISC + 8);
    if (F.tid == 0) { const unsigned me = xb_xcc_id() + 1u; const unsigned prev = atomicCAS((unsigned*)(F.ctl + CW_ALIGN + 64 * (blockIdx.x & 7)), 0u, me);
        if (prev != 0u && prev != me) atomicOr((unsigned*)(F.ctl + CW_MISMATCH), 1u); }
    F.local_ok = 0;
#define GRID_BAR_L() do { if (F.local_ok) xcd_barrier_local(bar); else xcd_barrier(bar); int t_ = threadIdx.x; asm volatile("" : "+v"(t_)); F.tid = t_; F.lane = t_ & 63; } while (0)
#define GRID_BAR() do { xcd_barrier(bar); int t_ = threadIdx.x; asm volatile("" : "+v"(t_)); F.tid = t_; F.lane = t_ & 63; } while (0)
    const float* x = (const float*)args.in[0]; float* out = args.out;
    bf16* const A = (bf16*)(ws + WS_A); bf16* const XR = (bf16*)(ws + WS_XR);
    typedef pg8::bf16_t pb;

    { P0Args a; a.w_in = (const float*)args.in[3]; a.w_out = (const float*)args.in[10]; a.w_gate = (const float*)args.in[12]; a.w_up = (const float*)args.in[13]; a.w_down = (const float*)args.in[14];
      a.w_qkv = (const float*)args.in[16]; a.w_o = (const float*)args.in[22]; a.w_pool = (const float*)args.in[4]; a.we_gate = (const float*)args.in[25]; a.we_up = (const float*)args.in[26]; a.we_down = (const float*)args.in[27];
      a.w_spatial = (const float*)args.in[8]; a.positions = (const int*)args.in[1]; a.x = x; a.norm_mix = (const float*)args.in[2];
      p0_prologue(F, a, ws); }
    GRID_BAR();
    F.local_ok = __builtin_amdgcn_readfirstlane((F.G == 256 && __hip_atomic_load(F.ctl + CW_MISMATCH, RLX_AGENT) == 0u) ? 1 : 0);
    { pg8::Gemm g{(const pb*)A, (const pb*)(ws + WS_WIN), D / 2, 0}; pg8::StaticOrder S; S.init(M, ZW, F.G, (int)blockIdx.x);
      pg8::EpiZq E{(pb*)(ws + WS_Z), ZW, PW / 256, (const float*)(ws + WS_HSCALE), ((volatile LAS float*)(F.lds + LDSCTL_OFF))[LW_WSC + 20]};
      pg8::gemm_phase<pg8::EpiZq, pg8::StaticOrder, true, true, false, true>(F.lds + RING_OFF, g, S, E); }
    GRID_BAR();
    p2_mixer(F, (const bf16*)(ws + WS_Z), (bf16*)(ws + WS_Y1), (const bf16*)(ws + WS_WPOOL), (const float*)args.in[5], (const bf16*)(ws + WS_WSP), (const float*)args.in[9], (const float*)args.in[6], (const float*)args.in[7]);
    GRID_BAR();
    { pg8::Gemm g{(const pb*)(ws + WS_Y1), (const pb*)(ws + WS_WOUT), D, 0}; pg8::StaticOrder S; S.init(M, D, F.G, (int)blockIdx.x);
      pg8::EpiResB<true> E{x, (pb*)XR, D, 1.0f};
      pg8::gemm_phase<pg8::EpiResB<true>, pg8::StaticOrder, true, true>(F.lds + RING_OFF, g, S, E); }
    GRID_BAR_L();
    norm_phase_q(F, XR, (const float*)args.in[11], (unsigned char*)A, (float*)(ws + WS_HSCALE));
    GRID_BAR_L();
    { pg8::Gemm g{(const pb*)A, (const pb*)(ws + WS_WGU), D / 2, 0}; pg8::StaticOrder S; S.init(M, 2 * FF, F.G, (int)blockIdx.x);
      volatile LAS float* LWf = (volatile LAS float*)(F.lds + LDSCTL_OFF);
      pg8::EpiSwiGLUq E{ws + WS_ACT, FF, (const float*)(ws + WS_HSCALE), LWf[LW_WSC], LWf[LW_WSC + 1]};
      pg8::gemm_phase<pg8::EpiSwiGLUq, pg8::StaticOrder, true, true, false, true>(F.lds + RING_OFF, g, S, E); }
    GRID_BAR_L();
    { pg8::Gemm g{(const pb*)(ws + WS_ACT), (const pb*)(ws + WS_WD), FF / 2, 0}; pg8::StaticOrder S; S.init(M, D, F.G, (int)blockIdx.x);
      pg8::EpiResB<false> E{(const pb*)XR, (pb*)XR, D, 1.0f / W8_SCALE};
      pg8::gemm_phase<pg8::EpiResB<false>, pg8::StaticOrder, true, true, true>(F.lds + RING_OFF, g, S, E); }
    GRID_BAR_L();
    norm_phase_q(F, XR, (const float*)args.in[15], (unsigned char*)A, (float*)(ws + WS_HSCALE));
    GRID_BAR();
    { pg8::Gemm g{(const pb*)A, (const pb*)(ws + WS_WQKV), D / 2, 0}; pg8::StaticOrder S; S.init(M, 2 * D, F.G, (int)blockIdx.x);
      pg8::EpiQKVq8 E{ws + WS_Q, ws + WS_K, D, (const float*)(ws + WS_ROPE), attn_body::C2, (const float*)(ws + WS_HSCALE), ((volatile LAS float*)(F.lds + LDSCTL_OFF))[LW_WSC + 2]};
      pg8::gemm_phase<pg8::EpiQKVq8, pg8::StaticOrder, true, true, false, true>(F.lds + RING_OFF, g, S, E); }
    { pg8::Gemm g{(const pb*)(ws + WS_WQKV + (size_t)2 * D * D), (const pb*)A, D / 2, 0}; pg8::StaticOrder S; S.init(D, M, F.G, (int)blockIdx.x);
      pg8::EpiVT E{ws + WS_V, (const float*)(ws + WS_HSCALE), ((volatile LAS float*)(F.lds + LDSCTL_OFF))[LW_WSC + 2], SEQ};
      pg8::gemm_phase<pg8::EpiVT, pg8::StaticOrder, true, true, false, true>(F.lds + RING_OFF, g, S, E); }
    GRID_BAR();
    { const attn_body::DiffOrder S(F.vcu); attn_body::AttnUnit u;
      const unsigned char* Qb = ws + WS_Q; const unsigned char* Kb = ws + WS_K;     const unsigned char* VTb = ws + WS_V;
#define ATTN_UNITS(TRAIL) for (int i = 0; S.next(i, u); ++i) { const int qc = (u.h * 2 + u.c) * 64, vc = u.h * 128; \
          attn_body::bf16* Ob = (attn_body::bf16*)(ws + (u.c ? WS_O1 : WS_O0)); \
          attn_body::attn_unit<8, TRAIL>(u.b, 0, u.qb, Qb + qc, Kb + qc, VTb + (size_t)(u.b * 16 + u.h) * 128 * SEQ, Ob + vc, (char*)lds + RING_OFF); }
      if (F.wave < 4) { ATTN_UNITS(false) } else { ATTN_UNITS(true) }
#undef ATTN_UNITS
    }
    GRID_BAR();
    p10_combine(F, (const bf16*)(ws + WS_O0), (const bf16*)(ws + WS_O1), (unsigned char*)A, (float*)(ws + WS_HSCALE), (const float*)args.in[17], (const float*)args.in[18], (const float*)args.in[19], (const float*)args.in[20], (const float*)args.in[21]);
    GRID_BAR_L();
    { pg8::Gemm g{(const pb*)A, (const pb*)(ws + WS_WO), D / 2, 0}; pg8::StaticOrder S; S.init(M, D, F.G, (int)blockIdx.x);
      pg8::EpiResBq E{(pb*)XR, D, (const float*)(ws + WS_HSCALE), ((volatile LAS float*)(F.lds + LDSCTL_OFF))[LW_WSC + 3]};
      pg8::gemm_phase<pg8::EpiResBq, pg8::StaticOrder, true, true, false, true>(F.lds + RING_OFF, g, S, E); }
    GRID_BAR_L();
    p12a_route(F, XR, (const float*)args.in[23], (const float*)args.in[24], ws);
    GRID_BAR();
    p12b_gather(F, XR, (const float*)args.in[23], ws);
    GRID_BAR();
    { volatile LAS int* LW = (volatile LAS int*)(F.lds + LDSCTL_OFF); const int n_tiles = __builtin_amdgcn_readfirstlane(LW[LW_TS + 8]);
      { pg8::Gemm g{(const pb*)(ws + WS_XP), (const pb*)(ws + WS_WEGU), D / 2, (size_t)2 * FF * D}; pg8::MoeOrder S; S.init(n_tiles * 256, 2 * FF, F.G, (int)blockIdx.x); S.tile0 = 0;
        S.texp = (const volatile LAS int*)(F.lds + LDSCTL_OFF) + LW_TEXP;
        pg8::EpiSwiGLUqs E{ws + WS_ACTC, FF, XP_CLIP / 127.0f, (const volatile LAS float*)(F.lds + LDSCTL_OFF) + LW_WSC + 4};
        pg8::gemm_phase<pg8::EpiSwiGLUqs, pg8::MoeOrder, true, true, false, true>(F.lds + RING_OFF, g, S, E); }
      GRID_BAR();
      { pg8::Gemm g{(const pb*)(ws + WS_ACTC), (const pb*)(ws + WS_WED), FF / 2, (size_t)D * FF}; pg8::MoeOrder S; S.init(n_tiles * 256, D, F.G, (int)blockIdx.x); S.tile0 = 0;
        S.texp = (const volatile LAS int*)(F.lds + LDSCTL_OFF) + LW_TEXP;
        pg8::EpiPlainS E{(pb*)(ws + WS_YM), D, 1.0f / W8_SCALE};
        pg8::gemm_phase<pg8::EpiPlainS, pg8::MoeOrder, true, true, true>(F.lds + RING_OFF, g, S, E); }
      GRID_BAR();
    }
    { const bool poison = __hip_atomic_load(F.ctl + CW_BAR + XB_TMO, RLX_AGENT) != 0u;
      p15_final(F, XR, out, (const float*)args.in[28], ws, poison); }
}

extern "C" void kernel_launch(void* const* d_in, const int* in_sizes, int n_in, void* d_out, int out_size, void* d_ws, size_t ws_size, hipStream_t stream) {
    static int grid = 0;
    if (grid == 0) {
        if (n_in != 29 || in_sizes[0] != M * D || out_size != M * D || ws_size < WS_END) { fprintf(stderr, "kernel_launch: unexpected shapes (n_in %d, in0 %d, out %d, ws %zu < %zu); nothing launched\n", n_in, n_in > 0 ? in_sizes[0] : -1, out_size, ws_size, (size_t)WS_END); grid = -1; return; }
        int dev = 0, cus = 0, per_cu = 0;
        if (hipGetDevice(&dev) != hipSuccess || hipDeviceGetAttribute(&cus, hipDeviceAttributeMultiprocessorCount, dev) != hipSuccess) { grid = -1; return; }
        if (hipFuncSetAttribute((const void*)hybrid_fwd, hipFuncAttributeMaxDynamicSharedMemorySize, LDS_BYTES) != hipSuccess) { fprintf(stderr, "kernel_launch: hipFuncSetAttribute failed\n"); grid = -1; return; }
        if (hipOccupancyMaxActiveBlocksPerMultiprocessor(&per_cu, (const void*)hybrid_fwd, NWAVES * 64, LDS_BYTES) != hipSuccess || per_cu < 1) fprintf(stderr, "kernel_launch: occupancy query says %d\n", per_cu);
        (void)hipGetLastError();
        if (cus < 256) { fprintf(stderr, "kernel_launch: needs 256 CUs, device has %d\n", cus); grid = -1; return; }
        grid = 256;
    }
    if (grid < 0) return;
    if (hipMemsetAsync((char*)d_ws + WS_CTL, 0, CTL_ZERO_BYTES, stream) != hipSuccess) return;
    Args a{};
    for (int i = 0; i < 29; ++i) a.in[i] = d_in[i];
    a.out = (float*)d_out; a.ws = (unsigned char*)d_ws;
    hipLaunchKernelGGL(hybrid_fwd, dim3(grid), dim3(NWAVES * 64), LDS_BYTES, stream, a);
    const hipError_t le = hipPeekAtLastError();
    if (le != hipSuccess) fprintf(stderr, "kernel_launch: launch failed: %s\n", hipGetErrorName(le));
}
```
